# Optimizing an MI355X kernel written in HIP

```python
import math
import jax
import jax.numpy as jnp
from jax import lax
import numpy as np

D_MODEL = 1024
BATCH = 4
SEQ = 4096
DEPTH = 2

GRID_W = 64
CTX_LEN = 256
MIX_W = D_MODEL
ML_H = 4
ML_W = MIX_W // 4
ML_D = ML_W // ML_H
ML_CHUNK = 64
HG_H = 4
HG_W = MIX_W // 4
HG_K = HG_W // HG_H
HG_V = HG_W // HG_H
HG_CHUNK = 16
DA_H = 4
DA_W = MIX_W // 2
DA_V = DA_W // DA_H
DA_D = DA_V // 2
Q_BLOCK = 128
ROPE_BASE = 10000.0
FF_DENSE = ((8 * D_MODEL // 3 + 255) // 256) * 256
N_EXPERTS = 8
TOP_K = 2
FF_EXPERT = 7 * D_MODEL // 2
N_DENSE = (DEPTH + 1) // 2
N_MOE = DEPTH // 2
EPS = 1e-6
MASK_NEG = -1e30
LB_FLOOR = 1e-30
f32 = jnp.float32

PROJ_LAYOUT = (
    ('ml_q', ML_W), ('ml_k', ML_W), ('ml_v', ML_W), ('ml_o', ML_W), ('ml_gates', 4 * ML_H),
    ('hg_q', HG_W), ('hg_f', 2 * HG_W), ('hg_i', HG_W), ('hg_g', HG_W),
    ('da_q', DA_W), ('da_k', DA_W), ('da_v', DA_W),
)
PROJ_W = sum(w for _, w in PROJ_LAYOUT)

kernel_name = 'hybrid_mlstm_hgrn2_diffattn_prefix_dit'


def rms_norm(x, w):
    x32 = x.astype(f32)
    y = x32 * lax.rsqrt(jnp.mean(x32 * x32, axis=-1, keepdims=True) + EPS)
    return (y * w.astype(f32)).astype(x.dtype)


def head_rms_norm(x, w, n_heads):
    b, l, _ = x.shape
    return rms_norm(x.reshape(b, l, n_heads, -1), w).reshape(b, l, -1)


def modulate(h, shift, scale):
    return h * (1 + scale) + shift


def split_proj(p):
    out = {}
    start = 0
    for name, width in PROJ_LAYOUT:
        out[name] = p[..., start:start + width]
        start += width
    return out


def to_heads(t, n_heads):
    b, l, w = t.shape
    return t.astype(f32).reshape(b, l, n_heads, w // n_heads).transpose(0, 2, 1, 3)


def from_heads(t):
    b, h, l, d = t.shape
    return t.transpose(0, 2, 1, 3).reshape(b, l, h * d)


def chunk_time(a, lc):
    b, h, l = a.shape[:3]
    return a.reshape(b, h, l // lc, lc, *a.shape[3:])


def unchunk_time(a):
    b, h, n, lc = a.shape[:4]
    return a.reshape(b, h, n * lc, *a.shape[4:])


def scan_chunks(step, init, xs):
    xs = jax.tree_util.tree_map(lambda a: jnp.moveaxis(a, 2, 0), xs)
    final, starts = lax.scan(step, init, xs)
    starts = jax.tree_util.tree_map(lambda a: jnp.moveaxis(a, 0, 2), starts)
    return starts, final


def run_direction(states_fn, outputs_fn, lc, ctx_in, lat_in, init, reverse, need_ctx):
    def prep(arrs):
        return tuple(chunk_time(jnp.flip(a, axis=2) if reverse else a, lc) for a in arrs)

    def post(o):
        o = unchunk_time(o)
        return jnp.flip(o, axis=2) if reverse else o

    c_in = prep(ctx_in)
    c_starts, c_final = states_fn(c_in, init)
    out_c = post(outputs_fn(c_in, c_starts)) if need_ctx else None
    x_in = prep(lat_in)
    x_starts, _ = states_fn(x_in, c_final)
    out_x = post(outputs_fn(x_in, x_starts))
    return out_x, out_c


def mlstm_states(inputs, init):
    q, k, v, li, lf = inputs
    b = jnp.cumsum(lf, axis=-1)
    b_last = b[..., -1]
    a = b_last[..., None] - b + li
    m_loc = jnp.max(a, axis=-1)
    w = jnp.exp(a - m_loc[..., None])
    dC = jnp.einsum('bhncd,bhnce->bhnde', k * w[..., None], v)
    dn = jnp.einsum('bhncd,bhnc->bhnd', k, w)

    def step(carry, inp):
        C, n, m = carry
        dC_j, dn_j, bl_j, ml_j = inp
        m_new = jnp.maximum(bl_j + m, ml_j)
        s_old = jnp.exp(bl_j + m - m_new)
        s_new = jnp.exp(ml_j - m_new)
        C_new = s_old[..., None, None] * C + s_new[..., None, None] * dC_j
        n_new = s_old[..., None] * n + s_new[..., None] * dn_j
        return (C_new, n_new, m_new), (C, n, m)

    return scan_chunks(step, init, (dC, dn, b_last, m_loc))


def mlstm_outputs(inputs, starts):
    q, k, v, li, lf = inputs
    C0, n0, m0 = starts
    lc = q.shape[3]
    b = jnp.cumsum(lf, axis=-1)
    causal = jnp.tril(jnp.ones((lc, lc), dtype=bool))
    d = jnp.where(causal, b[..., :, None] - b[..., None, :] + li[..., None, :], MASK_NEG)
    inter = b + m0[..., None]
    m = jnp.maximum(inter, jnp.max(d, axis=-1))
    w_intra = jnp.exp(d - m[..., None])
    w_inter = jnp.exp(inter - m)
    s = jnp.einsum('bhntd,bhnsd->bhnts', q, k) * w_intra
    num = jnp.einsum('bhnts,bhnse->bhnte', s, v) + w_inter[..., None] * jnp.einsum('bhntd,bhnde->bhnte', q, C0)
    den = jnp.sum(s, axis=-1) + w_inter * jnp.einsum('bhntd,bhnd->bhnt', q, n0)
    return num / jnp.maximum(jnp.abs(den), jnp.exp(-m))[..., None]


def mlstm_mixer(pc, px, gate_b, norm_w, need_ctx):
    def prep(p):
        b, l, _ = p['ml_q'].shape
        q = to_heads(p['ml_q'], ML_H)
        k = to_heads(p['ml_k'], ML_H) * (ML_D ** -0.5)
        v = to_heads(p['ml_v'], ML_H)
        g = (p['ml_gates'].astype(f32) + gate_b.astype(f32)).reshape(b, l, 4, ML_H).transpose(2, 0, 3, 1)
        fwd = (q, k, v, g[0], jax.nn.log_sigmoid(g[1]))
        bwd = (q, k, v, g[2], jax.nn.log_sigmoid(g[3]))
        return fwd, bwd

    c_f, c_b = prep(pc)
    x_f, x_b = prep(px)
    bsz = px['ml_q'].shape[0]
    init = (jnp.zeros((bsz, ML_H, ML_D, ML_D), f32), jnp.zeros((bsz, ML_H, ML_D), f32), jnp.zeros((bsz, ML_H), f32))
    xf, cf = run_direction(mlstm_states, mlstm_outputs, ML_CHUNK, c_f, x_f, init, False, need_ctx)
    xb, cb = run_direction(mlstm_states, mlstm_outputs, ML_CHUNK, c_b, x_b, init, True, need_ctx)
    dtype = px['ml_q'].dtype

    def finish(h, p):
        return (jax.nn.sigmoid(p['ml_o'].astype(f32)) * head_rms_norm(from_heads(h), norm_w.reshape(ML_H, ML_D), ML_H)).astype(dtype)

    return finish(xf + xb, px), (finish(cf + cb, pc) if need_ctx else None)


def gla_states(inputs, init):
    q, k, v, g = inputs
    G = jnp.cumsum(g, axis=3)
    G_last = G[:, :, :, -1]
    dS = jnp.einsum('bhnck,bhnce->bhnke', k * jnp.exp(G_last[:, :, :, None] - G), v)

    def step(S, inp):
        dS_j, gl_j = inp
        return jnp.exp(gl_j)[..., None] * S + dS_j, S

    return scan_chunks(step, init, (dS, G_last))


def gla_outputs(inputs, S0):
    q, k, v, g = inputs
    lc = q.shape[3]
    G = jnp.cumsum(g, axis=3)
    causal = jnp.tril(jnp.ones((lc, lc), dtype=bool))
    decay = jnp.exp(jnp.where(causal[:, :, None], G[:, :, :, :, None, :] - G[:, :, :, None, :, :], MASK_NEG))
    a = jnp.einsum('bhntk,bhntsk,bhnsk->bhnts', q, decay, k)
    return jnp.einsum('bhnts,bhnse->bhnte', a, v) + jnp.einsum('bhntk,bhnke->bhnte', q * jnp.exp(G), S0)


def hgrn2_mixer(pc, px, lb, norm_w, need_ctx):
    lb = lb.astype(f32)
    log_lb = jnp.log(jnp.maximum(lb, LB_FLOOR))
    log_1m_lb = jnp.log1p(-lb)

    def prep(p):
        q = to_heads(jax.nn.silu(p['hg_q'].astype(f32)), HG_H)
        v = to_heads(p['hg_i'], HG_H)
        fr = p['hg_f'].astype(f32)
        dirs = []
        for fr_d in (fr[..., :HG_W], fr[..., HG_W:]):
            log_f = jnp.logaddexp(log_lb, log_1m_lb + jax.nn.log_sigmoid(fr_d))
            k = (1.0 - lb) * jax.nn.sigmoid(-fr_d)
            dirs.append((q, to_heads(k, HG_H), v, to_heads(log_f, HG_H)))
        return dirs

    c_f, c_b = prep(pc)
    x_f, x_b = prep(px)
    bsz = px['hg_q'].shape[0]
    init = jnp.zeros((bsz, HG_H, HG_K, HG_V), f32)
    xf, cf = run_direction(gla_states, gla_outputs, HG_CHUNK, c_f, x_f, init, False, need_ctx)
    xb, cb = run_direction(gla_states, gla_outputs, HG_CHUNK, c_b, x_b, init, True, need_ctx)
    dtype = px['hg_q'].dtype

    def finish(o, p):
        return (head_rms_norm(from_heads(o), norm_w.reshape(HG_H, HG_V), HG_H) * jax.nn.silu(p['hg_g'].astype(f32))).astype(dtype)

    return finish(xf + xb, px), (finish(cf + cb, pc) if need_ctx else None)


def axial_rope_tables(n_tokens):
    rows = n_tokens // GRID_W
    row = jnp.repeat(jnp.arange(rows), GRID_W).astype(f32)
    col = jnp.tile(jnp.arange(GRID_W), rows).astype(f32)
    n_freq = DA_D // 4
    inv = ROPE_BASE ** (-jnp.arange(n_freq, dtype=f32) / n_freq)
    ang = jnp.stack([row[:, None] * inv, col[:, None] * inv], axis=1)
    return jnp.cos(ang), jnp.sin(ang)


def apply_axial_rope(t, cos, sin):
    shape = t.shape
    t = t.reshape(*shape[:-1], 2, 2, DA_D // 4)
    t1, t2 = t[..., 0, :], t[..., 1, :]
    out = jnp.stack([t1 * cos - t2 * sin, t1 * sin + t2 * cos], axis=-2)
    return out.reshape(shape)


def diff_softmax_attend(q, k, v, lam):
    s = jnp.einsum('ibhqd,ibhkd->ibhqk', q, k).astype(f32) * (DA_D ** -0.5)
    p = jax.nn.softmax(s, axis=-1)
    return jnp.einsum('bhqk,bhkv->bhqv', p[0] - lam * p[1], v.astype(f32))


def diff_attn_blocks(q, k, v, lam):
    _, b, h, l, d = q.shape
    nb = l // Q_BLOCK
    qb = jnp.moveaxis(q.reshape(2, b, h, nb, Q_BLOCK, d), 3, 0)
    out = lax.map(lambda blk: diff_softmax_attend(blk, k, v, lam), qb)
    return jnp.moveaxis(out, 0, 2).reshape(b, h, l, -1)


def diff_attn_mixer(pc, px, lam_p, norm_w, lam_init, need_ctx):
    def qkv(p):
        b, l, _ = p['da_q'].shape
        q = p['da_q'].astype(f32).reshape(b, l, DA_H, 2, DA_D).transpose(3, 0, 2, 1, 4)
        k = p['da_k'].astype(f32).reshape(b, l, DA_H, 2, DA_D).transpose(3, 0, 2, 1, 4)
        v = to_heads(p['da_v'], DA_H)
        return q, k, v

    qc, kc, vc = qkv(pc)
    qx, kx, vx = qkv(px)
    cos, sin = axial_rope_tables(qx.shape[3])
    qx = apply_axial_rope(qx, cos, sin)
    kx = apply_axial_rope(kx, cos, sin)
    lp = lam_p.astype(f32)
    lam = jnp.exp(jnp.sum(lp[0] * lp[1])) - jnp.exp(jnp.sum(lp[2] * lp[3])) + lam_init
    k_all = jnp.concatenate([kx, kc], axis=3)
    v_all = jnp.concatenate([vx, vc], axis=2)
    dtype = px['da_q'].dtype

    def finish(o):
        return (head_rms_norm(from_heads(o), norm_w, DA_H) * (1.0 - lam_init)).astype(dtype)

    out_x = finish(diff_attn_blocks(qx, k_all, v_all, lam))
    out_c = finish(diff_softmax_attend(qc, kc, vc, lam)) if need_ctx else None
    return out_x, out_c


def swiglu(h, w_gate, w_up, w_down):
    return (jax.nn.silu(h @ w_gate) * (h @ w_up)) @ w_down


def moe_swiglu(h, router_w, router_b, w_gate, w_up, w_down):
    shape = h.shape
    t = h.reshape(-1, shape[-1])
    logits = (t @ router_w + router_b).astype(f32)
    top_v, top_i = lax.top_k(logits, TOP_K)
    top_g = jax.nn.softmax(top_v, axis=-1)
    gates = jnp.sum(jax.nn.one_hot(top_i, N_EXPERTS, dtype=f32) * top_g[..., None], axis=1)
    y = jnp.zeros(t.shape, f32)
    for e in range(N_EXPERTS):
        y = y + gates[:, e:e + 1] * swiglu(t, w_gate[e], w_up[e], w_down[e]).astype(f32)
    return y.reshape(shape).astype(h.dtype)


def setup_inputs(seed: int = 0) -> dict:
    key = jax.random.key(seed)
    ks = jax.random.split(key, 32)
    nrm = jax.random.normal
    D = D_MODEL
    fb = jnp.linspace(3.0, 6.0, ML_H)
    gate_base = jnp.stack([jnp.zeros(ML_H), fb, jnp.zeros(ML_H), fb])
    return {
        'x': nrm(ks[0], (BATCH, SEQ, D), f32),
        'c': nrm(ks[1], (BATCH, D), f32),
        'ctx': nrm(ks[2], (BATCH, CTX_LEN, D), f32),
        'c_ctx': nrm(ks[3], (D,), f32),
        'w_mod': nrm(ks[4], (DEPTH, D, 6 * D), f32) * (0.5 * D ** -0.5),
        'b_mod': nrm(ks[5], (DEPTH, 6 * D), f32) * 0.02,
        'norm_pre_mix': 1.0 + 0.05 * nrm(ks[6], (DEPTH, D), f32),
        'norm_post_mix': 1.0 + 0.05 * nrm(ks[7], (DEPTH, D), f32),
        'norm_pre_ffn': 1.0 + 0.05 * nrm(ks[8], (DEPTH, D), f32),
        'norm_post_ffn': 1.0 + 0.05 * nrm(ks[9], (DEPTH, D), f32),
        'w_in': nrm(ks[10], (DEPTH, D, PROJ_W), f32) * D ** -0.5,
        'w_out': nrm(ks[11], (DEPTH, MIX_W, D), f32) * MIX_W ** -0.5,
        'ml_gate_b': (gate_base[None] + 0.1 * nrm(ks[12], (DEPTH, 4, ML_H), f32)).reshape(DEPTH, 4 * ML_H),
        'ml_norm': 1.0 + 0.05 * nrm(ks[13], (DEPTH, ML_W), f32),
        'hg_lb_logits': nrm(ks[14], (DEPTH, HG_W), f32),
        'hg_norm': 1.0 + 0.05 * nrm(ks[15], (DEPTH, HG_W), f32),
        'da_lambda': 0.1 * nrm(ks[16], (DEPTH, 4, DA_D), f32),
        'da_norm': 1.0 + 0.05 * nrm(ks[17], (DEPTH, DA_V), f32),
        'ffn_w_gate': nrm(ks[18], (N_DENSE, D, FF_DENSE), f32) * D ** -0.5,
        'ffn_w_up': nrm(ks[19], (N_DENSE, D, FF_DENSE), f32) * D ** -0.5,
        'ffn_w_down': nrm(ks[20], (N_DENSE, FF_DENSE, D), f32) * FF_DENSE ** -0.5,
        'router_w': nrm(ks[21], (N_MOE, D, N_EXPERTS), f32) * D ** -0.5,
        'router_b': 0.01 * nrm(ks[22], (N_MOE, N_EXPERTS), f32),
        'moe_w_gate': nrm(ks[23], (N_MOE, N_EXPERTS, D, FF_EXPERT), f32) * D ** -0.5,
        'moe_w_up': nrm(ks[24], (N_MOE, N_EXPERTS, D, FF_EXPERT), f32) * D ** -0.5,
        'moe_w_down': nrm(ks[25], (N_MOE, N_EXPERTS, FF_EXPERT, D), f32) * FF_EXPERT ** -0.5,
    }


def reference(x, c, ctx, c_ctx, w_mod, b_mod, norm_pre_mix, norm_post_mix, norm_pre_ffn, norm_post_ffn,
              w_in, w_out, ml_gate_b, ml_norm, hg_lb_logits, hg_norm, da_lambda, da_norm,
              ffn_w_gate, ffn_w_up, ffn_w_down, router_w, router_b, moe_w_gate, moe_w_up, moe_w_down):
    lb_soft = jax.nn.softmax(hg_lb_logits.astype(f32), axis=0)
    lower_bounds = jnp.cumsum(lb_soft, axis=0) - lb_soft[0]
    for layer in range(DEPTH):
        need_ctx = layer < DEPTH - 1
        mod_x = jnp.split((jax.nn.silu(c) @ w_mod[layer] + b_mod[layer])[:, None, :], 6, axis=-1)
        mod_c = jnp.split(jax.nn.silu(c_ctx) @ w_mod[layer] + b_mod[layer], 6, axis=-1)
        lam_init = 0.8 - 0.6 * math.exp(-0.3 * layer)

        hx = modulate(rms_norm(x, norm_pre_mix[layer]), mod_x[0], mod_x[1])
        hc = modulate(rms_norm(ctx, norm_pre_mix[layer]), mod_c[0], mod_c[1])
        px = split_proj(hx @ w_in[layer])
        pc = split_proj(hc @ w_in[layer])
        ml_x, ml_c = mlstm_mixer(pc, px, ml_gate_b[layer], ml_norm[layer], need_ctx)
        hg_x, hg_c = hgrn2_mixer(pc, px, lower_bounds[layer], hg_norm[layer], need_ctx)
        da_x, da_c = diff_attn_mixer(pc, px, da_lambda[layer], da_norm[layer], lam_init, need_ctx)
        mix_x = jnp.concatenate([ml_x, hg_x, da_x], axis=-1) @ w_out[layer]
        x = x + mod_x[2] * rms_norm(mix_x, norm_post_mix[layer])
        if need_ctx:
            mix_c = jnp.concatenate([ml_c, hg_c, da_c], axis=-1) @ w_out[layer]
            ctx = ctx + mod_c[2] * rms_norm(mix_c, norm_post_mix[layer])

        def channel_mixer(h, layer=layer):
            i = layer // 2
            if layer % 2 == 0:
                return swiglu(h, ffn_w_gate[i], ffn_w_up[i], ffn_w_down[i])
            return moe_swiglu(h, router_w[i], router_b[i], moe_w_gate[i], moe_w_up[i], moe_w_down[i])

        hx = modulate(rms_norm(x, norm_pre_ffn[layer]), mod_x[3], mod_x[4])
        x = x + mod_x[5] * rms_norm(channel_mixer(hx), norm_post_ffn[layer])
        if need_ctx:
            hc = modulate(rms_norm(ctx, norm_pre_ffn[layer]), mod_c[3], mod_c[4])
            ctx = ctx + mod_c[5] * rms_norm(channel_mixer(hc), norm_post_ffn[layer])
    return x
```

```cpp
#include <hip/hip_runtime.h>
#include <cstdio>
#include <cstdint>

#ifndef N_LAUNCHES
#define N_LAUNCHES 1
#endif
#ifndef ENMASK
#define ENMASK 0xffffffffu
#endif
#define EN(b) ((ENMASK >> (b)) & 1u)
#ifndef ATT_DBL
#define ATT_DBL 0
#endif
#ifndef REPMASK
#define REPMASK 0u
#endif
#define REP(b) ((REPMASK >> (b)) & 1u)

#define GAS __attribute__((address_space(1)))
#define LAS __attribute__((address_space(3)))
typedef unsigned short bf16_t;
typedef short bf16x8 __attribute__((ext_vector_type(8)));
typedef float f32x4 __attribute__((ext_vector_type(4)));
typedef float f32x2 __attribute__((ext_vector_type(2)));
typedef unsigned u32x4 __attribute__((ext_vector_type(4)));
typedef unsigned u32x2 __attribute__((ext_vector_type(2)));
typedef float f32x16 __attribute__((ext_vector_type(16)));
typedef short s16x4 __attribute__((ext_vector_type(4)));

constexpr int D = 1024, NB = 4, SEQ = 4096, CTXL = 256, NLAT = NB * SEQ, NCTX = NB * CTXL, ROWS = NLAT + NCTX;
constexpr int PW = 3840;
constexpr int ML_Q = 0, ML_K = 256, ML_V = 512, ML_O = 768, HG_Q = 1024, HG_F = 1280, HG_I = 1792, HG_G = 2048, DA_Q = 2304, DA_K = 2816, DA_V = 3328;
constexpr int WIN_LD = 3856;
constexpr int FF = 2816, FE = 3584, NE = 8;
constexpr int NKEYS = SEQ + CTXL;
constexpr float EPS = 1e-6f;
constexpr float LOG2E = 1.4426950408889634f;
constexpr float C2 = 0.125f * LOG2E;
constexpr int NWAVES = 8, NTHR = 512;

constexpr size_t MiB = 1u << 20;
constexpr size_t WS_CTL = 0, CTL_ZERO_BYTES = 2 * MiB;
constexpr size_t WS_SMALL = 2 * MiB;
constexpr size_t WS_WIN = 3 * MiB;
constexpr size_t WS_WOUT = 18 * MiB;
constexpr size_t WS_WGU = 22 * MiB;
constexpr size_t WS_WD = 33 * MiB;
constexpr size_t WS_XC = 39 * MiB;
constexpr size_t WS_MOE_SIDE = 43 * MiB;
constexpr size_t WS_HN = 43 * MiB;
constexpr size_t WS_GATES = 77 * MiB;
constexpr size_t WS_ROUTE = 79 * MiB;
constexpr size_t WS_MOE_D = 80 * MiB;
constexpr size_t WS_MOE_GU = 136 * MiB;
constexpr size_t WS_P = 248 * MiB;
constexpr size_t WS_MIX = 376 * MiB;
constexpr size_t WS_Y = 410 * MiB;
constexpr size_t WS_SCR = 444 * MiB;
constexpr size_t WS_END = 512 * MiB;
constexpr int MOE_ROWS_MAX = 34816;
constexpr int CW_BAR = 4096;
constexpr int CW_CNT = 8192;
constexpr int CW_LIST = 65536;
static_assert((CW_LIST + NE * NLAT) * 4 <= (int)CTL_ZERO_BYTES, "ctl");
constexpr size_t SM_MODV = 0, SM_COS = 256 * 1024, SM_SIN = 260 * 1024, SM_CONST = 264 * 1024, SM_LB = 268 * 1024;

constexpr int RING_BYTES = 131072, LDSCTL_OFF = RING_BYTES, MISC_OFF = LDSCTL_OFF + 320, LDS_BYTES = 147456;

#define RLX_AGENT __ATOMIC_RELAXED, __HIP_MEMORY_SCOPE_AGENT
#define PHASE_TID() int tid = threadIdx.x; asm volatile("" : "+v"(tid)); const int lane = tid & 63; const int wave = __builtin_amdgcn_readfirstlane(tid >> 6); (void)lane; (void)wave
#define LDS_WAIT() asm volatile("s_waitcnt lgkmcnt(0)" ::: "memory")
#define VM_WAIT() asm volatile("s_waitcnt vmcnt(0)" ::: "memory")
typedef float f32x2_t __attribute__((ext_vector_type(2))); typedef __bf16 bf16x2_t __attribute__((ext_vector_type(2)));
__device__ __forceinline__ unsigned cvt_pk_bf16(float lo, float hi) { const f32x2_t v = {lo, hi}; const bf16x2_t b = __builtin_convertvector(v, bf16x2_t); unsigned r = __builtin_bit_cast(unsigned, b); asm volatile("" : "+v"(r)); return r; }
__device__ __forceinline__ unsigned cvtpk_s(float lo, float hi) { const f32x2_t v = {lo, hi}; const bf16x2_t b = __builtin_convertvector(v, bf16x2_t); return __builtin_bit_cast(unsigned, b); }
__device__ __forceinline__ float dot2_ones(unsigned w, float acc) { return __builtin_amdgcn_fdot2_f32_bf16(__builtin_bit_cast(bf16x2_t, w), __builtin_bit_cast(bf16x2_t, 0x3F803F80u), acc, false); }
__device__ __forceinline__ float bf_lo(unsigned w) { return __uint_as_float(w << 16); }
__device__ __forceinline__ float bf_hi(unsigned w) { return __uint_as_float(w & 0xffff0000u); }
__device__ __forceinline__ float bf2f(bf16_t v) { return __uint_as_float((unsigned)v << 16); }
template <int CTRL, int ROWMASK>
__device__ __forceinline__ float dpp_get(float v) { return __int_as_float(__builtin_amdgcn_update_dpp(0, __float_as_int(v), CTRL, ROWMASK, 0xF, false)); }
__device__ __forceinline__ float sum8(float v) { v += dpp_get<0xB1, 0xF>(v); v += dpp_get<0x4E, 0xF>(v); v += dpp_get<0x141, 0xF>(v); return v; }
__device__ __forceinline__ float sum16(float v) { v = sum8(v); v += dpp_get<0x140, 0xF>(v); return v; }
__device__ __forceinline__ float sum32(float v) { v = sum16(v); const auto r = __builtin_amdgcn_permlane16_swap(__float_as_uint(v), __float_as_uint(v), false, false); return __uint_as_float(r[0]) + __uint_as_float(r[1]); }
__device__ __forceinline__ float wave_sum(float v) {
    v += dpp_get<0xB1, 0xF>(v); v += dpp_get<0x4E, 0xF>(v); v += dpp_get<0x141, 0xF>(v); v += dpp_get<0x140, 0xF>(v);
    v += dpp_get<0x142, 0xA>(v); v += dpp_get<0x143, 0xC>(v);
    return __int_as_float(__builtin_amdgcn_readlane(__float_as_int(v), 63)); }
__device__ __forceinline__ float fast_exp2(float x) { return __builtin_amdgcn_exp2f(x); }
__device__ __forceinline__ float fast_rcp(float x) { return __builtin_amdgcn_rcpf(x); }
__device__ __forceinline__ float sigmoidf_(float x) { return 1.0f / (1.0f + __expf(-x)); }
__device__ __forceinline__ float siluf_(float x) { return x / (1.0f + __expf(-x)); }
__device__ __forceinline__ float log_sigmoidf_(float x) { return fminf(x, 0.f) - log1pf(__expf(-fabsf(x))); }

#define XB_TMO      128
#define XB_XCNT(j)  (256  + 64 * (j))
#define XB_XSUB(j)  (1280 + 64 * (j))
#define XB_XGEN(j)  (2304 + 64 * (j))
#define XB_TOP      3328
#define XB_TOPGEN   3392
#define XCD_BAR_WORDS 3456
#define XB_SPIN_CAP (1u << 18)
__device__ __forceinline__ unsigned xb_ld(unsigned* p)              { return __hip_atomic_load(p, __ATOMIC_RELAXED, __HIP_MEMORY_SCOPE_AGENT); }
__device__ __forceinline__ unsigned xb_add(unsigned* p, unsigned v) { return __hip_atomic_fetch_add(p, v, __ATOMIC_RELAXED, __HIP_MEMORY_SCOPE_AGENT); }
__device__ __forceinline__ unsigned xb_xcc_id() { return (unsigned)__builtin_amdgcn_s_getreg((3 << 11) | 20) & 0xFu; }
#define XB_SPIN(cond, bar) do { unsigned _sp = 0; while (cond) { __builtin_amdgcn_s_sleep(1); \
    if ((++_sp & 255u) == 0u) { if (xb_ld(&(bar)[XB_TMO])) break; if (_sp > XB_SPIN_CAP) { atomicAdd(&(bar)[XB_TMO], 1u); break; } } } } while (0)
struct XcdBarrier { unsigned* bar; unsigned x; volatile LAS unsigned* st; };
__device__ __forceinline__ XcdBarrier xcd_barrier_post(unsigned* bar, volatile LAS unsigned* st) {
    XcdBarrier b; b.bar = bar; b.x = xb_xcc_id(); b.st = st;
    if (threadIdx.x == 0) (void)xb_add(&bar[XB_XCNT(b.x)], 1u);
    return b;
}
__device__ __forceinline__ void xcd_barrier_complete(unsigned* bar, unsigned x, unsigned& nloc, unsigned& nx) {
    const unsigned G = gridDim.x * gridDim.y * gridDim.z;
    unsigned sum, cnt, mine, sp = 0u;
    for (;;) {
        sum = 0u; cnt = 0u; mine = 0u;
#pragma unroll
        for (unsigned j = 0; j < 16; ++j) { const unsigned c = xb_ld(&bar[XB_XCNT(j)]); sum += c; cnt += (c > 0u) ? 1u : 0u; mine = (j == x) ? c : mine; }
        if (sum == G) break;
        __builtin_amdgcn_s_sleep(1);
        if ((++sp & 255u) == 0u) { if (xb_ld(&bar[XB_TMO])) break; if (sp > XB_SPIN_CAP) { atomicAdd(&bar[XB_TMO], 1u); break; } }
    }
    nloc = mine > 0u ? mine : 1u; nx = cnt > 0u ? cnt : 1u;
}
__device__ __forceinline__ void xcd_barrier(const XcdBarrier& b) {
    asm volatile("s_waitcnt vmcnt(0)" ::: "memory");
    __syncthreads();
    if (threadIdx.x == 0) {
        unsigned* bar = b.bar;
        __builtin_amdgcn_s_waitcnt(0);
        unsigned nloc = b.st[0], nx = b.st[1];
        if (nloc == 0u) { xcd_barrier_complete(bar, b.x, nloc, nx); b.st[0] = nloc; b.st[1] = nx; }
        const unsigned old = xb_add(&bar[XB_XSUB(b.x)], 1u);
        const unsigned gen = old / nloc;
        if (old + 1u == (gen + 1u) * nloc) {
            __builtin_amdgcn_fence(__ATOMIC_RELEASE, "agent");
            asm volatile("s_waitcnt vmcnt(0)" ::: "memory");
            const unsigned og = xb_add(&bar[XB_TOP], 1u);
            const unsigned tg = og / nx;
            if (og + 1u == (tg + 1u) * nx) xb_add(&bar[XB_TOPGEN], 1u);
            else XB_SPIN(xb_ld(&bar[XB_TOPGEN]) == tg, bar);
            __builtin_amdgcn_fence(__ATOMIC_ACQUIRE, "agent");
            xb_add(&bar[XB_XGEN(b.x)], 1u);
            asm volatile("s_waitcnt vmcnt(0)" ::: "memory");
        } else {
            XB_SPIN(xb_ld(&bar[XB_XGEN(b.x)]) == gen, bar);
            __builtin_amdgcn_fence(__ATOMIC_ACQUIRE, "agent");
            asm volatile("s_waitcnt vmcnt(0)" ::: "memory");
        }
    }
    __syncthreads();
}

namespace pg8 {
constexpr int BM = 256, BK = 64, HALF = 128, HTB = HALF * BK * 2, STAGE_BYTES = 8 * HTB, NXCD = 8, WGM = 8;
__host__ __device__ __forceinline__ int lds_byte(int r, int c) { const int st = (r >> 4) * 2 + (c >> 5), rr = r & 15, cc = c & 31, ob = rr * 64 + cc * 2; return st * 1024 + (ob ^ (((ob >> 9) & 1) << 5)); }
__host__ __device__ __forceinline__ void stage_rc(int b, int& R, int& C) { const int st = b / 1024, sb = b % 1024, swz = sb ^ (((sb >> 9) & 1) << 5); R = (st >> 1) * 16 + swz / 64; C = (st & 1) * 32 + (swz % 64) / 2; }
__host__ __device__ __forceinline__ int perm32(int rho) { const int n = rho >> 4, i = rho & 15; return 8 * (i >> 2) + 4 * n + (i & 3); }

struct Unit { int pm, pn, e, lt; };

__device__ __forceinline__ int xcd_remap(int wgid, int nwg) { const int q = nwg / NXCD, r = nwg % NXCD, xcd = wgid % NXCD, off = wgid / NXCD; return (xcd < r ? xcd * (q + 1) : r * (q + 1) + (xcd - r) * q) + off; }

struct DenseOrder {
    static constexpr bool GATHER = false;
    int nM, nN, nwg, G, c, K; const char* Bt;
    __device__ __forceinline__ void init(int M, int N, int K_, const bf16_t* Bt_, int G_, int c_) { nM = M / BM; nN = N / BM; nwg = nM * nN; G = G_; c = c_; K = K_; Bt = (const char*)Bt_; }
    __device__ __forceinline__ bool next(int i, Unit& u) const {
        const long L = (long)i * G + c; if (L >= nwg) return false;
        const int wgid = xcd_remap((int)L, nwg);
        const int nig = WGM * nN, gid = wgid / nig, fm = gid * WGM, gsz = (nM - fm) < WGM ? (nM - fm) : WGM;
        u.pm = fm + ((wgid % nig) % gsz); u.pn = (wgid % nig) / gsz; u.e = 0; u.lt = 0; return true;
    }
    __device__ __forceinline__ void a_offsets(const Unit&, const int (&)[2], const int (&)[2], unsigned (&)[2][2]) const {}
    __device__ __forceinline__ size_t a_tile(const Unit& u) const { return (size_t)u.pm * BM * K * 2; }
    __device__ __forceinline__ const char* b_ptr(const Unit& u) const { return Bt + (size_t)u.pn * BM * K * 2; }
};

template <bool GATHER_> struct MoeOrder {
    static constexpr bool GATHER = GATHER_;
    int tb[9]; int nN, nU, G, c, K; const char* Bt; size_t bstride; const unsigned* list;
    __device__ __forceinline__ void init(const unsigned* cnt_words, int N, int K_, const bf16_t* Bt_, size_t bstride_elems, const unsigned* list_, int G_, int c_) {
        int acc = 0;
#pragma unroll
        for (int e = 0; e < 8; ++e) { tb[e] = acc; const int ce = __builtin_amdgcn_readfirstlane((int)__hip_atomic_load(cnt_words + 64 * e, RLX_AGENT)); acc += (ce + 255) >> 8; }
        tb[8] = acc; nN = N / BM; nU = acc * nN; G = G_; c = c_; K = K_; Bt = (const char*)Bt_; bstride = bstride_elems * 2; list = list_;
    }
    __device__ __forceinline__ bool next(int i, Unit& u) const {
        const long L = (long)i * G + c; if (L >= nU) return false;
        const int wgid = xcd_remap((int)L, nU);
        int e = 0, t0 = 0, t1 = tb[1];
#pragma unroll
        for (int k = 1; k < 8; ++k) { if (wgid >= tb[k] * nN) { e = k; t0 = tb[k]; t1 = tb[k + 1]; } }
        const int local = wgid - t0 * nN, te = t1 - t0;
        u.pn = local / te; u.lt = local % te; u.pm = t0 + u.lt; u.e = e; return true;
    }
    __device__ __forceinline__ void a_offsets(const Unit& u, const int (&R)[2], const int (&C)[2], unsigned (&o)[2][2]) const {
#pragma unroll
        for (int h = 0; h < 2; ++h)
#pragma unroll
            for (int i = 0; i < 2; ++i) {
                if (GATHER) { const unsigned tok = list[(size_t)u.e * NLAT + u.lt * BM + h * HALF + R[i]]; o[h][i] = (unsigned)(((size_t)tok * K + C[i]) * 2); }
            }
    }
    __device__ __forceinline__ size_t a_tile(const Unit& u) const { return (size_t)u.pm * BM * K * 2; }
    __device__ __forceinline__ const char* b_ptr(const Unit& u) const { return Bt + (size_t)u.e * bstride + (size_t)u.pn * BM * K * 2; }
};

constexpr int KSW = 512, KSL = FE / KSW;
static_assert(KSL * KSW == FE && (KSW / BK) % 2 == 0, "K slices");
template <int MODE> struct MoeDown {
    static constexpr bool GATHER = false;
    int tb[9]; unsigned pmask; int nN, nU, G, c; const char* Bt; size_t bstride;
    __device__ __forceinline__ void init(const unsigned* cnt_words, const bf16_t* Bt_, size_t bstride_elems, int G_, int c_) {
        int acc = 0, accf = 0; unsigned pm_ = 0u;
#pragma unroll
        for (int e = 0; e < 8; ++e) { tb[e] = acc | (accf << 16); const int ce = __builtin_amdgcn_readfirstlane((int)__hip_atomic_load(cnt_words + 64 * e, RLX_AGENT)); acc += (ce + 255) >> 8; accf += ce >> 8; pm_ |= (ce & 255) ? (1u << e) : 0u; }
        tb[8] = acc | (accf << 16); pmask = pm_; nN = D / BM; G = G_; c = c_; Bt = (const char*)Bt_; bstride = bstride_elems * 2;
        nU = MODE == 0 ? accf * nN : __builtin_popcount(pm_) * nN * KSL;
    }
    __device__ __forceinline__ bool next(int i, Unit& u) const {
        const long L = (long)i * G + (MODE == 0 ? c : G - 1 - c); if (L >= nU) return false;
        if (MODE == 0) {
            const int wgid = xcd_remap((int)L, nU);
            int e = 0, f0 = 0, f1 = tb[1] >> 16, t0 = 0;
#pragma unroll
            for (int k = 1; k < 8; ++k) { if (wgid >= (tb[k] >> 16) * nN) { e = k; f0 = tb[k] >> 16; f1 = tb[k + 1] >> 16; t0 = tb[k] & 0xffff; } }
            const int local = wgid - f0 * nN, te = f1 - f0;
            u.pn = local / te; u.lt = t0 + local % te; u.pm = u.lt; u.e = e; return true;
        } else {
            const int wgid = (int)L, pidx = wgid / (nN * KSL), rem = wgid - pidx * (nN * KSL), ks = rem / nN;
            int e = 0, lt = 0, seen = 0;
#pragma unroll
            for (int k = 0; k < 8; ++k) { if ((pmask >> k) & 1u) { if (seen == pidx) { e = k; lt = (tb[k] & 0xffff) + ((tb[k + 1] >> 16) - (tb[k] >> 16)); } ++seen; } }
            u.pn = rem - ks * nN; u.lt = lt; u.pm = ks * 8 + e; u.e = e | (ks << 8); return true;
        }
    }
    __device__ __forceinline__ void a_offsets(const Unit&, const int (&)[2], const int (&)[2], unsigned (&)[2][2]) const {}
    __device__ __forceinline__ size_t a_tile(const Unit& u) const { return (size_t)u.lt * BM * FE * 2 + (MODE == 0 ? (size_t)0 : (size_t)(u.e >> 8) * KSW * 2); }
    __device__ __forceinline__ const char* b_ptr(const Unit& u) const { return Bt + (size_t)(u.e & 255) * bstride + (size_t)u.pn * BM * FE * 2 + (MODE == 0 ? (size_t)0 : (size_t)(u.e >> 8) * KSW * 2); }
};

__device__ __forceinline__ u32x4 widen16(u32x2 p0, u32x2 p1) {
    const auto a = __builtin_amdgcn_permlane16_swap(p0.x, p1.x, false, false); const auto b = __builtin_amdgcn_permlane16_swap(p0.y, p1.y, false, false);
    return (u32x4){a[0], b[0], a[1], b[1]}; }
struct EpiBf16 {
    static constexpr bool PERM = true;
    bf16_t* O; int ldc;
    __device__ __forceinline__ void operator()(const f32x4 (&acc)[2][2][4][2], const Unit& u, int wr, int wc, int fr, int fq) const {
        const int row0 = u.pm * BM + wr * 64 + fr; const int col0 = u.pn * BM + wc * 32 + 8 * fq;
#pragma unroll
        for (int ai = 0; ai < 2; ++ai)
#pragma unroll
            for (int m = 0; m < 4; ++m) { bf16_t* rowp = O + (size_t)(row0 + ai * HALF + m * 16) * ldc + col0;
#pragma unroll
                for (int bj = 0; bj < 2; ++bj) { const f32x4 v0 = acc[ai][bj][m][0], v1 = acc[ai][bj][m][1];
                    u32x4 w; w.x = cvt_pk_bf16(v0[0], v0[1]); w.y = cvt_pk_bf16(v0[2], v0[3]); w.z = cvt_pk_bf16(v1[0], v1[1]); w.w = cvt_pk_bf16(v1[2], v1[3]);
                    *(u32x4*)(rowp + bj * HALF) = w; } }
    }
};
struct EpiProj {
    static constexpr bool PERM = false;
    bf16_t* O; const float* cosT; const float* sinT;
    __device__ __forceinline__ void operator()(const f32x4 (&acc)[2][2][4][2], const Unit& u, int wr, int wc, int fr, int fq) const {
        const int row0 = u.pm * BM + wr * 64 + fr; const int col0 = u.pn * BM + wc * 32 + 4 * fq;
        const int wofs = (fq & 1) ? 12 : 0;
        const bool rope = (u.pn >= 9) && (u.pn <= 12) && (u.pm < NLAT / BM);
#pragma unroll
        for (int ai = 0; ai < 2; ++ai)
#pragma unroll
            for (int m = 0; m < 4; ++m) { const int row = row0 + ai * HALF + m * 16; bf16_t* rowp = O + (size_t)row * PW + col0;
                const int l = row & (SEQ - 1);
#pragma unroll
                for (int bj = 0; bj < 2; ++bj) { f32x4 t1 = acc[ai][bj][m][0], t2 = acc[ai][bj][m][1];
                    if (rope) { const int axis = ((col0 + bj * HALF) >> 5) & 1; const int pos = axis ? (l & 63) : (l >> 6);
                        const f32x4 cs = *(const f32x4*)(cosT + pos * 16 + 4 * fq), sn = *(const f32x4*)(sinT + pos * 16 + 4 * fq);
                        const f32x4 o1 = t1 * cs - t2 * sn, o2 = t1 * sn + t2 * cs; t1 = o1; t2 = o2; }
                    u32x2 w1, w2; w1.x = cvt_pk_bf16(t1[0], t1[1]); w1.y = cvt_pk_bf16(t1[2], t1[3]); w2.x = cvt_pk_bf16(t2[0], t2[1]); w2.y = cvt_pk_bf16(t2[2], t2[3]);
                    *(u32x4*)(rowp + bj * HALF + wofs) = widen16(w1, w2); } }
    }
};
struct EpiSwiGLU {
    static constexpr bool PERM = false;
    bf16_t* O; int ldc;
    __device__ __forceinline__ void operator()(const f32x4 (&acc)[2][2][4][2], const Unit& u, int wr, int wc, int fr, int fq) const {
        const int row0 = u.pm * BM + wr * 64 + fr;
#pragma unroll
        for (int ai = 0; ai < 2; ++ai)
#pragma unroll
            for (int m = 0; m < 4; ++m) { bf16_t* rowp = O + (size_t)(row0 + ai * HALF + m * 16) * ldc + u.pn * 128 + 4 * fq;
                u32x2 w[2];
#pragma unroll
                for (int bj = 0; bj < 2; ++bj) { const f32x4 g = acc[ai][bj][m][0], up = acc[ai][bj][m][1]; f32x4 h;
#pragma unroll
                    for (int j = 0; j < 4; ++j) h[j] = g[j] * fast_rcp(1.0f + fast_exp2(-LOG2E * g[j])) * up[j];
                    w[bj].x = cvt_pk_bf16(h[0], h[1]); w[bj].y = cvt_pk_bf16(h[2], h[3]); }
                *(u32x4*)(rowp + ((fq & 1) ? (4 + wc) * 16 - 4 : wc * 16)) = widen16(w[0], w[1]); }
    }
};

template <class Epi, class Sched, bool ALIGN_EPI>
__device__ __forceinline__ void gemm_phase(LAS unsigned char* lds, const char* Abase, const int K, const Sched& S, const Epi& E, const int LD_ = 0) {
    int tid = threadIdx.x; asm volatile("" : "+v"(tid));
    const int wid = __builtin_amdgcn_readfirstlane(tid >> 6), lane = tid & 63, wr = wid >> 2, wc = wid & 3, fr = lane & 15, fq = lane >> 4;
    const int nt = K / BK, LD = LD_ ? LD_ : K;
    constexpr bool GA = Sched::GATHER;
    int Rr[2], Cc[2]; unsigned voffA[2], voffB[2];
#pragma unroll
    for (int i = 0; i < 2; ++i) { int R, C; stage_rc(tid * 16 + i * 8192, R, C); const int Rb = Epi::PERM ? ((R & ~31) + perm32(R & 31)) : R; Rr[i] = R; Cc[i] = C; voffA[i] = (unsigned)(R * LD + C) * 2u; voffB[i] = (unsigned)(Rb * LD + C) * 2u; }
    const size_t kstep = (size_t)(BK * 2);
    const size_t hstep = (size_t)HALF * LD * 2;
    const unsigned ldsw = (unsigned)wid * 1024u;
    const int aoff = lds_byte(wr * 64 + fr, fq * 8), boff = lds_byte(wc * 32 + fr, fq * 8);
#define PG8_SA(b, h) (((b) * 2 + (h)) * HTB)
#define PG8_SB(b, h) ((4 + (b) * 2 + (h)) * HTB)
#define PG8_STAGE(bufoff, gbase, voff) do { _Pragma("unroll") for (int _i = 0; _i < 2; ++_i) \
        __builtin_amdgcn_global_load_lds((const unsigned*)((const char*)(gbase) + (voff)[_i]), (LAS unsigned*)(lds + (bufoff) + ldsw + _i * 8192), 16, 0, 0); } while (0)
#define PG8_STAGE_A(bufoff, uptr, oarr, h, kofs) do { if constexpr (GA) { PG8_STAGE(bufoff, Abase + (kofs), (oarr)[h]); } else { PG8_STAGE(bufoff, (uptr) + (h) * hstep + (kofs), voffA); } } while (0)
#define PG8_LDA(dst, b, h) do { _Pragma("unroll") for (int m = 0; m < 4; ++m) _Pragma("unroll") for (int k = 0; k < 2; ++k) dst[m][k] = *(const LAS bf16x8*)(lds + PG8_SA(b, h) + aoff + m * 2048 + k * 1024); } while (0)
#define PG8_LDB(dst, b, h) do { _Pragma("unroll") for (int n = 0; n < 2; ++n) _Pragma("unroll") for (int k = 0; k < 2; ++k) dst[n][k] = *(const LAS bf16x8*)(lds + PG8_SB(b, h) + boff + n * 2048 + k * 1024); } while (0)
#define PG8_MMA(ai, bj, At, Bt) do { __builtin_amdgcn_s_setprio(1); _Pragma("unroll") for (int m = 0; m < 4; ++m) _Pragma("unroll") for (int n = 0; n < 2; ++n) _Pragma("unroll") for (int k = 0; k < 2; ++k) \
        acc[ai][bj][m][n] = __builtin_amdgcn_mfma_f32_16x16x32_bf16(Bt[n][k], At[m][k], acc[ai][bj][m][n], 0, 0, 0); __builtin_amdgcn_s_setprio(0); } while (0)
#define PG8_WAIT_V(n) asm volatile("s_waitcnt vmcnt(" #n ")" ::: "memory")
#define PG8_WAIT_L(n) asm volatile("s_waitcnt lgkmcnt(" #n ")" ::: "memory")
#define PG8_BAR __builtin_amdgcn_s_barrier()
#define PG8_SCHED __builtin_amdgcn_sched_barrier(0)
    Unit cur, nxt; int ui = 0;
    if (!S.next(0, cur)) return;
    f32x4 acc[2][2][4][2];
#pragma unroll
    for (int a = 0; a < 2; ++a)
#pragma unroll
        for (int b = 0; b < 2; ++b)
#pragma unroll
            for (int m = 0; m < 4; ++m)
#pragma unroll
                for (int n = 0; n < 2; ++n) acc[a][b][m][n] = (f32x4){0.f, 0.f, 0.f, 0.f};
    bf16x8 At[4][2], B0[2][2], B1[2][2];
    unsigned oA[2][2], oN[2][2];
    if constexpr (GA) S.a_offsets(cur, Rr, Cc, oA);
    const char* cA = Abase + S.a_tile(cur);
    const char* cB = S.b_ptr(cur);
    PG8_STAGE(PG8_SB(0, 0), cB, voffB); PG8_STAGE(PG8_SB(0, 1), cB + hstep, voffB); PG8_STAGE_A(PG8_SA(0, 0), cA, oA, 0, 0); PG8_STAGE_A(PG8_SA(0, 1), cA, oA, 1, 0);
    if (wr == 1) PG8_BAR;
    PG8_WAIT_V(2); PG8_BAR;
    PG8_STAGE(PG8_SB(1, 0), cB + kstep, voffB); PG8_STAGE_A(PG8_SA(1, 0), cA, oA, 0, kstep); PG8_STAGE(PG8_SB(1, 1), cB + hstep + kstep, voffB);
    PG8_WAIT_V(6); PG8_BAR;
    for (;;) {
        const bool has_next = S.next(ui + 1, nxt);
        const char* nB = cB; const char* nA = cA;
        if (has_next) { if constexpr (GA) S.a_offsets(nxt, Rr, Cc, oN); nB = S.b_ptr(nxt); nA = Abase + S.a_tile(nxt); }
        else if constexpr (GA) {
#pragma unroll
            for (int h = 0; h < 2; ++h)
#pragma unroll
                for (int i = 0; i < 2; ++i) oN[h][i] = oA[h][i];
        }
        for (int t = 0; t < nt; t += 2) {
            const bool last = (t == nt - 2);
            const size_t k1 = (size_t)(t + 1) * kstep, k2 = last ? (size_t)0 : (size_t)(t + 2) * kstep, k3 = k2 + kstep;
            const char* ua = last ? nA : cA; const char* b2 = last ? nB : cB + (size_t)(t + 2) * kstep; const char* b3 = b2 + kstep;
            unsigned o2[2][2];
            if constexpr (GA) {
#pragma unroll
                for (int h = 0; h < 2; ++h)
#pragma unroll
                    for (int i = 0; i < 2; ++i) o2[h][i] = last ? oN[h][i] : oA[h][i];
            }
            PG8_LDB(B0, 0, 0); PG8_LDB(B1, 0, 1); PG8_SCHED; PG8_LDA(At, 0, 0); PG8_STAGE_A(PG8_SA(1, 1), cA, oA, 1, k1);
            PG8_WAIT_V(8); PG8_WAIT_L(0); PG8_BAR; PG8_MMA(0, 0, At, B0); PG8_MMA(0, 1, At, B1); PG8_BAR; PG8_SCHED;
            PG8_LDA(At, 0, 1); PG8_STAGE(PG8_SB(0, 0), b2, voffB); PG8_STAGE(PG8_SB(0, 1), b2 + hstep, voffB); PG8_STAGE_A(PG8_SA(0, 0), ua, o2, 0, k2);
            PG8_WAIT_V(8); PG8_WAIT_L(0); PG8_BAR; PG8_MMA(1, 0, At, B0); PG8_MMA(1, 1, At, B1); PG8_BAR; PG8_SCHED;
            PG8_LDB(B0, 1, 0); PG8_LDB(B1, 1, 1); PG8_SCHED; PG8_LDA(At, 1, 0); PG8_STAGE_A(PG8_SA(0, 1), ua, o2, 1, k2);
            PG8_WAIT_V(8); PG8_WAIT_L(0); PG8_BAR; PG8_MMA(0, 0, At, B0); PG8_MMA(0, 1, At, B1); PG8_BAR; PG8_SCHED;
            PG8_LDA(At, 1, 1); PG8_STAGE(PG8_SB(1, 0), b3, voffB); PG8_STAGE(PG8_SB(1, 1), b3 + hstep, voffB); PG8_STAGE_A(PG8_SA(1, 0), ua, o2, 0, k3);
            PG8_WAIT_V(8); PG8_WAIT_L(0); PG8_BAR; PG8_MMA(1, 0, At, B0); PG8_MMA(1, 1, At, B1); PG8_BAR; PG8_SCHED;
        }
        if constexpr (ALIGN_EPI) { if (wr == 0) PG8_BAR; }
        E(acc, cur, wr, wc, fr, fq);
        if (!has_next) break;
#pragma unroll
        for (int a = 0; a < 2; ++a)
#pragma unroll
            for (int b = 0; b < 2; ++b)
#pragma unroll
                for (int m = 0; m < 4; ++m)
#pragma unroll
                    for (int n = 0; n < 2; ++n) acc[a][b][m][n] = (f32x4){0.f, 0.f, 0.f, 0.f};
        cur = nxt; cB = nB; cA = nA; ++ui;
        if constexpr (GA) {
#pragma unroll
            for (int h = 0; h < 2; ++h)
#pragma unroll
                for (int i = 0; i < 2; ++i) oA[h][i] = oN[h][i];
        }
        if constexpr (ALIGN_EPI) { if (wr == 1) PG8_BAR; }
    }
    PG8_WAIT_V(0);
    if constexpr (!ALIGN_EPI) { if (wr == 0) PG8_BAR; }
    PG8_BAR;
#undef PG8_SA
#undef PG8_SB
#undef PG8_STAGE
#undef PG8_STAGE_A
#undef PG8_LDA
#undef PG8_LDB
#undef PG8_MMA
#undef PG8_WAIT_V
#undef PG8_WAIT_L
#undef PG8_BAR
#undef PG8_SCHED
}
}

struct Args { const float* in[26]; float* out; unsigned char* ws; int ph_lo, ph_hi; };
struct Frame {
    LAS unsigned char* lds;
    volatile LAS unsigned* MISC;
    unsigned* ctl;
    int G, bid;
    const struct Args* a;
    float* out; unsigned char* ws;
};
enum { I_X = 0, I_C, I_CTX, I_CCTX, I_WMOD, I_BMOD, I_NPREMIX, I_NPOSTMIX, I_NPREFFN, I_NPOSTFFN, I_WIN, I_WOUT, I_MLGB, I_MLNORM, I_HGLB, I_HGNORM, I_DALAM, I_DANORM,
       I_FWG, I_FWU, I_FWD, I_RW, I_RB, I_MWG, I_MWU, I_MWD };

__device__ __forceinline__ void transpose_item(const float* colptr, float scale, int ld, int K, bf16_t* WT, int n0, int k0, LAS float* scr, int lane) {
#pragma unroll 8
    for (int i = 0; i < 32; ++i) { const int kk = 2 * i + (lane >> 5); scr[kk * 33 + (lane & 31)] = colptr[(size_t)(k0 + kk) * ld] * scale; }
    LDS_WAIT(); asm volatile("" ::: "memory");
    const int c = lane & 7;
#pragma unroll
    for (int j = 0; j < 4; ++j) { const int n = (lane >> 3) + 8 * j; const LAS float* s = scr + (8 * c) * 33 + n;
        u32x4 o; o.x = cvt_pk_bf16(s[0 * 33], s[1 * 33]); o.y = cvt_pk_bf16(s[2 * 33], s[3 * 33]); o.z = cvt_pk_bf16(s[4 * 33], s[5 * 33]); o.w = cvt_pk_bf16(s[6 * 33], s[7 * 33]);
        *(GAS u32x4*)(WT + (size_t)(n0 + n) * K + k0 + 8 * c) = o; }
    LDS_WAIT(); asm volatile("" ::: "memory");
}
__device__ __forceinline__ void p_mod_vectors(Frame& F) {
    PHASE_TID();
    if (F.bid >= 192) return;
    LAS float* sv = (LAS float*)(F.lds);
    LAS float* red = (LAS float*)(F.lds + 20480);
    for (int idx = tid; idx < 5 * D; idx += NTHR) { const int r = idx >> 10, k = idx & 1023; const float v = r < 4 ? F.a->in[I_C][r * D + k] : F.a->in[I_CCTX][k]; sv[idx] = siluf_(v); }
    __syncthreads();
    const int l = F.bid / 96, cb = (F.bid % 96) * 64;
    const float* W = F.a->in[I_WMOD] + (size_t)l * D * 6144 + cb + lane;
    float a[5] = {0.f, 0.f, 0.f, 0.f, 0.f};
    const int kb = wave * 128;
#pragma unroll 4
    for (int k = 0; k < 128; ++k) { const float wv = W[(size_t)(kb + k) * 6144];
#pragma unroll
        for (int r = 0; r < 5; ++r) a[r] += sv[r * 1024 + kb + k] * wv; }
#pragma unroll
    for (int r = 0; r < 5; ++r) red[(wave * 5 + r) * 64 + lane] = a[r];
    __syncthreads();
    if (tid < 320) { const int r = tid >> 6, ln = tid & 63; float s = 0.f;
#pragma unroll
        for (int w = 0; w < 8; ++w) s += red[(w * 5 + r) * 64 + ln];
        float* MODV = (float*)(F.ws + WS_SMALL + SM_MODV);
        MODV[(size_t)(l * 5 + r) * 6144 + cb + ln] = s + F.a->in[I_BMOD][l * 6144 + cb + ln]; }
    __syncthreads();
}
__device__ __forceinline__ void p_consts(Frame& F) {
    PHASE_TID();
    if (F.bid != 255 % F.G) return;
    float* COS = (float*)(F.ws + WS_SMALL + SM_COS); float* SIN = (float*)(F.ws + WS_SMALL + SM_SIN);
    float* CST = (float*)(F.ws + WS_SMALL + SM_CONST); float* LB = (float*)(F.ws + WS_SMALL + SM_LB);
    for (int idx = tid; idx < 1024; idx += NTHR) { const int pos = idx >> 4, f = idx & 15;
        const double frac[4] = {1.0, 0.5623413251903491, 0.31622776601683794, 0.1778279410038923};
        double inv = (f & 3) == 0 ? frac[0] : ((f & 3) == 1 ? frac[1] : ((f & 3) == 2 ? frac[2] : frac[3]));
        const int dec = f >> 2; inv *= (dec == 0 ? 1.0 : (dec == 1 ? 0.1 : (dec == 2 ? 0.01 : 0.001)));
        const double ang = (double)pos * inv; const double kq = __builtin_rint(ang * 0.15915494309189535); const float r = (float)(ang - kq * 6.283185307179586);
        COS[idx] = __cosf(r); SIN[idx] = __sinf(r); }
    if (tid < 2) { const int l = tid; const float* lp = F.a->in[I_DALAM] + l * 256; float s1 = 0.f, s2 = 0.f;
        for (int i = 0; i < 64; ++i) { s1 += lp[i] * lp[64 + i]; s2 += lp[128 + i] * lp[192 + i]; }
        const float lam_init = 0.8f - 0.6f * expf(-0.3f * (float)l);
        CST[l * 4 + 0] = expf(s1) - expf(s2) + lam_init; CST[l * 4 + 1] = lam_init; }
    if (tid < 256) { const float z0 = F.a->in[I_HGLB][tid], z1 = F.a->in[I_HGLB][256 + tid]; const float mx = fmaxf(z0, z1); const float e0 = expf(z0 - mx), e1 = expf(z1 - mx);
        LB[tid] = 0.f; LB[256 + tid] = e1 / (e0 + e1); }
}
__device__ __forceinline__ void p_weights(Frame& F) {
    PHASE_TID();
    LAS float* scr = (LAS float*)(F.lds + 32768 + wave * 12288);
    const int gw = F.bid * NWAVES + wave, NGW = F.G * NWAVES, nl = lane & 31;
    constexpr int I_IN = 16 * (PW / 32), I_OUT = 16 * 32, I_GU = 16 * (2 * FF / 32), I_DN = (FF / 64) * 32, I_MGU = 16 * (2 * FE / 32), I_MDN = (FE / 64) * 32;
    constexpr int NITEMS = 2 * I_IN + 2 * I_OUT + I_GU + I_DN + NE * I_MGU + NE * I_MDN;
    for (int it = gw; it < NITEMS; it += NGW) {
        int r = it;
        if (r < 2 * I_IN) { const int l = r / I_IN; r %= I_IN; const int nblk = PW / 32, kb = r / nblk, nb = r % nblk, np = nb * 32 + nl; const int col = np < 1024 ? np : np + 16;
            const float sc = (np >= ML_K && np < ML_V) ? 0.125f : ((np >= DA_Q && np < DA_K) ? C2 : 1.0f);
            transpose_item(F.a->in[I_WIN] + (size_t)l * D * WIN_LD + col, sc, WIN_LD, D, (bf16_t*)(F.ws + WS_WIN) + (size_t)l * PW * D, nb * 32, kb * 64, scr, lane); continue; }
        r -= 2 * I_IN;
        if (r < 2 * I_OUT) { const int l = r / I_OUT; r %= I_OUT; const int kb = r / 32, nb = r % 32;
            transpose_item(F.a->in[I_WOUT] + (size_t)l * D * D + nb * 32 + nl, 1.0f, D, D, (bf16_t*)(F.ws + WS_WOUT) + (size_t)l * D * D, nb * 32, kb * 64, scr, lane); continue; }
        r -= 2 * I_OUT;
        if (r < I_GU) { const int nblk = 2 * FF / 32, kb = r / nblk, nb = r % nblk; const float* src = (nl < 16 ? F.a->in[I_FWG] : F.a->in[I_FWU]) + nb * 16 + (nl & 15);
            transpose_item(src, 1.0f, FF, D, (bf16_t*)(F.ws + WS_WGU), nb * 32, kb * 64, scr, lane); continue; }
        r -= I_GU;
        if (r < I_DN) { const int kb = r / 32, nb = r % 32;
            transpose_item(F.a->in[I_FWD] + nb * 32 + nl, 1.0f, D, FF, (bf16_t*)(F.ws + WS_WD), nb * 32, kb * 64, scr, lane); continue; }
        r -= I_DN;
        if (r < NE * I_MGU) { const int e = r / I_MGU; r %= I_MGU; const int nblk = 2 * FE / 32, kb = r / nblk, nb = r % nblk;
            const float* src = (nl < 16 ? F.a->in[I_MWG] : F.a->in[I_MWU]) + (size_t)e * D * FE + nb * 16 + (nl & 15);
            transpose_item(src, 1.0f, FE, D, (bf16_t*)(F.ws + WS_MOE_GU) + (size_t)e * 2 * FE * D, nb * 32, kb * 64, scr, lane); continue; }
        r -= NE * I_MGU;
        { const int e = r / I_MDN; r %= I_MDN; const int kb = r / 32, nb = r % 32;
            transpose_item(F.a->in[I_MWD] + (size_t)e * FE * D + nb * 32 + nl, 1.0f, D, FE, (bf16_t*)(F.ws + WS_MOE_D) + (size_t)e * D * FE, nb * 32, kb * 64, scr, lane); }
    }
}

struct RowCfg {
    const float* xlat; const float* xctx;
    float* olat; float* octx;
    const bf16_t* Y;
    const float* wpost; int lg, gi;
    const float* wpre; int lm, si;
    int xib, xob;
};
__device__ __forceinline__ const float* modv_row(Frame& F, int layer, int row) { const int r = row < NLAT ? (row >> 12) : 4; return (const float*)(F.ws + WS_SMALL + SM_MODV) + (size_t)(layer * 5 + r) * 6144; }
__device__ __forceinline__ void load_bf16_row(const bf16_t* p, int lane, f32x4 (&v)[4]) {
#pragma unroll
    for (int j = 0; j < 4; ++j) { const u32x2 w = *(const GAS u32x2*)(p + 4 * lane + 256 * j); v[j] = (f32x4){bf_lo(w.x), bf_hi(w.x), bf_lo(w.y), bf_hi(w.y)}; }
}
__device__ __forceinline__ float sumsq4(const f32x4 (&v)[4]) { float s = 0.f;
#pragma unroll
    for (int j = 0; j < 4; ++j) s += (v[j].x * v[j].x + v[j].y * v[j].y) + (v[j].z * v[j].z + v[j].w * v[j].w);
    return s; }
struct RowRegs { f32x4 wpost[4], wpre[4], g[4], sh[4], sc[4]; int rb; };
template <bool HAS_Y, bool WRITE_HN>
__device__ __forceinline__ void row_regs_init(const RowCfg& c, int lane, RowRegs& R) { R.rb = -1;
#pragma unroll
    for (int j = 0; j < 4; ++j) { if (HAS_Y) R.wpost[j] = *(const GAS f32x4*)(c.wpost + 4 * lane + 256 * j); if (WRITE_HN) R.wpre[j] = *(const GAS f32x4*)(c.wpre + 4 * lane + 256 * j); } }
template <bool HAS_Y, bool WRITE_X, bool WRITE_HN>
__device__ __forceinline__ void row_core(Frame& F, const RowCfg& c, int row, int lane, f32x4 (&yv)[4], f32x4 (&hv)[4], RowRegs& R) {
    { const int r = row < NLAT ? (row >> 12) : 4;
        if (r != R.rb) { R.rb = r;
            if (HAS_Y) { const float* gate = modv_row(F, c.lg, row) + c.gi * 1024;
#pragma unroll
                for (int j = 0; j < 4; ++j) R.g[j] = *(const GAS f32x4*)(gate + 4 * lane + 256 * j); }
            if (WRITE_HN) { const float* mv = modv_row(F, c.lm, row); const float* shift = mv + c.si * 1024; const float* scale = mv + (c.si + 1) * 1024;
#pragma unroll
                for (int j = 0; j < 4; ++j) { R.sh[j] = *(const GAS f32x4*)(shift + 4 * lane + 256 * j); R.sc[j] = *(const GAS f32x4*)(scale + 4 * lane + 256 * j); } } } }
    f32x4 xv[4];
    if (row < NLAT && c.xib) load_bf16_row((const bf16_t*)(c.xlat + (size_t)row * D) + D, lane, xv);
    else { const float* xs = row < NLAT ? c.xlat + (size_t)row * D : c.xctx + (size_t)(row - NLAT) * D;
#pragma unroll
        for (int j = 0; j < 4; ++j) xv[j] = *(const GAS f32x4*)(xs + 4 * lane + 256 * j); }
    if (HAS_Y) {
        const float ry = 1.0f / sqrtf(wave_sum(sumsq4(yv)) * (1.0f / D) + EPS);
#pragma unroll
        for (int j = 0; j < 4; ++j) xv[j] = xv[j] + R.g[j] * (yv[j] * ry * R.wpost[j]);
    }
    if (WRITE_X) {
        if (row < NLAT && c.xob) { bf16_t* xb = (bf16_t*)(c.olat + (size_t)row * D) + D;
#pragma unroll
            for (int j = 0; j < 4; ++j) { u32x2 o; o.x = cvt_pk_bf16(xv[j].x, xv[j].y); o.y = cvt_pk_bf16(xv[j].z, xv[j].w); *(GAS u32x2*)(xb + 4 * lane + 256 * j) = o; } }
        else { float* xd = row < NLAT ? c.olat + (size_t)row * D : c.octx + (size_t)(row - NLAT) * D;
#pragma unroll
            for (int j = 0; j < 4; ++j) *(GAS f32x4*)(xd + 4 * lane + 256 * j) = xv[j]; } }
    if (WRITE_HN) {
        const float rx = 1.0f / sqrtf(wave_sum(sumsq4(xv)) * (1.0f / D) + EPS);
        bf16_t* hn = (bf16_t*)(F.ws + WS_HN) + (size_t)row * D;
#pragma unroll
        for (int j = 0; j < 4; ++j) { hv[j] = (xv[j] * rx * R.wpre[j]) * (1.0f + R.sc[j]) + R.sh[j];
            u32x2 o; o.x = cvt_pk_bf16(hv[j].x, hv[j].y); o.y = cvt_pk_bf16(hv[j].z, hv[j].w); *(GAS u32x2*)(hn + 4 * lane + 256 * j) = o; }
    }
}
template <bool HAS_Y, bool WRITE_X, bool WRITE_HN, bool GATES>
__device__ __forceinline__ void row_phase(Frame& F, const RowCfg& c, int nrows) {
    PHASE_TID();
    LAS float* wgT = (LAS float*)F.lds;
    if (GATES) { const float* wg = F.a->in[I_WIN] + (size_t)c.lm * D * WIN_LD + 1024;
        for (int idx = tid; idx < 16 * D; idx += NTHR) { const int k = idx >> 4, i = idx & 15; wgT[i * D + k] = wg[(size_t)k * WIN_LD + i]; }
        __syncthreads(); }
    const int gw = F.bid * NWAVES + wave, NGW = F.G * NWAVES;
    RowRegs R; row_regs_init<HAS_Y, WRITE_HN>(c, lane, R);
    for (int row = gw; row < nrows; row += NGW) {
        f32x4 yv[4], hv[4];
        if (HAS_Y) load_bf16_row(c.Y + (size_t)row * D, lane, yv);
        row_core<HAS_Y, WRITE_X, WRITE_HN>(F, c, row, lane, yv, hv, R);
        if (GATES) { float* G = (float*)(F.ws + WS_GATES) + (size_t)row * 16; float mine = 0.f;
#pragma unroll
            for (int i = 0; i < 16; ++i) { float s = 0.f;
#pragma unroll
                for (int j = 0; j < 4; ++j) { const f32x4 w = *(const LAS f32x4*)(wgT + i * D + 4 * lane + 256 * j); s += (hv[j].x * w.x + hv[j].y * w.y) + (hv[j].z * w.z + hv[j].w * w.w); }
                s = wave_sum(s); if (lane == i) mine = s; }
            if (lane < 16) G[lane] = mine; }
    }
    if (GATES) __syncthreads();
}
__device__ __forceinline__ void route_phase(Frame& F, const RowCfg& c) {
    PHASE_TID();
    LAS float* wrT = (LAS float*)F.lds;
    LAS unsigned* lcnt = (LAS unsigned*)(F.lds + 32768);
    LAS unsigned* rec = (LAS unsigned*)(F.lds + 32768 + 256);
    for (int idx = tid; idx < 8 * D; idx += NTHR) { const int k = idx >> 3, e = idx & 7; wrT[e * D + k] = F.a->in[I_RW][(size_t)k * 8 + e]; }
    unsigned* cntw = F.ctl + CW_CNT; unsigned* lists = F.ctl + CW_LIST; unsigned* route = (unsigned*)(F.ws + WS_ROUTE);
    RowRegs R; row_regs_init<true, true>(c, lane, R);
    for (int blk = F.bid; blk < NLAT / 64; blk += F.G) {
        if (tid < 16) lcnt[tid] = 0u;
        __syncthreads();
        for (int q = 0; q < 8; ++q) { const int tl = wave * 8 + q, row = blk * 64 + tl;
            f32x4 yv[4], hv[4]; load_bf16_row(c.Y + (size_t)row * D, lane, yv);
            row_core<true, true, true>(F, c, row, lane, yv, hv, R);
            float lg[8];
#pragma unroll
            for (int e = 0; e < 8; ++e) { float s = 0.f;
#pragma unroll
                for (int j = 0; j < 4; ++j) { const f32x4 w = *(const LAS f32x4*)(wrT + e * D + 4 * lane + 256 * j); s += (hv[j].x * w.x + hv[j].y * w.y) + (hv[j].z * w.z + hv[j].w * w.w); }
                lg[e] = wave_sum(s) + F.a->in[I_RB][e]; }
            int e1 = 0; float v1 = lg[0];
#pragma unroll
            for (int e = 1; e < 8; ++e) if (lg[e] > v1) { v1 = lg[e]; e1 = e; }
            int e2 = (e1 + 1) & 7; float v2 = -3.0e38f;
#pragma unroll
            for (int e = 0; e < 8; ++e) if (e != e1 && lg[e] > v2) { v2 = lg[e]; e2 = e; }
            const float ex = __expf(v2 - v1), g1 = 1.0f / (1.0f + ex), g2 = ex * g1;
            if (lane == 0) { const unsigned p1 = __hip_atomic_fetch_add(&lcnt[e1], 1u, __ATOMIC_RELAXED, __HIP_MEMORY_SCOPE_WORKGROUP), p2 = __hip_atomic_fetch_add(&lcnt[e2], 1u, __ATOMIC_RELAXED, __HIP_MEMORY_SCOPE_WORKGROUP);
                rec[tl * 6 + 0] = (unsigned)e1; rec[tl * 6 + 1] = (unsigned)e2; rec[tl * 6 + 2] = p1; rec[tl * 6 + 3] = p2; rec[tl * 6 + 4] = __float_as_uint(g1); rec[tl * 6 + 5] = __float_as_uint(g2); }
        }
        __syncthreads();
        if (tid < 8) lcnt[8 + tid] = __hip_atomic_fetch_add(cntw + 64 * tid, lcnt[tid], RLX_AGENT);
        __syncthreads();
        if (tid < 64) { const int tok = blk * 64 + tid; const unsigned e1 = rec[tid * 6 + 0], e2 = rec[tid * 6 + 1];
            const unsigned p1 = lcnt[8 + e1] + rec[tid * 6 + 2], p2 = lcnt[8 + e2] + rec[tid * 6 + 3];
            lists[(size_t)e1 * NLAT + p1] = (unsigned)tok; lists[(size_t)e2 * NLAT + p2] = (unsigned)tok;
            u32x4 r0 = {e1, p1, rec[tid * 6 + 4], 0u}, r1 = {e2, p2, rec[tid * 6 + 5], 0u};
            *(u32x4*)(route + (size_t)tok * 8) = r0; *(u32x4*)(route + (size_t)tok * 8 + 4) = r1; }
        __syncthreads();
    }
}
__device__ __forceinline__ void final_phase(Frame& F, const RowCfg& c) {
    PHASE_TID();
    const unsigned* cntw = F.ctl + CW_CNT; int tb[8]; { int acc = 0;
#pragma unroll
        for (int e = 0; e < 8; ++e) { const int ce = (int)__hip_atomic_load(cntw + 64 * e, RLX_AGENT); tb[e] = acc | ((ce >> 8) << 16); acc += (ce + 255) >> 8; } }
    const bf16_t* SIDE = (const bf16_t*)(F.ws + WS_MOE_SIDE);
    const unsigned* route = (const unsigned*)(F.ws + WS_ROUTE); const bf16_t* YM = (const bf16_t*)(F.ws + WS_MOE_GU);
    const int gw = F.bid * NWAVES + wave, NGW = F.G * NWAVES;
    RowRegs R; row_regs_init<true, false>(c, lane, R);
    for (int row = gw; row < NLAT; row += NGW) {
        const u32x4 r0 = *(const GAS u32x4*)(route + (size_t)row * 8), r1 = *(const GAS u32x4*)(route + (size_t)row * 8 + 4);
        int t1 = 0, t2 = 0;
#pragma unroll
        for (int e = 0; e < 8; ++e) { if ((int)r0.x == e) t1 = tb[e]; if ((int)r1.x == e) t2 = tb[e]; }
        const size_t s1 = (size_t)(t1 & 0xffff) * 256 + r0.y, s2 = (size_t)(t2 & 0xffff) * 256 + r1.y; const float g1 = __uint_as_float(r0.z), g2 = __uint_as_float(r1.z);
        const int p1 = (int)r0.y - (t1 >> 16) * 256, p2 = (int)r1.y - (t2 >> 16) * 256;
        f32x4 ya[4], yb[4], yv[4], hv[4];
        if (p1 < 0) load_bf16_row(YM + s1 * D, lane, ya);
        else { load_bf16_row(SIDE + ((size_t)r0.x * 256 + p1) * D, lane, ya);
            for (int ks = 1; ks < pg8::KSL; ++ks) { f32x4 t[4]; load_bf16_row(SIDE + ((size_t)(ks * 8 + (int)r0.x) * 256 + p1) * D, lane, t);
#pragma unroll
                for (int j = 0; j < 4; ++j) ya[j] += t[j]; } }
        if (p2 < 0) load_bf16_row(YM + s2 * D, lane, yb);
        else { load_bf16_row(SIDE + ((size_t)r1.x * 256 + p2) * D, lane, yb);
            for (int ks = 1; ks < pg8::KSL; ++ks) { f32x4 t[4]; load_bf16_row(SIDE + ((size_t)(ks * 8 + (int)r1.x) * 256 + p2) * D, lane, t);
#pragma unroll
                for (int j = 0; j < 4; ++j) yb[j] += t[j]; } }
#pragma unroll
        for (int j = 0; j < 4; ++j) yv[j] = ya[j] * g1 + yb[j] * g2;
        row_core<true, true, false>(F, c, row, lane, yv, hv, R);
    }
}

__device__ __forceinline__ int seq_row(int b, int dir, int n) {
    if (n < CTXL) { const int j = dir ? (CTXL - 1 - n) : n; return NLAT + b * CTXL + j; }
    const int l = dir ? (SEQ - 1 - (n - CTXL)) : (n - CTXL); return b * SEQ + l;
}
constexpr int LCH = 68, NCH = 64, NSEQ = 64, NUNIT = NSEQ * NCH;
constexpr size_t WS_DC = WS_Y;
constexpr size_t WS_C0 = WS_HN;
constexpr size_t WS_DN = WS_Y + 32 * MiB;
constexpr size_t WS_N0 = WS_Y + 33 * MiB;
constexpr size_t SM_SCAL = 512 * 1024;
template <int MODE>
__device__ __forceinline__ void mix_rec_phase(Frame& F, int layer, bool need_ctx) {
    PHASE_TID();
    const bf16_t* P = (const bf16_t*)(F.ws + WS_P); const float* GT = (const float*)(F.ws + WS_GATES); float* SCR = (float*)(F.ws + WS_SCR);
    bf16_t* DC = (bf16_t*)(F.ws + WS_DC); const bf16_t* C0 = (const bf16_t*)(F.ws + WS_C0); float* DN = (float*)(F.ws + WS_DN); const float* N0 = (const float*)(F.ws + WS_N0);
    float* SCAL = (float*)(F.ws + WS_SMALL + SM_SCAL);
    LAS float* tq = (LAS float*)(F.lds + wave * 13312); LAS float* tk = tq + 17 * 64; LAS float* tv = tk + 17 * 64; LAS float* tg = tv + 17 * 64;
    const int dblk = lane >> 3, eblk = lane & 7;
    const int gw = F.bid * NWAVES + wave, NGW = F.G * NWAVES;
    for (int unit = NUNIT / 2 + gw; unit < NUNIT; unit += NGW) {
        const int sq = unit >> 6, j = unit & 63, kind = sq >> 5, b = (sq >> 3) & 3, h = (sq >> 1) & 3, dir = sq & 1;
        float C[8][8], n8[8];
        float mrun = (MODE == 0) ? -1e30f : 0.f, bsum = 0.f;
        if (MODE == 0) {
#pragma unroll
            for (int i = 0; i < 8; ++i) { n8[i] = (kind == 0) ? 0.f : 1.f;
#pragma unroll
                for (int jj = 0; jj < 8; ++jj) C[i][jj] = 0.f; }
        } else {
            const bf16_t* c0 = C0 + (size_t)unit * 4096 + (8 * dblk) * 64 + 8 * eblk;
#pragma unroll
            for (int i = 0; i < 8; ++i) { const u32x4 w = *(const GAS u32x4*)(c0 + i * 64);
                C[i][0] = bf_lo(w.x); C[i][1] = bf_hi(w.x); C[i][2] = bf_lo(w.y); C[i][3] = bf_hi(w.y); C[i][4] = bf_lo(w.z); C[i][5] = bf_hi(w.z); C[i][6] = bf_lo(w.w); C[i][7] = bf_hi(w.w);
                n8[i] = N0[(size_t)unit * 64 + 8 * dblk + i]; }
            mrun = SCAL[2 * 4096 + unit];
        }
        float* outp = SCR + (size_t)(kind * 2 + dir) * ROWS * 256 + h * 64 + 8 * eblk + dblk;
        const float gb_i = F.a->in[I_MLGB][layer * 16 + (2 * dir) * 4 + h], gb_f = F.a->in[I_MLGB][layer * 16 + (2 * dir + 1) * 4 + h];
        const float lb = ((const float*)(F.ws + WS_SMALL + SM_LB))[layer * 256 + h * 64 + lane];
        for (int n0 = 0; n0 < LCH; n0 += 17) {
            const int nb = j * LCH + n0;
            if (kind == 0) {
#pragma unroll
                for (int tt = 0; tt < 17; ++tt) { const bf16_t* pr = P + (size_t)seq_row(b, dir, nb + tt) * PW + h * 64 + lane;
                    tq[tt * 64 + lane] = bf2f(pr[ML_Q]); tk[tt * 64 + lane] = bf2f(pr[ML_K]); tv[tt * 64 + lane] = bf2f(pr[ML_V]); }
                if (lane < 17) { const float* g = GT + (size_t)seq_row(b, dir, nb + lane) * 16; tg[lane] = g[(2 * dir) * 4 + h] + gb_i; tg[17 + lane] = log_sigmoidf_(g[(2 * dir + 1) * 4 + h] + gb_f); }
            } else {
#pragma unroll
                for (int tt = 0; tt < 17; ++tt) { const bf16_t* pr = P + (size_t)seq_row(b, dir, nb + tt) * PW + h * 64 + lane;
                    const float sg = sigmoidf_(bf2f(pr[HG_F + dir * 256]));
                    tq[tt * 64 + lane] = siluf_(bf2f(pr[HG_Q])); tk[tt * 64 + lane] = fmaxf(lb, 1e-30f) + (1.0f - lb) * sg; tv[tt * 64 + lane] = bf2f(pr[HG_I]); }
            }
            LDS_WAIT(); asm volatile("" ::: "memory");
            for (int tt = 0; tt < 17; ++tt) {
                const f32x4 ka = *(const LAS f32x4*)(tk + tt * 64 + 8 * dblk), kb = *(const LAS f32x4*)(tk + tt * 64 + 8 * dblk + 4);
                const f32x4 va = *(const LAS f32x4*)(tv + tt * 64 + 8 * eblk), vb = *(const LAS f32x4*)(tv + tt * 64 + 8 * eblk + 4);
                const float k8[8] = {ka.x, ka.y, ka.z, ka.w, kb.x, kb.y, kb.z, kb.w}, v8[8] = {va.x, va.y, va.z, va.w, vb.x, vb.y, vb.z, vb.w};
                float q8[8];
                if (MODE == 2) { const f32x4 qa = *(const LAS f32x4*)(tq + tt * 64 + 8 * dblk), qb = *(const LAS f32x4*)(tq + tt * 64 + 8 * dblk + 4);
                    q8[0] = qa.x; q8[1] = qa.y; q8[2] = qa.z; q8[3] = qa.w; q8[4] = qb.x; q8[5] = qb.y; q8[6] = qb.z; q8[7] = qb.w; }
                float po[8], dpart = 0.f, floorv = 0.f;
#pragma unroll
                for (int jj = 0; jj < 8; ++jj) po[jj] = 0.f;
                if (kind == 0) {
                    const float li = tg[tt], lf = tg[17 + tt];
                    const float mnew = fmaxf(lf + mrun, li); const float fs = __expf(lf + mrun - mnew), is = __expf(li - mnew); mrun = mnew; bsum += lf;
#pragma unroll
                    for (int i = 0; i < 8; ++i) { const float ik = is * k8[i]; n8[i] = fs * n8[i] + ik;
#pragma unroll
                        for (int jj = 0; jj < 8; ++jj) { C[i][jj] = fs * C[i][jj] + ik * v8[jj]; if (MODE == 2) po[jj] += q8[i] * C[i][jj]; }
                        if (MODE == 2) dpart += q8[i] * n8[i]; }
                    if (MODE == 2) floorv = __expf(-mnew);
                } else {
#pragma unroll
                    for (int i = 0; i < 8; ++i) { const float f = k8[i], kk = 1.0f - f; n8[i] *= f;
#pragma unroll
                        for (int jj = 0; jj < 8; ++jj) { C[i][jj] = f * C[i][jj] + kk * v8[jj]; if (MODE == 2) po[jj] += q8[i] * C[i][jj]; } }
                }
                if (MODE == 2) {
                    float r4[4], r2[2], o;
                    const bool b5 = (lane & 32) != 0, b4 = (lane & 16) != 0, b3 = (lane & 8) != 0;
#pragma unroll
                    for (int x = 0; x < 4; ++x) { const float keep = b5 ? po[4 + x] : po[x], send = b5 ? po[x] : po[4 + x]; r4[x] = keep + __shfl_xor(send, 32); }
#pragma unroll
                    for (int x = 0; x < 2; ++x) { const float keep = b4 ? r4[2 + x] : r4[x], send = b4 ? r4[x] : r4[2 + x]; r2[x] = keep + __shfl_xor(send, 16); }
                    { const float keep = b3 ? r2[1] : r2[0], send = b3 ? r2[0] : r2[1]; o = keep + __shfl_xor(send, 8); }
                    if (kind == 0) { dpart += __shfl_xor(dpart, 8); dpart += __shfl_xor(dpart, 16); dpart += __shfl_xor(dpart, 32); o = o / fmaxf(fabsf(dpart), floorv); }
                    const int row = seq_row(b, dir, nb + tt);
                    if (need_ctx || row < NLAT) outp[(size_t)row * 256] = o;
                }
            }
            LDS_WAIT(); asm volatile("" ::: "memory");
        }
        if (MODE == 0) {
            bf16_t* dc = DC + (size_t)unit * 4096 + (8 * dblk) * 64 + 8 * eblk;
#pragma unroll
            for (int i = 0; i < 8; ++i) { u32x4 w; w.x = cvt_pk_bf16(C[i][0], C[i][1]); w.y = cvt_pk_bf16(C[i][2], C[i][3]); w.z = cvt_pk_bf16(C[i][4], C[i][5]); w.w = cvt_pk_bf16(C[i][6], C[i][7]); *(GAS u32x4*)(dc + i * 64) = w; }
            if (eblk == 0) {
#pragma unroll
                for (int i = 0; i < 8; ++i) DN[(size_t)unit * 64 + 8 * dblk + i] = n8[i]; }
            if (lane == 0) { SCAL[unit] = mrun; SCAL[4096 + unit] = bsum; }
        }
    }
}
__device__ __forceinline__ void mix_scan_phase(Frame& F) {
    PHASE_TID();
    const bf16_t* DC = (const bf16_t*)(F.ws + WS_DC); bf16_t* C0 = (bf16_t*)(F.ws + WS_C0); const float* DN = (const float*)(F.ws + WS_DN); float* N0 = (float*)(F.ws + WS_N0);
    float* SCAL = (float*)(F.ws + WS_SMALL + SM_SCAL);
    LAS float* sml = (LAS float*)F.lds; LAS float* sbl = sml + 64;
    for (int it = NSEQ * 2 + F.bid; it < NSEQ * 4; it += F.G) {
        const int sq = it >> 2, qtr = it & 3, kind = sq >> 5, d = 16 * qtr + (tid >> 5), e2 = (tid & 31) * 2;
        __syncthreads();
        if (tid < 64) { sml[tid] = SCAL[sq * 64 + tid]; sbl[tid] = SCAL[4096 + sq * 64 + tid]; }
        __syncthreads();
        float c0 = 0.f, c1 = 0.f, nn = 0.f, m = 0.f;
        const bf16_t* dcp = DC + (size_t)(sq * 64) * 4096 + d * 64 + e2; bf16_t* c0p = C0 + (size_t)(sq * 64) * 4096 + d * 64 + e2;
        const float* dnp = DN + (size_t)(sq * 64) * 64 + d; float* n0p = N0 + (size_t)(sq * 64) * 64 + d;
        for (int jb = 0; jb < 64; jb += 16) {
            unsigned dcv[16]; float dnv[16];
#pragma unroll
            for (int j = 0; j < 16; ++j) { dcv[j] = *(const GAS unsigned*)(dcp + (size_t)(jb + j) * 4096); dnv[j] = dnp[(size_t)(jb + j) * 64]; }
#pragma unroll
            for (int j = 0; j < 16; ++j) {
                *(GAS unsigned*)(c0p + (size_t)(jb + j) * 4096) = cvt_pk_bf16(c0, c1);
                if (kind == 0) {
                    if (e2 == 0) n0p[(size_t)(jb + j) * 64] = nn;
                    if (qtr == 0 && tid == 0) SCAL[2 * 4096 + sq * 64 + jb + j] = m;
                    const float ml = sml[jb + j], bl = sbl[jb + j]; const float mnew = fmaxf(bl + m, ml); const float so = __expf(bl + m - mnew), sn = __expf(ml - mnew); m = mnew;
                    c0 = so * c0 + sn * bf_lo(dcv[j]); c1 = so * c1 + sn * bf_hi(dcv[j]); nn = so * nn + sn * dnv[j];
                } else { const float a = dnv[j]; c0 = a * c0 + bf_lo(dcv[j]); c1 = a * c1 + bf_hi(dcv[j]); }
            }
        }
    }
}
constexpr int NC2 = 68;
constexpr size_t WS_DCM = WS_SCR;
constexpr size_t WS_C0M = WS_SCR + 34 * MiB;
constexpr size_t WS_DNM = WS_Y;
constexpr size_t WS_N0M = WS_Y + 2 * MiB;
constexpr size_t SM_SCALM = 768 * 1024;
__device__ __forceinline__ f32x16 zero16() { f32x16 v;
#pragma unroll
    for (int r = 0; r < 16; ++r) v[r] = 0.f;
    asm volatile("" : "+v"(v)); return v; }
__device__ __forceinline__ f32x16 mfma32(bf16x8 a, bf16x8 b, f32x16 c) { const f32x16 d = __builtin_amdgcn_mfma_f32_32x32x16_bf16(a, b, c, 0, 0, 0); asm volatile("" :: "v"(a), "v"(b)); return d; }
__device__ __forceinline__ f32x4 mfma16(bf16x8 a, bf16x8 b, f32x4 c) {
    asm volatile("s_nop 1\n\tv_mfma_f32_16x16x32_bf16 %0, %1, %2, %0\n\ts_nop 7\n\ts_nop 7" : "+v"(c) : "v"(a), "v"(b));
    return c; }
__device__ __forceinline__ int crow(int r, int hi) { return (r & 3) + 8 * (r >> 2) + 4 * hi; }
__device__ __forceinline__ float wave_prefix_sum(float x, int lane) {
#pragma unroll
    for (int o = 1; o < 64; o <<= 1) { const float y = __shfl_up(x, o); if (lane >= o) x += y; }
    return x; }
__device__ __forceinline__ float wave_suffix_sum(float x, int lane) {
#pragma unroll
    for (int o = 1; o < 64; o <<= 1) { const float y = __shfl_down(x, o); if (lane + o < 64) x += y; }
    return x; }
__device__ __forceinline__ float wave_prefix_max(float x, int lane) {
#pragma unroll
    for (int o = 1; o < 64; o <<= 1) { const float y = __shfl_up(x, o); if (lane >= o) x = fmaxf(x, y); }
    return x; }
__device__ __forceinline__ float wave_suffix_max(float x, int lane) {
#pragma unroll
    for (int o = 1; o < 64; o <<= 1) { const float y = __shfl_down(x, o); if (lane + o < 64) x = fmaxf(x, y); }
    return x; }
__device__ __forceinline__ float wave_max(float v) {
#pragma unroll
    for (int o = 1; o < 64; o <<= 1) v = fmaxf(v, __shfl_xor(v, o));
    return v; }
__device__ __forceinline__ bf16x8 tr_frag(const LAS unsigned char* p) {
    const s16x4 lo = __builtin_bit_cast(s16x4, __builtin_amdgcn_ds_read_tr16_b64_v4i16((LAS s16x4*)(p)));
    const s16x4 hh = __builtin_bit_cast(s16x4, __builtin_amdgcn_ds_read_tr16_b64_v4i16((LAS s16x4*)(p + 512)));
    return (bf16x8){lo[0], lo[1], lo[2], lo[3], hh[0], hh[1], hh[2], hh[3]}; }
__device__ __forceinline__ u32x4 scale_bf16x8(u32x4 w, float sc) { u32x4 o; o.x = cvt_pk_bf16(bf_lo(w.x) * sc, bf_hi(w.x) * sc); o.y = cvt_pk_bf16(bf_lo(w.y) * sc, bf_hi(w.y) * sc); o.z = cvt_pk_bf16(bf_lo(w.z) * sc, bf_hi(w.z) * sc); o.w = cvt_pk_bf16(bf_lo(w.w) * sc, bf_hi(w.w) * sc); return o; }
__device__ __forceinline__ void ml_unit(int unit, int& b, int& h, int& c, int& row0, int& jf, int& jb) {
    const int bh = unit / NC2; c = unit - bh * NC2; b = bh >> 2; h = bh & 3;
    row0 = c < 4 ? NLAT + b * CTXL + 64 * c : b * SEQ + 64 * (c - 4); jf = c; jb = c < 4 ? 3 - c : 71 - c; }
__device__ __forceinline__ void mlstm_a_phase(Frame& F, int layer) {
    PHASE_TID();
    const bf16_t* P = (const bf16_t*)(F.ws + WS_P); const float* GT = (const float*)(F.ws + WS_GATES);
    bf16_t* DCM = (bf16_t*)(F.ws + WS_DCM); float* DNM = (float*)(F.ws + WS_DNM); float* SC = (float*)(F.ws + WS_SMALL + SM_SCALM);
    LAS unsigned char* Vimg = F.lds; LAS unsigned char* Kimg = F.lds + 8192; LAS float* wv = (LAS float*)(F.lds + 24576);
    const int r32 = lane & 31, hi = lane >> 5;
    const int vrd = ((lane >> 4) & 1) * 32 + (lane & 3) * 8 + (4 * hi + ((lane & 15) >> 2)) * 64;
    const int ps = tid >> 3, pc = tid & 7, pst = (pc >> 2) * 4096 + ps * 64 + (pc & 3) * 16;
    const bf16x8 ones = {0x3F80, 0x3F80, 0x3F80, 0x3F80, 0x3F80, 0x3F80, 0x3F80, 0x3F80};
    for (int unit = F.bid; unit < 16 * NC2; unit += F.G) {
        int b, h, c, row0, jf, jb; ml_unit(unit, b, h, c, row0, jf, jb);
        __syncthreads();
        const u32x4 kraw = *(const GAS u32x4*)(P + (size_t)(row0 + ps) * PW + ML_K + h * 64 + pc * 8);
        *(LAS u32x4*)(Vimg + pst) = *(const GAS u32x4*)(P + (size_t)(row0 + ps) * PW + ML_V + h * 64 + pc * 8);
        if (wave < 2) { const int dir = wave; const float* g = GT + (size_t)(row0 + lane) * 16;
            const float li = g[(2 * dir) * 4 + h] + F.a->in[I_MLGB][layer * 16 + (2 * dir) * 4 + h], lf = log_sigmoidf_(g[(2 * dir + 1) * 4 + h] + F.a->in[I_MLGB][layer * 16 + (2 * dir + 1) * 4 + h]);
            const float bt = dir == 0 ? wave_prefix_sum(lf, lane) : wave_suffix_sum(lf, lane);
            const float btot = __shfl(bt, dir == 0 ? 63 : 0);
            const float a = btot - bt + li; const float mloc = wave_max(a);
            wv[dir * 64 + lane] = __expf(a - mloc);
            if (lane == 0) { const int si = ((b * 4 + h) * 2 + dir) * NC2 + (dir == 0 ? jf : jb); SC[si] = mloc; SC[32 * NC2 + si] = btot; } }
        __syncthreads();
        *(LAS u32x4*)(Kimg + pst) = scale_bf16x8(kraw, wv[ps]); *(LAS u32x4*)(Kimg + 8192 + pst) = scale_bf16x8(kraw, wv[64 + ps]);
        __syncthreads();
        { const int dir = wave >> 2, eblk = (wave >> 1) & 1, dblk = wave & 1;
            f32x16 acc = zero16(), dn = zero16();
#pragma unroll
            for (int ks = 0; ks < 4; ++ks) { const bf16x8 va = tr_frag(Vimg + eblk * 4096 + ks * 1024 + vrd), kb = tr_frag(Kimg + dir * 8192 + dblk * 4096 + ks * 1024 + vrd);
                acc = mfma32(va, kb, acc); if (eblk == 0) dn = mfma32(ones, kb, dn); }
            const size_t si = (size_t)((b * 4 + h) * 2 + dir) * NC2 + (dir == 0 ? jf : jb);
            bf16_t* dst = DCM + si * 4096 + (32 * eblk) * 64 + 32 * dblk + r32;
#pragma unroll
            for (int r = 0; r < 16; ++r) dst[crow(r, hi) * 64] = (bf16_t)(cvt_pk_bf16(acc[r], 0.f) & 0xffffu);
            if (eblk == 0 && hi == 0) DNM[si * 64 + 32 * dblk + r32] = dn[0];
        }
    }
}
__device__ __forceinline__ void mix_scan2_phase(Frame& F) {
    PHASE_TID();
    const bf16_t* DCM = (const bf16_t*)(F.ws + WS_DCM); bf16_t* C0M = (bf16_t*)(F.ws + WS_C0M); const float* DNM = (const float*)(F.ws + WS_DNM); float* N0M = (float*)(F.ws + WS_N0M);
    float* SC = (float*)(F.ws + WS_SMALL + SM_SCALM);
    LAS float* sml = (LAS float*)(F.lds + 120 * 1024); LAS float* sbl = sml + NC2;
    for (int it = F.bid; it < 64 * 4; it += F.G) {
        const int sq = it >> 2, qtr = it & 3, kind = sq >> 5, e = 16 * qtr + (tid >> 5), d2 = (tid & 31) * 2;
        __syncthreads();
        if (kind == 0 && tid < NC2) { sml[tid] = SC[sq * NC2 + tid]; sbl[tid] = SC[32 * NC2 + sq * NC2 + tid]; }
        __syncthreads();
        float c0 = 0.f, c1 = 0.f, n0 = 0.f, n1 = 0.f, m = 0.f;
        const bf16_t* dcp = DCM + (size_t)(sq * NC2) * 4096 + e * 64 + d2; bf16_t* c0p = C0M + (size_t)(sq * NC2) * 4096 + e * 64 + d2;
        const float* dnp = DNM + (size_t)(sq * NC2) * 64 + d2; float* n0p = N0M + (size_t)(sq * NC2) * 64 + d2;
        const bool nrow = (kind == 0) && (qtr == 0) && ((tid >> 5) == 0);
#define SCAN_LOAD(DC, DN, jb) do { _Pragma("unroll") for (int j = 0; j < 17; ++j) { DC[j] = *(const GAS unsigned*)(dcp + (size_t)((jb) + j) * 4096); DN[j] = (nrow || kind == 1) ? *(const GAS f32x2*)(dnp + (size_t)((jb) + j) * 64) : (f32x2){0.f, 0.f}; } } while (0)
#define SCAN_STEP(DC, DN, jb) do { _Pragma("unroll") for (int j = 0; j < 17; ++j) { \
                *(GAS unsigned*)(c0p + (size_t)((jb) + j) * 4096) = cvt_pk_bf16(c0, c1); \
                if (kind == 0) { \
                    if (nrow) { *(GAS f32x2*)(n0p + (size_t)((jb) + j) * 64) = (f32x2){n0, n1}; if (tid == 0) SC[64 * NC2 + sq * NC2 + (jb) + j] = m; } \
                    const float ml = sml[(jb) + j], bl = sbl[(jb) + j]; const float mnew = fmaxf(bl + m, ml); const float so = __expf(bl + m - mnew), sn = __expf(ml - mnew); m = mnew; \
                    c0 = so * c0 + sn * bf_lo(DC[j]); c1 = so * c1 + sn * bf_hi(DC[j]); n0 = so * n0 + sn * DN[j].x; n1 = so * n1 + sn * DN[j].y; \
                } else { c0 = DN[j].x * c0 + bf_lo(DC[j]); c1 = DN[j].y * c1 + bf_hi(DC[j]); } } } while (0)
        { unsigned dca[17], dcb[17]; f32x2 dna[17], dnb[17];
            SCAN_LOAD(dca, dna, 0); SCAN_LOAD(dcb, dnb, 17); SCAN_STEP(dca, dna, 0);
            SCAN_LOAD(dca, dna, 34); SCAN_STEP(dcb, dnb, 17);
            SCAN_LOAD(dcb, dnb, 51); SCAN_STEP(dca, dna, 34);
            SCAN_STEP(dcb, dnb, 51); }
#undef SCAN_LOAD
#undef SCAN_STEP
    }
}
__device__ __forceinline__ void mlstm_c_phase(Frame& F, int layer, bool need_ctx) {
    PHASE_TID();
    const bf16_t* P = (const bf16_t*)(F.ws + WS_P); const float* GT = (const float*)(F.ws + WS_GATES); bf16_t* MIX = (bf16_t*)(F.ws + WS_MIX);
    const bf16_t* C0M = (const bf16_t*)(F.ws + WS_C0M); const float* N0M = (const float*)(F.ws + WS_N0M); const float* SC = (const float*)(F.ws + WS_SMALL + SM_SCALM);
    LAS unsigned char* Qimg = F.lds; LAS unsigned char* Kimg = F.lds + 8192; LAS unsigned char* Vimg = F.lds + 16384;
    LAS float* vec = (LAS float*)(F.lds + 24576);
    LAS float* Hx = (LAS float*)(F.lds + 26624);
    const int r32 = lane & 31, hi = lane >> 5;
    const int vrd = ((lane >> 4) & 1) * 32 + (lane & 3) * 8 + (4 * hi + ((lane & 15) >> 2)) * 64;
    const int ps = tid >> 3, pc = tid & 7, pst = (pc >> 2) * 4096 + ps * 64 + (pc & 3) * 16, prm = ps * 128 + ((pc ^ ((ps >> 1) & 7)) << 4);
    const bf16x8 ones = {0x3F80, 0x3F80, 0x3F80, 0x3F80, 0x3F80, 0x3F80, 0x3F80, 0x3F80};
    const int nunit = need_ctx ? 16 * NC2 : 16 * 64;
    const int vb = F.G == 256 ? ((F.bid + 192) & 255) : F.bid;
    u32x4 rq, rk, rv, ro;
#define ML_LOAD(uu) do { const int un_ = need_ctx ? (uu) : ((uu) >> 6) * NC2 + 4 + ((uu) & 63); int b_, h_, c_, r_, j_, k_; ml_unit(un_, b_, h_, c_, r_, j_, k_); \
        const bf16_t* pr_ = P + (size_t)(r_ + ps) * PW + h_ * 64 + pc * 8; rq = *(const GAS u32x4*)(pr_ + ML_Q); rk = *(const GAS u32x4*)(pr_ + ML_K); rv = *(const GAS u32x4*)(pr_ + ML_V); ro = *(const GAS u32x4*)(pr_ + ML_O); } while (0)
    if (vb < nunit) ML_LOAD(vb);
    for (int u0 = vb; u0 < nunit; u0 += F.G) {
        const int unit = need_ctx ? u0 : (u0 >> 6) * NC2 + 4 + (u0 & 63);
        int b, h, c, row0, jf, jb; ml_unit(unit, b, h, c, row0, jf, jb);
        __syncthreads();
        *(LAS u32x4*)(Qimg + prm) = rq; *(LAS u32x4*)(Kimg + prm) = rk; *(LAS u32x4*)(Vimg + pst) = rv; const u32x4 ow = ro;
        if (u0 + F.G < nunit) ML_LOAD(u0 + F.G);
        if (wave < 2) { const int dir = wave; const float* g = GT + (size_t)(row0 + lane) * 16;
            const float li = g[(2 * dir) * 4 + h] + F.a->in[I_MLGB][layer * 16 + (2 * dir) * 4 + h], lf = log_sigmoidf_(g[(2 * dir + 1) * 4 + h] + F.a->in[I_MLGB][layer * 16 + (2 * dir + 1) * 4 + h]);
            const float m0 = SC[64 * NC2 + ((b * 4 + h) * 2 + dir) * NC2 + (dir == 0 ? jf : jb)];
            const float bt = dir == 0 ? wave_prefix_sum(lf, lane) : wave_suffix_sum(lf, lane);
            const float cv = li - bt; const float pm = dir == 0 ? wave_prefix_max(cv, lane) : wave_suffix_max(cv, lane);
            const float gv = fmaxf(m0, pm);
            LAS float* vd = vec + dir * 256; vd[lane] = cv; vd[64 + lane] = gv; vd[128 + lane] = __expf(m0 - gv); vd[192 + lane] = __expf(-(bt + gv)); }
        __syncthreads();
        { const int dir = wave >> 2, tblk = (wave >> 1) & 1, eblk = wave & 1;
            const LAS float* vd = vec + dir * 256;
            const int tl = 32 * tblk + r32; const float g_t = vd[64 + tl];
            bf16x8 qf[4];
#pragma unroll
            for (int ks = 0; ks < 4; ++ks) qf[ks] = *(const LAS bf16x8*)(Qimg + tl * 128 + (((2 * ks + hi) ^ ((tl >> 1) & 7)) << 4));
            f32x16 O = zero16(), L = zero16(), Oi = zero16(), Li = zero16();
#pragma unroll
            for (int sblk = 0; sblk < 2; ++sblk) {
                const bool valid = dir == 0 ? (sblk <= tblk) : (sblk >= tblk);
                if (valid) {
                    f32x16 S = zero16();
                    const int sl = 32 * sblk + r32;
#pragma unroll
                    for (int ks = 0; ks < 4; ++ks) { const bf16x8 ka = *(const LAS bf16x8*)(Kimg + sl * 128 + (((2 * ks + hi) ^ ((sl >> 1) & 7)) << 4)); S = mfma32(ka, qf[ks], S); }
#pragma unroll
                    for (int r = 0; r < 16; ++r) { const int s = 32 * sblk + crow(r, hi); const float w = __expf(vd[s] - g_t); const bool ok = dir == 0 ? (s <= tl) : (s >= tl); S[r] = ok ? S[r] * w : 0.f; }
                    u32x4 w0, w1;
                    w0.x = cvt_pk_bf16(S[0], S[1]); w0.y = cvt_pk_bf16(S[2], S[3]); w0.z = cvt_pk_bf16(S[4], S[5]); w0.w = cvt_pk_bf16(S[6], S[7]);
                    w1.x = cvt_pk_bf16(S[8], S[9]); w1.y = cvt_pk_bf16(S[10], S[11]); w1.z = cvt_pk_bf16(S[12], S[13]); w1.w = cvt_pk_bf16(S[14], S[15]);
                    const bf16x8 p0 = __builtin_bit_cast(bf16x8, w0), p1 = __builtin_bit_cast(bf16x8, w1);
                    const bf16x8 v0 = tr_frag(Vimg + eblk * 4096 + (2 * sblk) * 1024 + vrd), v1 = tr_frag(Vimg + eblk * 4096 + (2 * sblk + 1) * 1024 + vrd);
                    O = mfma32(p0, v0, O); O = mfma32(p1, v1, O);
                    L = mfma32(p0, ones, L); L = mfma32(p1, ones, L);
                }
            }
            { const size_t si = (size_t)((b * 4 + h) * 2 + dir) * NC2 + (dir == 0 ? jf : jb);
                const bf16_t* c0 = C0M + si * 4096 + (size_t)(32 * eblk + r32) * 64 + 8 * hi; const float* n0 = N0M + si * 64 + 8 * hi;
#pragma unroll
                for (int ks = 0; ks < 4; ++ks) { const bf16x8 cb = __builtin_bit_cast(bf16x8, *(const GAS u32x4*)(c0 + 16 * ks));
                    const f32x4 na = *(const GAS f32x4*)(n0 + 16 * ks), nb = *(const GAS f32x4*)(n0 + 16 * ks + 4);
                    u32x4 nw; nw.x = cvt_pk_bf16(na.x, na.y); nw.y = cvt_pk_bf16(na.z, na.w); nw.z = cvt_pk_bf16(nb.x, nb.y); nw.w = cvt_pk_bf16(nb.z, nb.w);
                    Oi = mfma32(qf[ks], cb, Oi); Li = mfma32(qf[ks], __builtin_bit_cast(bf16x8, nw), Li); } }
#pragma unroll
            for (int r = 0; r < 16; ++r) { const int t = 32 * tblk + crow(r, hi); const float wi = vd[128 + t], fl = vd[192 + t];
                const float num = O[r] + wi * Oi[r], den = L[r] + wi * Li[r];
                Hx[(dir * 64 + t) * 65 + 32 * eblk + r32] = num / fmaxf(fabsf(den), fl); }
        }
        __syncthreads();
        { const int t = tid >> 3, e8 = (tid & 7) * 8; float v[8]; float ss = 0.f;
#pragma unroll
            for (int i = 0; i < 8; ++i) { v[i] = Hx[t * 65 + e8 + i] + Hx[(64 + t) * 65 + e8 + i]; ss += v[i] * v[i]; }
            ss = sum8(ss);
            const float rs = 1.0f / sqrtf(ss * (1.0f / 64.0f) + EPS);
            const float og[8] = {bf_lo(ow.x), bf_hi(ow.x), bf_lo(ow.y), bf_hi(ow.y), bf_lo(ow.z), bf_hi(ow.z), bf_lo(ow.w), bf_hi(ow.w)};
            const float* nw = F.a->in[I_MLNORM] + layer * 256 + h * 64 + e8; float o[8];
#pragma unroll
            for (int i = 0; i < 8; ++i) o[i] = v[i] * rs * nw[i] * sigmoidf_(og[i]);
            u32x4 w; w.x = cvt_pk_bf16(o[0], o[1]); w.y = cvt_pk_bf16(o[2], o[3]); w.z = cvt_pk_bf16(o[4], o[5]); w.w = cvt_pk_bf16(o[6], o[7]);
            *(GAS u32x4*)(MIX + (size_t)(row0 + t) * D + h * 64 + e8) = w; }
    }
#undef ML_LOAD
    __syncthreads();
}
constexpr int HG_QR = 0, HG_VI = 8192, HG_GS = 16384, HG_KK = 49152, HG_QH = 65536, HG_KH = 81920, HG_AD = 98304, HG_LT = 106496, HG_C0 = 110592;
__device__ __forceinline__ int rm_off(int row, int ch) { return row * 128 + ((ch ^ ((row >> 1) & 7)) << 4); }
struct HgRaw { u32x4 v, q, f0, f1; };
template <bool WITH_Q>
__device__ __forceinline__ void hg_load(Frame& F, int h, int row0, int tid, HgRaw& r) {
    const bf16_t* pr = (const bf16_t*)(F.ws + WS_P) + (size_t)(row0 + (tid >> 3)) * PW + h * 64 + (tid & 7) * 8;
    r.v = *(const GAS u32x4*)(pr + HG_I); if (WITH_Q) r.q = *(const GAS u32x4*)(pr + HG_Q); r.f0 = *(const GAS u32x4*)(pr + HG_F); r.f1 = *(const GAS u32x4*)(pr + HG_F + 256);
}
template <bool WITH_Q>
__device__ __forceinline__ void hg_stage(Frame& F, int layer, int h, const HgRaw& raw, int tid) {
    const int ps = tid >> 3, pc = tid & 7;
    {
        const f32x4 lba = *(const GAS f32x4*)((const float*)(F.ws + WS_SMALL + SM_LB) + layer * 256 + h * 64 + pc * 8), lbb = *(const GAS f32x4*)((const float*)(F.ws + WS_SMALL + SM_LB) + layer * 256 + h * 64 + pc * 8 + 4);
        const float lb[8] = {lba.x, lba.y, lba.z, lba.w, lbb.x, lbb.y, lbb.z, lbb.w};
        *(LAS u32x4*)(F.lds + HG_VI + (pc >> 2) * 4096 + ps * 64 + (pc & 3) * 16) = raw.v;
        if (WITH_Q) { const u32x4 w = raw.q; u32x4 o;
            o.x = cvt_pk_bf16(siluf_(bf_lo(w.x)), siluf_(bf_hi(w.x))); o.y = cvt_pk_bf16(siluf_(bf_lo(w.y)), siluf_(bf_hi(w.y))); o.z = cvt_pk_bf16(siluf_(bf_lo(w.z)), siluf_(bf_hi(w.z))); o.w = cvt_pk_bf16(siluf_(bf_lo(w.w)), siluf_(bf_hi(w.w)));
            *(LAS u32x4*)(F.lds + HG_QR + rm_off(ps, pc)) = o; }
#pragma unroll
        for (int dir = 0; dir < 2; ++dir) { const u32x4 w = dir == 0 ? raw.f0 : raw.f1;
            const float fr[8] = {bf_lo(w.x), bf_hi(w.x), bf_lo(w.y), bf_hi(w.y), bf_lo(w.z), bf_hi(w.z), bf_lo(w.w), bf_hi(w.w)}; float g8[8], k8[8];
            float f8[8];
#pragma unroll
            for (int i = 0; i < 8; ++i) { const float sg = sigmoidf_(fr[i]); const float f = fmaxf(lb[i], 1e-30f) + (1.0f - lb[i]) * sg; f8[i] = f; g8[i] = __log2f(f);     k8[i] = (1.0f - lb[i]) * (1.0f - sg); }
            if (WITH_Q) { LAS float* fd = (LAS float*)(F.lds + HG_QH) + dir * 4096 + ps * 64 + pc * 8;
                *(LAS f32x4*)fd = (f32x4){f8[0], f8[1], f8[2], f8[3]}; *(LAS f32x4*)(fd + 4) = (f32x4){f8[4], f8[5], f8[6], f8[7]}; }
            LAS float* gs = (LAS float*)(F.lds + HG_GS) + dir * 4096 + ps * 64 + pc * 8;
            *(LAS f32x4*)gs = (f32x4){g8[0], g8[1], g8[2], g8[3]}; *(LAS f32x4*)(gs + 4) = (f32x4){g8[4], g8[5], g8[6], g8[7]};
            u32x4 o; o.x = cvt_pk_bf16(k8[0], k8[1]); o.y = cvt_pk_bf16(k8[2], k8[3]); o.z = cvt_pk_bf16(k8[4], k8[5]); o.w = cvt_pk_bf16(k8[6], k8[7]);
            *(LAS u32x4*)(F.lds + HG_KK + dir * 8192 + rm_off(ps, pc)) = o; }
    }
    __syncthreads();
    { const int dir = tid >> 8, grp = (tid >> 6) & 3, k = tid & 63; LAS float* gs = (LAS float*)(F.lds + HG_GS) + dir * 4096 + k; float acc = 0.f;
#pragma unroll
        for (int x = 0; x < 16; ++x) { const int tok = 16 * grp + (dir == 0 ? x : 15 - x); acc += gs[tok * 64]; gs[tok * 64] = acc; }
        ((LAS float*)(F.lds + HG_LT))[(dir * 4 + grp) * 64 + k] = acc; }
    __syncthreads();
}
__device__ __forceinline__ void hg_a_phase(Frame& F, int layer) {
    PHASE_TID();
    bf16_t* DCM = (bf16_t*)(F.ws + WS_DCM); float* DNM = (float*)(F.ws + WS_DNM);
    const int r32 = lane & 31, hi = lane >> 5;
    const int vrd = ((lane >> 4) & 1) * 32 + (lane & 3) * 8 + (4 * hi + ((lane & 15) >> 2)) * 64;
    const int ps = tid >> 3, pc = tid & 7;
    HgRaw cur; if (F.bid < 16 * NC2) { int b, h, c, row0, jf, jb; ml_unit(F.bid, b, h, c, row0, jf, jb); hg_load<false>(F, h, row0, tid, cur); }
    for (int unit = F.bid; unit < 16 * NC2; unit += F.G) {
        int b, h, c, row0, jf, jb; ml_unit(unit, b, h, c, row0, jf, jb);
        HgRaw nxt = cur; if (unit + F.G < 16 * NC2) { int b2, h2, c2, r2, j2, j3; ml_unit(unit + F.G, b2, h2, c2, r2, j2, j3); hg_load<false>(F, h2, r2, tid, nxt); }
        __syncthreads();
        hg_stage<false>(F, layer, h, cur, tid); cur = nxt;
        const LAS float* LT = (const LAS float*)(F.lds + HG_LT);
#pragma unroll
        for (int dir = 0; dir < 2; ++dir) { const int grp = ps >> 4; const LAS float* gs = (const LAS float*)(F.lds + HG_GS) + dir * 4096 + ps * 64 + pc * 8;
            const u32x4 kw = *(const LAS u32x4*)(F.lds + HG_KK + dir * 8192 + rm_off(ps, pc));
            const float kk8[8] = {bf_lo(kw.x), bf_hi(kw.x), bf_lo(kw.y), bf_hi(kw.y), bf_lo(kw.z), bf_hi(kw.z), bf_lo(kw.w), bf_hi(kw.w)}; float o8[8];
#pragma unroll
            for (int i = 0; i < 8; ++i) { float ex = LT[(dir * 4 + grp) * 64 + pc * 8 + i] - gs[i];
#pragma unroll
                for (int g2 = 0; g2 < 4; ++g2) { const bool after = dir == 0 ? (g2 > grp) : (g2 < grp); if (after) ex += LT[(dir * 4 + g2) * 64 + pc * 8 + i]; }
                o8[i] = kk8[i] * fast_exp2(ex); }
            u32x4 o; o.x = cvt_pk_bf16(o8[0], o8[1]); o.y = cvt_pk_bf16(o8[2], o8[3]); o.z = cvt_pk_bf16(o8[4], o8[5]); o.w = cvt_pk_bf16(o8[6], o8[7]);
            *(LAS u32x4*)(F.lds + HG_QH + dir * 8192 + (pc >> 2) * 4096 + ps * 64 + (pc & 3) * 16) = o; }
        if (tid < 128) { const int dir = tid >> 6, k = tid & 63; const float tot = (LT[(dir * 4 + 0) * 64 + k] + LT[(dir * 4 + 1) * 64 + k]) + (LT[(dir * 4 + 2) * 64 + k] + LT[(dir * 4 + 3) * 64 + k]);
            DNM[((size_t)(32 + (b * 4 + h) * 2 + dir) * NC2 + (dir == 0 ? jf : jb)) * 64 + k] = fast_exp2(tot); }
        __syncthreads();
        { const int dir = wave >> 2, eblk = (wave >> 1) & 1, dblk = wave & 1;
            f32x16 acc = zero16();
#pragma unroll
            for (int ks = 0; ks < 4; ++ks) { const bf16x8 va = tr_frag(F.lds + HG_VI + eblk * 4096 + ks * 1024 + vrd), kb = tr_frag(F.lds + HG_QH + dir * 8192 + dblk * 4096 + ks * 1024 + vrd);
                acc = mfma32(va, kb, acc); }
            const size_t si = (size_t)(32 + (b * 4 + h) * 2 + dir) * NC2 + (dir == 0 ? jf : jb);
            bf16_t* dst = DCM + si * 4096 + (32 * eblk) * 64 + 32 * dblk + r32;
#pragma unroll
            for (int r = 0; r < 16; ++r) dst[crow(r, hi) * 64] = (bf16_t)(cvt_pk_bf16(acc[r], 0.f) & 0xffffu);
        }
    }
}
__device__ __forceinline__ bf16x8 scale_frag(bf16x8 v, const LAS float* e0, const LAS float* e1, const LAS float* e2, int n) {
    const u32x4 w = __builtin_bit_cast(u32x4, v);
    f32x4 a = *(const LAS f32x4*)e0, bq = *(const LAS f32x4*)(e0 + 4);
    if (n > 1) { a = a + *(const LAS f32x4*)e1; bq = bq + *(const LAS f32x4*)(e1 + 4); }
    if (n > 2) { a = a + *(const LAS f32x4*)e2; bq = bq + *(const LAS f32x4*)(e2 + 4); }
    u32x4 o; o.x = cvt_pk_bf16(bf_lo(w.x) * fast_exp2(a.x), bf_hi(w.x) * fast_exp2(a.y)); o.y = cvt_pk_bf16(bf_lo(w.y) * fast_exp2(a.z), bf_hi(w.y) * fast_exp2(a.w));
    o.z = cvt_pk_bf16(bf_lo(w.z) * fast_exp2(bq.x), bf_hi(w.z) * fast_exp2(bq.y)); o.w = cvt_pk_bf16(bf_lo(w.w) * fast_exp2(bq.z), bf_hi(w.w) * fast_exp2(bq.w));
    return __builtin_bit_cast(bf16x8, o); }
__device__ __forceinline__ void hg_c_phase(Frame& F, int layer, bool need_ctx) {
    PHASE_TID();
    const bf16_t* P = (const bf16_t*)(F.ws + WS_P); bf16_t* MIX = (bf16_t*)(F.ws + WS_MIX); const bf16_t* C0M = (const bf16_t*)(F.ws + WS_C0M);
    const int ps = tid >> 3, pc = tid & 7;
    const int l16 = lane & 15, g4 = lane >> 4;
    const int nunit = need_ctx ? 16 * NC2 : 16 * 64;
    const int vb = F.G == 256 ? ((F.bid + 128) & 255) : F.bid;
    HgRaw cur; if (vb < nunit) { const int un = need_ctx ? vb : (vb >> 6) * NC2 + 4 + (vb & 63); int b, h, c, row0, jf, jb; ml_unit(un, b, h, c, row0, jf, jb); hg_load<true>(F, h, row0, tid, cur); }
    for (int u0 = vb; u0 < nunit; u0 += F.G) {
        const int unit = need_ctx ? u0 : (u0 >> 6) * NC2 + 4 + (u0 & 63);
        int b, h, c, row0, jf, jb; ml_unit(unit, b, h, c, row0, jf, jb);
        HgRaw nxt = cur; if (u0 + F.G < nunit) { const int un = need_ctx ? u0 + F.G : ((u0 + F.G) >> 6) * NC2 + 4 + ((u0 + F.G) & 63); int b2, h2, c2, r2, j2, j3; ml_unit(un, b2, h2, c2, r2, j2, j3); hg_load<true>(F, h2, r2, tid, nxt); }
        u32x4 c0raw[2];
#pragma unroll
        for (int dir = 0; dir < 2; ++dir) { const size_t sid = (size_t)(32 + (b * 4 + h) * 2 + dir) * NC2 + (dir == 0 ? jf : jb); c0raw[dir] = *(const GAS u32x4*)(C0M + sid * 4096 + ps * 64 + pc * 8); }
        const u32x4 owraw = *(const GAS u32x4*)(P + (size_t)(row0 + (tid >> 3)) * PW + HG_G + h * 64 + (tid & 7) * 8);
        __syncthreads();
        hg_stage<true>(F, layer, h, cur, tid); cur = nxt;
        const LAS float* LT = (const LAS float*)(F.lds + HG_LT);
        { const int dir = wave >> 2, grp = wave & 3, pl = lane >> 3, kc = lane & 7, n1 = 16 - pl;
            LAS float* AD = (LAS float*)(F.lds + HG_AD) + (dir * 4 + grp) * 256;
            const LAS float* FD = (const LAS float*)(F.lds + HG_QH) + dir * 4096 + kc * 8;
            const int s1 = dir == 0 ? pl : 15 - pl, s2 = 15 - s1;
            const u32x4 kw1 = *(const LAS u32x4*)(F.lds + HG_KK + dir * 8192 + rm_off(16 * grp + s1, kc)), kw2 = *(const LAS u32x4*)(F.lds + HG_KK + dir * 8192 + rm_off(16 * grp + s2, kc));
            float kd[8] = {bf_lo(kw1.x), bf_hi(kw1.x), bf_lo(kw1.y), bf_hi(kw1.y), bf_lo(kw1.z), bf_hi(kw1.z), bf_lo(kw1.w), bf_hi(kw1.w)};
            for (int it = 0; it < 17; ++it) {
                const bool second = it >= n1; const int x = second ? (15 - pl) + (it - n1) : pl + it;
                const int tl = dir == 0 ? x : 15 - x, sl = second ? s2 : s1, tr = 16 * grp + tl;
                const f32x4 fa = *(const LAS f32x4*)(FD + tr * 64), fb = *(const LAS f32x4*)(FD + tr * 64 + 4);
                const u32x4 qw = *(const LAS u32x4*)(F.lds + HG_QR + rm_off(tr, kc));
                kd[0] *= fa.x; kd[1] *= fa.y; kd[2] *= fa.z; kd[3] *= fa.w; kd[4] *= fb.x; kd[5] *= fb.y; kd[6] *= fb.z; kd[7] *= fb.w;
                if (it == 0 || it == n1) { const u32x4 kw = second ? kw2 : kw1;
                    kd[0] = bf_lo(kw.x); kd[1] = bf_hi(kw.x); kd[2] = bf_lo(kw.y); kd[3] = bf_hi(kw.y); kd[4] = bf_lo(kw.z); kd[5] = bf_hi(kw.z); kd[6] = bf_lo(kw.w); kd[7] = bf_hi(kw.w); }
                float sum = (bf_lo(qw.x) * kd[0] + bf_hi(qw.x) * kd[1]) + (bf_lo(qw.y) * kd[2] + bf_hi(qw.y) * kd[3]);
                sum += (bf_lo(qw.z) * kd[4] + bf_hi(qw.z) * kd[5]) + (bf_lo(qw.w) * kd[6] + bf_hi(qw.w) * kd[7]);
                sum = sum8(sum);
                if (kc == 0) AD[tl * 16 + sl] = sum; }
        }
        __syncthreads();
        { const u32x4 qw = *(const LAS u32x4*)(F.lds + HG_QR + rm_off(ps, pc));
            const float q8[8] = {bf_lo(qw.x), bf_hi(qw.x), bf_lo(qw.y), bf_hi(qw.y), bf_lo(qw.z), bf_hi(qw.z), bf_lo(qw.w), bf_hi(qw.w)};
#pragma unroll
            for (int dir = 0; dir < 2; ++dir) { const int grp = ps >> 4; const LAS float* gs = (const LAS float*)(F.lds + HG_GS) + dir * 4096 + ps * 64 + pc * 8;
                const u32x4 kw = *(const LAS u32x4*)(F.lds + HG_KK + dir * 8192 + rm_off(ps, pc));
                const float kk8[8] = {bf_lo(kw.x), bf_hi(kw.x), bf_lo(kw.y), bf_hi(kw.y), bf_lo(kw.z), bf_hi(kw.z), bf_lo(kw.w), bf_hi(kw.w)}; float qo[8], ko[8];
#pragma unroll
                for (int i = 0; i < 8; ++i) { const float gv = gs[i]; qo[i] = q8[i] * fast_exp2(gv); ko[i] = kk8[i] * fast_exp2(LT[(dir * 4 + grp) * 64 + pc * 8 + i] - gv); }
                u32x4 o; o.x = cvt_pk_bf16(qo[0], qo[1]); o.y = cvt_pk_bf16(qo[2], qo[3]); o.z = cvt_pk_bf16(qo[4], qo[5]); o.w = cvt_pk_bf16(qo[6], qo[7]);
                *(LAS u32x4*)(F.lds + HG_QH + dir * 8192 + rm_off(ps, pc)) = o;
                o.x = cvt_pk_bf16(ko[0], ko[1]); o.y = cvt_pk_bf16(ko[2], ko[3]); o.z = cvt_pk_bf16(ko[4], ko[5]); o.w = cvt_pk_bf16(ko[6], ko[7]);
                *(LAS u32x4*)(F.lds + HG_KH + dir * 8192 + rm_off(ps, pc)) = o;
                *(LAS u32x4*)(F.lds + HG_C0 + dir * 8192 + rm_off(ps, pc)) = c0raw[dir]; } }
        __syncthreads();
        { const int dir = wave >> 2, isub = wave & 3;
#define HG_GRP(j) (dir == 0 ? (j) : 3 - (j))
            const int gt_ = HG_GRP(isub); const int tt = 16 * gt_ + l16;
            const LAS float* LTd = LT + dir * 256;
            bf16x8 qh[2];
#pragma unroll
            for (int k2 = 0; k2 < 2; ++k2) qh[k2] = *(const LAS bf16x8*)(F.lds + HG_QH + dir * 8192 + rm_off(tt, 4 * k2 + g4));
            f32x4 S[4];
#pragma unroll
            for (int j = 0; j < 4; ++j) { S[j] = (f32x4){0.f, 0.f, 0.f, 0.f};
                if (j < isub) { const int gsrc = HG_GRP(j); const int ts = 16 * gsrc + l16; const int nd = isub - j - 1;
#pragma unroll
                    for (int k2 = 0; k2 < 2; ++k2) { const bf16x8 ka = *(const LAS bf16x8*)(F.lds + HG_KH + dir * 8192 + rm_off(ts, 4 * k2 + g4));
                        const int ko = 32 * k2 + 8 * g4;
                        const bf16x8 qb = nd == 0 ? qh[k2] : scale_frag(qh[k2], LTd + HG_GRP(j + 1) * 64 + ko, LTd + HG_GRP(j + 2 > 3 ? 3 : j + 2) * 64 + ko, LTd, nd);
                        S[j] = mfma16(ka, qb, S[j]); }
                } else if (j == isub) { const f32x4 ad = *(const LAS f32x4*)((const LAS float*)(F.lds + HG_AD) + (dir * 4 + gt_) * 256 + l16 * 16 + 4 * g4);
#pragma unroll
                    for (int r = 0; r < 4; ++r) { const int sl = 4 * g4 + r; const bool ok = dir == 0 ? (sl <= l16) : (sl >= l16); S[j][r] = ok ? ad[r] : 0.f; } }
            }
            f32x4 O[4];
#pragma unroll
            for (int et = 0; et < 4; ++et) O[et] = (f32x4){0.f, 0.f, 0.f, 0.f};
#pragma unroll
            for (int pr2 = 0; pr2 < 2; ++pr2) { if (2 * pr2 <= isub) {
                u32x4 pw; pw.x = cvt_pk_bf16(S[2 * pr2][0], S[2 * pr2][1]); pw.y = cvt_pk_bf16(S[2 * pr2][2], S[2 * pr2][3]); pw.z = cvt_pk_bf16(S[2 * pr2 + 1][0], S[2 * pr2 + 1][1]); pw.w = cvt_pk_bf16(S[2 * pr2 + 1][2], S[2 * pr2 + 1][3]);
                const bf16x8 pa = __builtin_bit_cast(bf16x8, pw);
                const int ra = 16 * HG_GRP(2 * pr2) + 4 * g4 + (l16 >> 2), rb = 16 * HG_GRP(2 * pr2 + 1) + 4 * g4 + (l16 >> 2);
#pragma unroll
                for (int et = 0; et < 4; ++et) { const int cb = 16 * et + 4 * (l16 & 3); const int co = (cb >> 5) * 4096 + (cb & 31) * 2;
                    const s16x4 lo = __builtin_bit_cast(s16x4, __builtin_amdgcn_ds_read_tr16_b64_v4i16((LAS s16x4*)(F.lds + HG_VI + co + ra * 64)));
                    const s16x4 hh = __builtin_bit_cast(s16x4, __builtin_amdgcn_ds_read_tr16_b64_v4i16((LAS s16x4*)(F.lds + HG_VI + co + rb * 64)));
                    const bf16x8 vf = {lo[0], lo[1], lo[2], lo[3], hh[0], hh[1], hh[2], hh[3]};
                    O[et] = mfma16(pa, vf, O[et]); } } }
            { const size_t si = (size_t)(32 + (b * 4 + h) * 2 + dir) * NC2 + (dir == 0 ? jf : jb);
#pragma unroll
                for (int k2 = 0; k2 < 2; ++k2) { const int ko = 32 * k2 + 8 * g4;
                    const bf16x8 qi = isub == 0 ? qh[k2] : scale_frag(qh[k2], LTd + HG_GRP(0) * 64 + ko, LTd + HG_GRP(1) * 64 + ko, LTd + HG_GRP(2) * 64 + ko, isub);
#pragma unroll
                    for (int et = 0; et < 4; ++et) { const bf16x8 cb = *(const LAS bf16x8*)(F.lds + HG_C0 + dir * 8192 + rm_off(16 * et + l16, 4 * k2 + g4));
                        O[et] = mfma16(qi, cb, O[et]); } } }
            LAS float* Hx = (LAS float*)(F.lds + HG_GS);
#pragma unroll
            for (int et = 0; et < 4; ++et)
#pragma unroll
                for (int r = 0; r < 4; ++r) Hx[(dir * 64 + 16 * gt_ + 4 * g4 + r) * 64 + 16 * et + l16] = O[et][r];
#undef HG_GRP
        }
        __syncthreads();
        { const int t = tid >> 3, e8 = (tid & 7) * 8; const LAS float* Hx = (const LAS float*)(F.lds + HG_GS); float v[8]; float ss = 0.f;
            const f32x4 a0 = *(const LAS f32x4*)(Hx + t * 64 + e8), a1 = *(const LAS f32x4*)(Hx + t * 64 + e8 + 4), b0 = *(const LAS f32x4*)(Hx + (64 + t) * 64 + e8), b1 = *(const LAS f32x4*)(Hx + (64 + t) * 64 + e8 + 4);
            v[0] = a0.x + b0.x; v[1] = a0.y + b0.y; v[2] = a0.z + b0.z; v[3] = a0.w + b0.w; v[4] = a1.x + b1.x; v[5] = a1.y + b1.y; v[6] = a1.z + b1.z; v[7] = a1.w + b1.w;
#pragma unroll
            for (int i = 0; i < 8; ++i) ss += v[i] * v[i];
            ss = sum8(ss);
            const float rs = 1.0f / sqrtf(ss * (1.0f / 64.0f) + EPS);
            const u32x4 ow = owraw;
            const float og[8] = {bf_lo(ow.x), bf_hi(ow.x), bf_lo(ow.y), bf_hi(ow.y), bf_lo(ow.z), bf_hi(ow.z), bf_lo(ow.w), bf_hi(ow.w)};
            const float* nw = F.a->in[I_HGNORM] + layer * 256 + h * 64 + e8; float o[8];
#pragma unroll
            for (int i = 0; i < 8; ++i) o[i] = v[i] * rs * nw[i] * siluf_(og[i]);
            u32x4 w; w.x = cvt_pk_bf16(o[0], o[1]); w.y = cvt_pk_bf16(o[2], o[3]); w.z = cvt_pk_bf16(o[4], o[5]); w.w = cvt_pk_bf16(o[6], o[7]);
            *(GAS u32x4*)(MIX + (size_t)(row0 + t) * D + 256 + h * 64 + e8) = w; }
    }
    __syncthreads();
}
__device__ __forceinline__ void finish_phase(Frame& F, int layer, int nrows) {
    PHASE_TID();
    const bf16_t* P = (const bf16_t*)(F.ws + WS_P); const float* SCR = (const float*)(F.ws + WS_SCR); bf16_t* MIX = (bf16_t*)(F.ws + WS_MIX);
    const int gw = F.bid * NWAVES + wave, NGW = F.G * NWAVES, c0 = 4 * lane;
    for (int row = gw; row < nrows; row += NGW) {
#pragma unroll
        for (int kind = 1; kind < 2; ++kind) {
            const f32x4 a = *(const GAS f32x4*)(SCR + ((size_t)(kind * 2 + 0) * ROWS + row) * 256 + c0), bq = *(const GAS f32x4*)(SCR + ((size_t)(kind * 2 + 1) * ROWS + row) * 256 + c0);
            const f32x4 v = a + bq; float ss = (v.x * v.x + v.y * v.y) + (v.z * v.z + v.w * v.w);
            ss = sum16(ss);
            const float r = 1.0f / sqrtf(ss * (1.0f / 64.0f) + EPS);
            const f32x4 w = *(const GAS f32x4*)(F.a->in[kind == 0 ? I_MLNORM : I_HGNORM] + layer * 256 + c0);
            const u32x2 gw2 = *(const GAS u32x2*)(P + (size_t)row * PW + (kind == 0 ? ML_O : HG_G) + c0);
            const f32x4 gr = {bf_lo(gw2.x), bf_hi(gw2.x), bf_lo(gw2.y), bf_hi(gw2.y)}; f32x4 o;
#pragma unroll
            for (int j = 0; j < 4; ++j) { const float gt = kind == 0 ? sigmoidf_(gr[j]) : siluf_(gr[j]); o[j] = v[j] * r * w[j] * gt; }
            u32x2 ow; ow.x = cvt_pk_bf16(o[0], o[1]); ow.y = cvt_pk_bf16(o[2], o[3]);
            *(GAS u32x2*)(MIX + (size_t)row * D + kind * 256 + c0) = ow;
        }
    }
}
#if 0
__device__ __forceinline__ void attn_naive_phase(Frame& F, int layer, bool need_ctx) {
    PHASE_TID();
    const bf16_t* P = (const bf16_t*)(F.ws + WS_P); bf16_t* MIX = (bf16_t*)(F.ws + WS_MIX);
    LAS float* Kt = (LAS float*)F.lds;
    LAS float* Vt = (LAS float*)(F.lds + 32 * 136 * 4);
    const float lam = ((const float*)(F.ws + WS_SMALL + SM_CONST))[layer * 4 + 0], lam_init = ((const float*)(F.ws + WS_SMALL + SM_CONST))[layer * 4 + 1];
    const int ql = tid >> 2, s = (tid >> 1) & 1, hf = tid & 1;
    const int nu = 512 + (need_ctx ? 32 : 0);
    for (int u = F.bid; u < nu; u += F.G) {
        int b, h, qrow0, k0, nk;
        if (u < 512) { const int bh = u >> 5, qb = u & 31; b = bh >> 2; h = bh & 3; qrow0 = b * SEQ + qb * 128; k0 = 0; nk = NKEYS; }
        else { const int bh = (u - 512) >> 1, qb = (u - 512) & 1; b = bh >> 2; h = bh & 3; qrow0 = NLAT + b * CTXL + qb * 128; k0 = SEQ; nk = CTXL; }
        const int row = qrow0 + ql;
        unsigned qp[32];
        { const bf16_t* qptr = P + (size_t)row * PW + DA_Q + h * 128 + s * 64;
#pragma unroll
            for (int i = 0; i < 8; ++i) { const u32x4 w = *(const GAS u32x4*)(qptr + 8 * i); qp[4 * i] = w.x; qp[4 * i + 1] = w.y; qp[4 * i + 2] = w.z; qp[4 * i + 3] = w.w; } }
        const int skey = tid >> 4, sch = tid & 15;
        float mx = -3.0e38f;
        for (int t0 = 0; t0 < nk; t0 += 32) {
            __syncthreads();
            { const int kidx = k0 + t0 + skey; const int krow = kidx < SEQ ? b * SEQ + kidx : NLAT + b * CTXL + (kidx - SEQ);
                const u32x4 w = *(const GAS u32x4*)(P + (size_t)krow * PW + DA_K + h * 128 + sch * 8);
                LAS float* d = Kt + skey * 136 + (sch >> 3) * 68 + (sch & 7) * 8;
                *(LAS f32x4*)d = (f32x4){bf_lo(w.x), bf_hi(w.x), bf_lo(w.y), bf_hi(w.y)}; *(LAS f32x4*)(d + 4) = (f32x4){bf_lo(w.z), bf_hi(w.z), bf_lo(w.w), bf_hi(w.w)}; }
            __syncthreads();
            for (int j = 0; j < 32; ++j) { const LAS float* kr = Kt + j * 136 + s * 68; float d0 = 0.f, d1 = 0.f;
#pragma unroll
                for (int i = 0; i < 16; i += 2) { const f32x4 ka = *(const LAS f32x4*)(kr + 4 * i), kb = *(const LAS f32x4*)(kr + 4 * i + 4);
                    d0 += (bf_lo(qp[2 * i]) * ka.x + bf_hi(qp[2 * i]) * ka.y) + (bf_lo(qp[2 * i + 1]) * ka.z + bf_hi(qp[2 * i + 1]) * ka.w);
                    d1 += (bf_lo(qp[2 * i + 2]) * kb.x + bf_hi(qp[2 * i + 2]) * kb.y) + (bf_lo(qp[2 * i + 3]) * kb.z + bf_hi(qp[2 * i + 3]) * kb.w); }
                mx = fmaxf(mx, d0 + d1); }
        }
        float acc[64];
#pragma unroll
        for (int i = 0; i < 64; ++i) acc[i] = 0.f;
        float lsum = 0.f;
        for (int t0 = 0; t0 < nk; t0 += 32) {
            __syncthreads();
            { const int kidx = k0 + t0 + skey; const int krow = kidx < SEQ ? b * SEQ + kidx : NLAT + b * CTXL + (kidx - SEQ);
                const u32x4 w = *(const GAS u32x4*)(P + (size_t)krow * PW + DA_K + h * 128 + sch * 8);
                LAS float* d = Kt + skey * 136 + (sch >> 3) * 68 + (sch & 7) * 8;
                *(LAS f32x4*)d = (f32x4){bf_lo(w.x), bf_hi(w.x), bf_lo(w.y), bf_hi(w.y)}; *(LAS f32x4*)(d + 4) = (f32x4){bf_lo(w.z), bf_hi(w.z), bf_lo(w.w), bf_hi(w.w)};
                const u32x4 wv = *(const GAS u32x4*)(P + (size_t)krow * PW + DA_V + h * 128 + sch * 8);
                LAS float* dv = Vt + skey * 136 + (sch >> 3) * 68 + (sch & 7) * 8;
                *(LAS f32x4*)dv = (f32x4){bf_lo(wv.x), bf_hi(wv.x), bf_lo(wv.y), bf_hi(wv.y)}; *(LAS f32x4*)(dv + 4) = (f32x4){bf_lo(wv.z), bf_hi(wv.z), bf_lo(wv.w), bf_hi(wv.w)}; }
            __syncthreads();
            for (int j = 0; j < 32; ++j) { const LAS float* kr = Kt + j * 136 + s * 68; float d0 = 0.f, d1 = 0.f;
#pragma unroll
                for (int i = 0; i < 16; i += 2) { const f32x4 ka = *(const LAS f32x4*)(kr + 4 * i), kb = *(const LAS f32x4*)(kr + 4 * i + 4);
                    d0 += (bf_lo(qp[2 * i]) * ka.x + bf_hi(qp[2 * i]) * ka.y) + (bf_lo(qp[2 * i + 1]) * ka.z + bf_hi(qp[2 * i + 1]) * ka.w);
                    d1 += (bf_lo(qp[2 * i + 2]) * kb.x + bf_hi(qp[2 * i + 2]) * kb.y) + (bf_lo(qp[2 * i + 3]) * kb.z + bf_hi(qp[2 * i + 3]) * kb.w); }
                const float p = fast_exp2((d0 + d1) - mx); lsum += p;
                const LAS float* vr = Vt + j * 136 + hf * 68;
#pragma unroll
                for (int i = 0; i < 16; ++i) { const f32x4 v4 = *(const LAS f32x4*)(vr + 4 * i); acc[4 * i] += p * v4.x; acc[4 * i + 1] += p * v4.y; acc[4 * i + 2] += p * v4.z; acc[4 * i + 3] += p * v4.w; } }
        }
        const float inv = 1.0f / lsum; float ss = 0.f;
#pragma unroll
        for (int i = 0; i < 64; ++i) { const float o = acc[i] * inv; const float other = __shfl_xor(o, 2); acc[i] = o - lam * other; ss += acc[i] * acc[i]; }
        ss += __shfl_xor(ss, 1);
        if (s == 0) { const float r = (1.0f - lam_init) / sqrtf(ss * (1.0f / 128.0f) + EPS); const float* nw = F.a->in[I_DANORM] + layer * 128 + hf * 64;
            bf16_t* op = MIX + (size_t)row * D + 512 + h * 128 + hf * 64;
#pragma unroll
            for (int i = 0; i < 8; ++i) { u32x4 w; w.x = cvt_pk_bf16(acc[8 * i] * r * nw[8 * i], acc[8 * i + 1] * r * nw[8 * i + 1]); w.y = cvt_pk_bf16(acc[8 * i + 2] * r * nw[8 * i + 2], acc[8 * i + 3] * r * nw[8 * i + 3]);
                w.z = cvt_pk_bf16(acc[8 * i + 4] * r * nw[8 * i + 4], acc[8 * i + 5] * r * nw[8 * i + 5]); w.w = cvt_pk_bf16(acc[8 * i + 6] * r * nw[8 * i + 6], acc[8 * i + 7] * r * nw[8 * i + 7]);
                *(GAS u32x4*)(op + 8 * i) = w; } }
    }
    __syncthreads();
}

#endif
__device__ __forceinline__ void glds16(const void* gsrc, unsigned lds_dst) { unsigned keep;
    asm volatile("s_mov_b32 %0, m0\n\ts_mov_b32 m0, %2\n\ts_nop 0\n\tglobal_load_lds_dwordx4 %1, off\n\ts_mov_b32 m0, %0" : "=&s"(keep) : "v"(gsrc), "s"(lds_dst) : "memory"); }
constexpr int CW_KMAX = 12288;
__device__ __forceinline__ void kmax_phase(Frame& F, int layer) {
    PHASE_TID();
    const bf16_t* P = (const bf16_t*)(F.ws + WS_P);
    LAS float* red = (LAS float*)(F.lds);
    for (int it = F.bid; it < 256; it += F.G) {
        const int bhs = it >> 3, sl = it & 7, b = bhs >> 3, h = (bhs >> 1) & 3, sub = bhs & 1;
        float mx = 0.f;
        for (int k0 = sl * 544; k0 < sl * 544 + 544; k0 += 64) {
            const int key = k0 + (tid >> 3), ch = tid & 7;
            const int krow = key < SEQ ? b * SEQ + key : NLAT + b * CTXL + (key - SEQ);
            float ss = 0.f;
            if (key < sl * 544 + 544) { const u32x4 w = *(const GAS u32x4*)(P + (size_t)krow * PW + DA_K + h * 128 + sub * 64 + ch * 8);
                const float a0 = bf_lo(w.x), a1 = bf_hi(w.x), a2 = bf_lo(w.y), a3 = bf_hi(w.y), a4 = bf_lo(w.z), a5 = bf_hi(w.z), a6 = bf_lo(w.w), a7 = bf_hi(w.w);
                ss = ((a0 * a0 + a1 * a1) + (a2 * a2 + a3 * a3)) + ((a4 * a4 + a5 * a5) + (a6 * a6 + a7 * a7)); }
            ss = sum8(ss);
            mx = fmaxf(mx, ss);
        }
#pragma unroll
        for (int o = 8; o < 64; o <<= 1) mx = fmaxf(mx, __shfl_xor(mx, o));
        if (lane == 0) red[wave] = mx;
        __syncthreads();
        if (tid == 0) { float m = red[0];
#pragma unroll
            for (int w = 1; w < 8; ++w) m = fmaxf(m, red[w]);
            atomicMax(F.ctl + CW_KMAX + layer * 64 + bhs, __float_as_uint(m)); }
        __syncthreads();
    }
}
__device__ __forceinline__ void attn_phase(Frame& F, int layer, bool need_ctx) {
    PHASE_TID();
    const bf16_t* P = (const bf16_t*)(F.ws + WS_P); bf16_t* MIX = (bf16_t*)(F.ws + WS_MIX);
    const float lam = ((const float*)(F.ws + WS_SMALL + SM_CONST))[layer * 4 + 0], lam_init = ((const float*)(F.ws + WS_SMALL + SM_CONST))[layer * 4 + 1];
    const int r32 = lane & 31, hi = lane >> 5, sub = wave & 1, rg = wave >> 1;
    LAS unsigned char* Kb = F.lds;
    LAS unsigned char* Vb = F.lds + 16384;
    const unsigned ldsb = (unsigned)(size_t)F.lds;
    LAS float* Xb = (LAS float*)(F.lds);
    const int krd = r32 * 256, kx = r32 & 15;
    const int vrd = ((lane >> 4) & 1) * 32 + (lane & 3) * 8 + (4 * hi + ((lane & 15) >> 2)) * 64;
    const int nu = 512 + (need_ctx ? 32 : 0);
    if (wave >= 4) __builtin_amdgcn_s_setprio(1);
    for (int i = 0;; ++i) {
        int u = i * F.G + ((i >= 2 && F.G == 256) ? ((F.bid + 64) & 255) : F.bid); if (u >= nu) break;
        int b, h, qrow0, t0, t1;
        if (u < 512) { int bh, qb; if (F.G == 256) { bh = (F.bid & 7) * 2 + i; qb = F.bid >> 3; } else { bh = u >> 5; qb = u & 31; }
            b = bh >> 2; h = bh & 3; qrow0 = b * SEQ + qb * 128; t0 = 0; t1 = NKEYS / 64; }
        else { const int bh = (u - 512) >> 1, qb = (u - 512) & 1; b = bh >> 2; h = bh & 3; qrow0 = NLAT + b * CTXL + qb * 128; t0 = SEQ / 64; t1 = NKEYS / 64; }
        const int row = qrow0 + rg * 32 + r32;
        bf16x8 qf[4]; float qn2 = 0.f;
        { const bf16_t* qp = P + (size_t)row * PW + DA_Q + h * 128 + sub * 64 + hi * 8;
#pragma unroll
            for (int ks = 0; ks < 4; ++ks) { const u32x4 w = *(const GAS u32x4*)(qp + 16 * ks); qf[ks] = __builtin_bit_cast(bf16x8, w);
                const float a0 = bf_lo(w.x), a1 = bf_hi(w.x), a2 = bf_lo(w.y), a3 = bf_hi(w.y), a4 = bf_lo(w.z), a5 = bf_hi(w.z), a6 = bf_lo(w.w), a7 = bf_hi(w.w);
                qn2 += ((a0 * a0 + a1 * a1) + (a2 * a2 + a3 * a3)) + ((a4 * a4 + a5 * a5) + (a6 * a6 + a7 * a7)); } }
        qn2 += __shfl_xor(qn2, 32);
        const float kmax2 = __uint_as_float(__hip_atomic_load(F.ctl + CW_KMAX + layer * 64 + (b * 4 + h) * 2 + sub, RLX_AGENT));
        const float nm = -(sqrtf(qn2 * kmax2) * 1.001f + 1e-20f);
        f32x16 O[4], NM16; float ls0 = 0.f, ls1 = 0.f;
#pragma unroll
        for (int r = 0; r < 16; ++r) { O[0][r] = 0.f; O[1][r] = 0.f; O[2][r] = 0.f; O[3][r] = 0.f; NM16[r] = nm; }
        asm volatile("" : "+v"(NM16));
#define ATT_TROW(t) ((t) < SEQ / 64 ? b * SEQ + (t) * 64 : NLAT + b * CTXL + ((t) - SEQ / 64) * 64)
#define ATT_DMAK(t, buf) do { const bf16_t* pk_ = P + (size_t)ATT_TROW(t) * PW + DA_K + h * 128; \
        _Pragma("unroll") for (int i_ = 0; i_ < 2; ++i_) { const int row_ = 4 * (2 * wave + i_) + (lane >> 4), ch_ = (lane & 15) ^ (row_ & 15); \
            glds16(pk_ + (size_t)row_ * PW + ch_ * 8, (unsigned)__builtin_amdgcn_readfirstlane((int)(ldsb + (buf) * 32768 + (2 * wave + i_) * 1024))); } } while (0)
#define ATT_DMAV(t, buf) do { const bf16_t* pv_ = P + (size_t)ATT_TROW(t) * PW + DA_V + h * 128; \
        _Pragma("unroll") for (int i_ = 0; i_ < 2; ++i_) { const int j_ = 2 * wave + i_, row_ = 16 * (j_ & 3) + (lane >> 2), col_ = (j_ >> 2) * 32 + (lane & 3) * 8; \
            glds16(pv_ + (size_t)row_ * PW + col_, (unsigned)__builtin_amdgcn_readfirstlane((int)(ldsb + 16384 + (buf) * 32768 + j_ * 1024))); } } while (0)
#define ATT_QK(SA, SB, buf) do { const LAS unsigned char* kb_ = Kb + (buf) * 32768 + krd; bf16x8 kf_[8]; \
        _Pragma("unroll") for (int ks = 0; ks < 4; ++ks) { const int co = ((sub * 8 + 2 * ks + hi) ^ kx) << 4; kf_[2 * ks] = *(const LAS bf16x8*)(kb_ + co); kf_[2 * ks + 1] = *(const LAS bf16x8*)(kb_ + 32 * 256 + co); } \
        __builtin_amdgcn_sched_barrier(0);     \
        __builtin_amdgcn_s_setprio(2); SA = mfma32(kf_[0], qf[0], NM16); SB = mfma32(kf_[1], qf[0], NM16);     \
        _Pragma("unroll") for (int ks = 1; ks < 4; ++ks) { SA = mfma32(kf_[2 * ks], qf[ks], SA); SB = mfma32(kf_[2 * ks + 1], qf[ks], SB); } if (wave >= 4) __builtin_amdgcn_s_setprio(1); else __builtin_amdgcn_s_setprio(0); } while (0)
#define ATT_STEP(CA, CB, t) do { const int cur = ((t) - t0) % 3, nx2 = ((t) + 2 - t0) % 3; \
        if ((t) + 2 < t1) { ATT_DMAK((t) + 2, nx2); ATT_DMAV((t) + 2, nx2); if (ATT_DBL & 8) { ATT_DMAK((t) + 2, nx2); ATT_DMAV((t) + 2, nx2); } } \
        f32x16 CA, CB; ATT_QK(CA, CB, cur); if (ATT_DBL & 1) { ATT_QK(CA, CB, cur); } \
        bf16x8 pf[4]; \
        _Pragma("unroll") for (int s2 = 0; s2 < 2; ++s2) { u32x4 w0, w1; \
            w0.x = cvtpk_s(fast_exp2(CA[8 * s2 + 0]), fast_exp2(CA[8 * s2 + 1])); w0.y = cvtpk_s(fast_exp2(CA[8 * s2 + 2]), fast_exp2(CA[8 * s2 + 3])); \
            w0.z = cvtpk_s(fast_exp2(CA[8 * s2 + 4]), fast_exp2(CA[8 * s2 + 5])); w0.w = cvtpk_s(fast_exp2(CA[8 * s2 + 6]), fast_exp2(CA[8 * s2 + 7])); \
            w1.x = cvtpk_s(fast_exp2(CB[8 * s2 + 0]), fast_exp2(CB[8 * s2 + 1])); w1.y = cvtpk_s(fast_exp2(CB[8 * s2 + 2]), fast_exp2(CB[8 * s2 + 3])); \
            w1.z = cvtpk_s(fast_exp2(CB[8 * s2 + 4]), fast_exp2(CB[8 * s2 + 5])); w1.w = cvtpk_s(fast_exp2(CB[8 * s2 + 6]), fast_exp2(CB[8 * s2 + 7])); \
            ls0 = dot2_ones(w0.x, ls0); ls1 = dot2_ones(w1.x, ls1); ls0 = dot2_ones(w0.y, ls0); ls1 = dot2_ones(w1.y, ls1); \
            ls0 = dot2_ones(w0.z, ls0); ls1 = dot2_ones(w1.z, ls1); ls0 = dot2_ones(w0.w, ls0); ls1 = dot2_ones(w1.w, ls1);     \
            pf[s2] = __builtin_bit_cast(bf16x8, w0); pf[2 + s2] = __builtin_bit_cast(bf16x8, w1); } \
        const LAS unsigned char* vb_ = Vb + cur * 32768 + vrd; \
        bf16x8 vfa_[4], vfb_[4]; \
        _Pragma("unroll") for (int blk = 0; blk < 4; ++blk) vfa_[blk] = tr_frag(vb_ + blk * 4096); \
        _Pragma("unroll") for (int blk = 0; blk < 4; ++blk) vfb_[blk] = tr_frag(vb_ + blk * 4096 + 1024); \
        __builtin_amdgcn_sched_barrier(0); \
        __builtin_amdgcn_s_setprio(2); \
        _Pragma("unroll") for (int blk = 0; blk < 4; ++blk) O[blk] = mfma32(pf[0], vfa_[blk], O[blk]); \
        _Pragma("unroll") for (int blk = 0; blk < 4; ++blk) vfa_[blk] = tr_frag(vb_ + blk * 4096 + 2048); \
        __builtin_amdgcn_sched_barrier(0); \
        _Pragma("unroll") for (int blk = 0; blk < 4; ++blk) O[blk] = mfma32(pf[1], vfb_[blk], O[blk]); \
        _Pragma("unroll") for (int blk = 0; blk < 4; ++blk) vfb_[blk] = tr_frag(vb_ + blk * 4096 + 3072); \
        __builtin_amdgcn_sched_barrier(0); \
        _Pragma("unroll") for (int blk = 0; blk < 4; ++blk) O[blk] = mfma32(pf[2], vfa_[blk], O[blk]); \
        _Pragma("unroll") for (int blk = 0; blk < 4; ++blk) O[blk] = mfma32(pf[3], vfb_[blk], O[blk]); \
        if (wave >= 4) __builtin_amdgcn_s_setprio(1); else __builtin_amdgcn_s_setprio(0); \
        if ((t) + 2 < t1) { if (ATT_DBL & 8) asm volatile("s_waitcnt vmcnt(8) lgkmcnt(0)" ::: "memory"); else asm volatile("s_waitcnt vmcnt(4) lgkmcnt(0)" ::: "memory"); } else asm volatile("s_waitcnt vmcnt(0) lgkmcnt(0)" ::: "memory"); \
        __builtin_amdgcn_s_barrier(); asm volatile("" ::: "memory"); } while (0)
        __syncthreads();
        ATT_DMAK(t0, 0); ATT_DMAV(t0, 0); ATT_DMAK(t0 + 1, 1); ATT_DMAV(t0 + 1, 1);
        asm volatile("s_waitcnt vmcnt(4)" ::: "memory"); __builtin_amdgcn_s_barrier(); asm volatile("" ::: "memory");
        for (int t = t0; t < t1; ++t) { ATT_STEP(sa_, sb_, t); }
#undef ATT_TROW
#undef ATT_DMAK
#undef ATT_DMAV
#undef ATT_QK
#undef ATT_STEP
        { float lsum = ls0 + ls1; lsum += __shfl_xor(lsum, 32);
            LAS float* lw = (LAS float*)(F.lds + 65536) + wave * 32;
            if (hi == 0) lw[r32] = 1.0f / lsum;
            asm volatile("s_waitcnt lgkmcnt(0)" ::: "memory");
#pragma unroll
            for (int g = 0; g < 4; ++g) { const f32x4 iv = *(const LAS f32x4*)(lw + 8 * g + 4 * hi);
#pragma unroll
                for (int j = 0; j < 4; ++j) { const float inv = iv[j]; O[0][4 * g + j] *= inv; O[1][4 * g + j] *= inv; O[2][4 * g + j] *= inv; O[3][4 * g + j] *= inv; } } }
        LAS float* xw = Xb + rg * 4096 + lane;
        if (sub == 1) {
#pragma unroll
            for (int blk = 0; blk < 4; ++blk)
#pragma unroll
                for (int r = 0; r < 16; ++r) xw[(blk * 16 + r) * 64] = O[blk][r];
        }
        __syncthreads();
        if (sub == 0) {
            const float* nw = F.a->in[I_DANORM] + layer * 128 + r32;
            const float w0 = nw[0], w1 = nw[32], w2 = nw[64], w3 = nw[96];
#pragma unroll
            for (int r = 0; r < 16; ++r) {
                const float d0 = O[0][r] - lam * xw[(0 * 16 + r) * 64], d1 = O[1][r] - lam * xw[(1 * 16 + r) * 64], d2 = O[2][r] - lam * xw[(2 * 16 + r) * 64], d3 = O[3][r] - lam * xw[(3 * 16 + r) * 64];
                float ss = (d0 * d0 + d1 * d1) + (d2 * d2 + d3 * d3);
                ss = sum32(ss);
                const float sc2 = (1.0f - lam_init) / sqrtf(ss * (1.0f / 128.0f) + EPS);
                const int qr = (r & 3) + 8 * (r >> 2) + 4 * hi;
                bf16_t* op = MIX + (size_t)(qrow0 + rg * 32 + qr) * D + 512 + h * 128 + r32;
                op[0] = (bf16_t)(cvt_pk_bf16(d0 * sc2 * w0, 0.f) & 0xffffu); op[32] = (bf16_t)(cvt_pk_bf16(d1 * sc2 * w1, 0.f) & 0xffffu);
                op[64] = (bf16_t)(cvt_pk_bf16(d2 * sc2 * w2, 0.f) & 0xffffu); op[96] = (bf16_t)(cvt_pk_bf16(d3 * sc2 * w3, 0.f) & 0xffffu);
            }
        }
    }
    __builtin_amdgcn_s_setprio(0);
    __syncthreads();
}

template <int K>
__device__ __forceinline__ void ctx_gemm_phase(Frame& F, const bf16_t* A, const bf16_t* Bt, bf16_t* C) {
    PHASE_TID();
    LAS float* part = (LAS float*)F.lds;
    const int l16 = lane & 15, g4 = lane >> 4; constexpr int kw = K >> 3;
    for (int tile = F.bid; tile < 256; tile += F.G) {
        const int tm = tile >> 4, tn = tile & 15;
        const bf16_t* ap = A + (size_t)(tm * 64 + l16) * K + wave * kw + 8 * g4;
        const bf16_t* bp = Bt + (size_t)(tn * 64 + l16) * K + wave * kw + 8 * g4;
        f32x4 acc[4][4];
#pragma unroll
        for (int m = 0; m < 4; ++m)
#pragma unroll
            for (int n = 0; n < 4; ++n) { acc[m][n] = (f32x4){0.f, 0.f, 0.f, 0.f}; asm volatile("" : "+v"(acc[m][n])); }
#pragma unroll
        for (int k0 = 0; k0 < kw; k0 += 32) {
            bf16x8 a[4], b[4];
#pragma unroll
            for (int m = 0; m < 4; ++m) { a[m] = __builtin_bit_cast(bf16x8, *(const GAS u32x4*)(ap + (size_t)(16 * m) * K + k0)); b[m] = __builtin_bit_cast(bf16x8, *(const GAS u32x4*)(bp + (size_t)(16 * m) * K + k0)); }
#pragma unroll
            for (int m = 0; m < 4; ++m)
                asm volatile("s_nop 1\n\tv_mfma_f32_16x16x32_bf16 %0, %4, %5, %0\n\tv_mfma_f32_16x16x32_bf16 %1, %4, %6, %1\n\tv_mfma_f32_16x16x32_bf16 %2, %4, %7, %2\n\tv_mfma_f32_16x16x32_bf16 %3, %4, %8, %3\n\ts_nop 7\n\ts_nop 7"
                             : "+v"(acc[m][0]), "+v"(acc[m][1]), "+v"(acc[m][2]), "+v"(acc[m][3]) : "v"(a[m]), "v"(b[0]), "v"(b[1]), "v"(b[2]), "v"(b[3]));
        }
        __syncthreads();
#pragma unroll
        for (int m = 0; m < 4; ++m)
#pragma unroll
            for (int n = 0; n < 4; ++n)
#pragma unroll
                for (int r = 0; r < 4; ++r) part[wave * 4096 + ((m * 4 + n) * 4 + r) * 64 + lane] = acc[m][n][r];
        __syncthreads();
#pragma unroll
        for (int j = 0; j < 8; ++j) { const int idx = tid + 512 * j; float sum = 0.f;
#pragma unroll
            for (int w = 0; w < 8; ++w) sum += part[w * 4096 + idx];
            const int ln = idx & 63, r = (idx >> 6) & 3, mn = idx >> 8, m = mn >> 2, n = mn & 3;
            C[(size_t)(tm * 64 + 16 * m + 4 * (ln >> 4) + r) * D + tn * 64 + 16 * n + (ln & 15)] = (bf16_t)(cvt_pk_bf16(sum, 0.f) & 0xffffu); }
    }
    __syncthreads();
}
constexpr int NPHASE = 25;

#define IN(k) (lo <= (k) && (k) < hi)
#define SEAM(k) do { if (N_LAUNCHES == 1 && (k) + 1 < hi) xcd_barrier(bar); } while (0)
template <int l>
__device__ __forceinline__ void layer_body(Frame& F, const XcdBarrier& bar, const int lo, const int hi) {
    float* XC = (float*)(F.ws + WS_XC);
    bf16_t* HN = (bf16_t*)(F.ws + WS_HN); bf16_t* Pb = (bf16_t*)(F.ws + WS_P); bf16_t* MIX = (bf16_t*)(F.ws + WS_MIX); bf16_t* Yb = (bf16_t*)(F.ws + WS_Y);
    const float* COS = (const float*)(F.ws + WS_SMALL + SM_COS); const float* SIN = (const float*)(F.ws + WS_SMALL + SM_SIN);
        constexpr int pb = 1 + 12 * l; constexpr bool need_ctx = (l == 0); constexpr int nrows = need_ctx ? ROWS : NLAT;
        if (l == 0 && IN(pb + 0)) {
            RowCfg c{F.a->in[I_X], F.a->in[I_CTX], nullptr, nullptr, nullptr, nullptr, 0, 0, F.a->in[I_NPREMIX], 0, 0, 0, 0};
            if (EN(1)) { row_phase<false, false, true, true>(F, c, ROWS); if (REP(1)) { row_phase<false, false, true, true>(F, c, ROWS); } } SEAM(pb + 0); }
        if (IN(pb + 1)) {
            pg8::DenseOrder S; S.init(ROWS, PW, D, (const bf16_t*)(F.ws + WS_WIN) + (size_t)l * PW * D, F.G, F.bid);
            pg8::EpiProj E{Pb, COS, SIN};
            if (EN(2)) { pg8::gemm_phase<pg8::EpiProj, pg8::DenseOrder, true>(F.lds, (const char*)HN, D, S, E); if (REP(2)) { pg8::gemm_phase<pg8::EpiProj, pg8::DenseOrder, true>(F.lds, (const char*)HN, D, S, E); } } SEAM(pb + 1); }
        if (IN(pb + 2)) { if (EN(3)) { kmax_phase(F, l); if (REP(15)) kmax_phase(F, l); mlstm_a_phase(F, l); if (REP(16)) mlstm_a_phase(F, l); hg_a_phase(F, l); if (REP(17)) hg_a_phase(F, l); } SEAM(pb + 2); }
        if (IN(pb + 3)) { if (EN(3)) { mix_scan2_phase(F); if (REP(18)) mix_scan2_phase(F); } SEAM(pb + 3); }
        if (IN(pb + 4)) { if (EN(3)) { mlstm_c_phase(F, l, need_ctx); if (REP(19)) mlstm_c_phase(F, l, need_ctx); hg_c_phase(F, l, need_ctx); if (REP(20)) hg_c_phase(F, l, need_ctx); }
            if (EN(4)) { attn_phase(F, l, need_ctx); if (REP(4)) { attn_phase(F, l, need_ctx); } } SEAM(pb + 4); }

        if (IN(pb + 7)) {
            pg8::DenseOrder S; S.init(NLAT, D, D, (const bf16_t*)(F.ws + WS_WOUT) + (size_t)l * D * D, F.G, F.bid);
            pg8::EpiBf16 E{Yb, D};
            if (EN(6)) { pg8::gemm_phase<pg8::EpiBf16, pg8::DenseOrder, true>(F.lds, (const char*)MIX, D, S, E); if (REP(6)) { pg8::gemm_phase<pg8::EpiBf16, pg8::DenseOrder, true>(F.lds, (const char*)MIX, D, S, E); } }
            if (need_ctx && EN(6)) ctx_gemm_phase<D>(F, MIX + (size_t)NLAT * D, (const bf16_t*)(F.ws + WS_WOUT) + (size_t)l * D * D, Yb + (size_t)NLAT * D);
            SEAM(pb + 7); }
        if constexpr (l == 0) {
            if (IN(pb + 8)) { RowCfg c{F.a->in[I_X], F.a->in[I_CTX], F.out, XC, Yb, F.a->in[I_NPOSTMIX], 0, 2, F.a->in[I_NPREFFN], 0, 3, 0, 1};
                if (EN(7)) { row_phase<true, true, true, false>(F, c, ROWS); if (REP(7)) { row_phase<true, true, true, false>(F, c, ROWS); } } SEAM(pb + 8); }
            if (IN(pb + 9)) { pg8::DenseOrder S; S.init(ROWS, 2 * FF, D, (const bf16_t*)(F.ws + WS_WGU), F.G, F.bid);
                pg8::EpiSwiGLU E{Pb, FF};
                if (EN(8)) { pg8::gemm_phase<pg8::EpiSwiGLU, pg8::DenseOrder, true>(F.lds, (const char*)HN, D, S, E); if (REP(8)) { pg8::gemm_phase<pg8::EpiSwiGLU, pg8::DenseOrder, true>(F.lds, (const char*)HN, D, S, E); } } SEAM(pb + 9); }
            if (IN(pb + 10)) { pg8::DenseOrder S; S.init(NLAT, D, FF, (const bf16_t*)(F.ws + WS_WD), F.G, F.bid);
                pg8::EpiBf16 E{Yb, D};
                if (EN(9)) { pg8::gemm_phase<pg8::EpiBf16, pg8::DenseOrder, true>(F.lds, (const char*)Pb, FF, S, E); if (REP(9)) { pg8::gemm_phase<pg8::EpiBf16, pg8::DenseOrder, true>(F.lds, (const char*)Pb, FF, S, E); } }
                if (EN(9)) ctx_gemm_phase<FF>(F, Pb + (size_t)NLAT * FF, (const bf16_t*)(F.ws + WS_WD), Yb + (size_t)NLAT * D);
                SEAM(pb + 10); }
            if (IN(pb + 11)) { RowCfg c{F.out, XC, F.out, XC, Yb, F.a->in[I_NPOSTFFN], 0, 5, F.a->in[I_NPREMIX] + D, 1, 0, 1, 1};
                if (EN(10)) { row_phase<true, true, true, true>(F, c, ROWS); if (REP(10)) { row_phase<true, true, true, true>(F, c, ROWS); } } SEAM(pb + 11); }
        } else {
            if (IN(pb + 8)) { RowCfg c{F.out, XC, F.out, XC, Yb, F.a->in[I_NPOSTMIX] + D, 1, 2, F.a->in[I_NPREFFN] + D, 1, 3, 1, 1};
                if (EN(11)) { route_phase(F, c); if (REP(11)) { route_phase(F, c); } } SEAM(pb + 8); }
            if (IN(pb + 9)) { pg8::MoeOrder<true> S; S.init(F.ctl + CW_CNT, 2 * FE, D, (const bf16_t*)(F.ws + WS_MOE_GU), (size_t)2 * FE * D, F.ctl + CW_LIST, F.G, F.bid);
                pg8::EpiSwiGLU E{Pb, FE};
                if (EN(12)) { pg8::gemm_phase<pg8::EpiSwiGLU, pg8::MoeOrder<true>, true>(F.lds, (const char*)HN, D, S, E); if (REP(12)) { pg8::gemm_phase<pg8::EpiSwiGLU, pg8::MoeOrder<true>, true>(F.lds, (const char*)HN, D, S, E); } } SEAM(pb + 9); }
            if (IN(pb + 10)) {
                if (EN(13)) { { pg8::MoeDown<0> S; S.init(F.ctl + CW_CNT, (const bf16_t*)(F.ws + WS_MOE_D), (size_t)D * FE, F.G, F.bid); pg8::EpiBf16 E{(bf16_t*)(F.ws + WS_MOE_GU), D};
                        pg8::gemm_phase<pg8::EpiBf16, pg8::MoeDown<0>, true>(F.lds, (const char*)Pb, FE, S, E); }
                    { pg8::MoeDown<1> S; S.init(F.ctl + CW_CNT, (const bf16_t*)(F.ws + WS_MOE_D), (size_t)D * FE, F.G, F.bid); pg8::EpiBf16 E{(bf16_t*)(F.ws + WS_MOE_SIDE), D};
                        pg8::gemm_phase<pg8::EpiBf16, pg8::MoeDown<1>, true>(F.lds, (const char*)Pb, pg8::KSW, S, E, FE); } } SEAM(pb + 10); }
            if (IN(pb + 11)) { RowCfg c{F.out, XC, F.out, XC, nullptr, F.a->in[I_NPOSTFFN] + D, 1, 5, nullptr, 0, 0, 1, 0};
                if (EN(14)) { final_phase(F, c); if (REP(14)) { final_phase(F, c); } } }
        }
    }
__global__ void __launch_bounds__(NTHR, 2) fwd(Args args) {
    extern __shared__ __attribute__((aligned(16))) unsigned char lds_raw[];
    Frame F;
    F.lds = (LAS unsigned char*)lds_raw; F.MISC = (volatile LAS unsigned*)(F.lds + MISC_OFF);
    F.G = gridDim.x; F.bid = blockIdx.x;
    F.a = &args;
    F.out = args.out; F.ws = args.ws; F.ctl = (unsigned*)(args.ws + WS_CTL);
    for (int u = threadIdx.x; u < (LDS_BYTES - LDSCTL_OFF) / 4; u += NTHR) ((LAS unsigned*)(F.lds + LDSCTL_OFF))[u] = 0u;
    __syncthreads();
    XcdBarrier bar; bar.bar = F.ctl + CW_BAR; bar.x = 0; bar.st = nullptr;
    if (N_LAUNCHES == 1) bar = xcd_barrier_post(F.ctl + CW_BAR, F.MISC + 8);
    const int lo = args.ph_lo, hi = args.ph_hi;

    if (IN(0)) { if (EN(0)) { p_mod_vectors(F); p_consts(F); p_weights(F); if (REP(0)) { p_mod_vectors(F); p_consts(F); p_weights(F); } } SEAM(0); }

    layer_body<0>(F, bar, lo, hi);
    layer_body<1>(F, bar, lo, hi);
#undef IN
#undef SEAM
}

extern "C" void kernel_launch(void* const* d_in, const int* in_sizes, int n_in, void* d_out, int out_size, void* d_ws, size_t ws_size, hipStream_t stream) {
    static int grid = 0;
    if (grid == 0) {
        if (n_in != 26 || out_size != NLAT * D || ws_size < WS_END) { fprintf(stderr, "kernel_launch: unexpected shapes: n_in %d out %d ws %zu (need %zu)\n", n_in, out_size, ws_size, (size_t)WS_END); grid = -1; return; }
        int dev = 0, cus = 0, per_cu = 0;
        if (hipGetDevice(&dev) != hipSuccess || hipDeviceGetAttribute(&cus, hipDeviceAttributeMultiprocessorCount, dev) != hipSuccess) { grid = -1; return; }
        if (hipFuncSetAttribute((const void*)fwd, hipFuncAttributeMaxDynamicSharedMemorySize, LDS_BYTES) != hipSuccess) { fprintf(stderr, "kernel_launch: hipFuncSetAttribute failed\n"); grid = -1; return; }
        if (hipOccupancyMaxActiveBlocksPerMultiprocessor(&per_cu, (const void*)fwd, NTHR, LDS_BYTES) != hipSuccess || per_cu < 1) { fprintf(stderr, "kernel_launch: occupancy query says %d\n", per_cu); }
        (void)hipGetLastError();
        grid = cus;
    }
    if (grid < 0) return;
    (void)hipMemsetAsync((char*)d_ws + WS_CTL, 0, CTL_ZERO_BYTES, stream);
    Args a{};
    for (int i = 0; i < 26; ++i) a.in[i] = (const float*)d_in[i];
    a.out = (float*)d_out; a.ws = (unsigned char*)d_ws;
    if (N_LAUNCHES == 1) { a.ph_lo = 0; a.ph_hi = NPHASE; hipLaunchKernelGGL(fwd, dim3(grid), dim3(NTHR), LDS_BYTES, stream, a); }
    else {
        for (int p = 0; p < NPHASE; ++p) { if (p == 13) continue; a.ph_lo = p; a.ph_hi = p + 1; hipLaunchKernelGGL(fwd, dim3(grid), dim3(NTHR), LDS_BYTES, stream, a); }
    }
}
```

```cpp
#include <hip/hip_runtime.h>
#include <cstdio>
#include <cstdint>

#ifndef N_LAUNCHES
#define N_LAUNCHES 1
#endif
#ifndef ENMASK
#define ENMASK 0xffffffffu
#endif
#define EN(b) ((ENMASK >> (b)) & 1u)
#ifndef ATT_DBL
#define ATT_DBL 0
#endif
#ifndef REPMASK
#define REPMASK 0u
#endif
#define REP(b) ((REPMASK >> (b)) & 1u)

#define GAS __attribute__((address_space(1)))
#define LAS __attribute__((address_space(3)))
typedef unsigned short bf16_t;
typedef short bf16x8 __attribute__((ext_vector_type(8)));
typedef float f32x4 __attribute__((ext_vector_type(4)));
typedef float f32x2 __attribute__((ext_vector_type(2)));
typedef unsigned u32x4 __attribute__((ext_vector_type(4)));
typedef unsigned u32x2 __attribute__((ext_vector_type(2)));
typedef float f32x16 __attribute__((ext_vector_type(16)));
typedef short s16x4 __attribute__((ext_vector_type(4)));

constexpr int D = 1024, NB = 4, SEQ = 4096, CTXL = 256, NLAT = NB * SEQ, NCTX = NB * CTXL, ROWS = NLAT + NCTX;
constexpr int PW = 3840;
constexpr int ML_Q = 0, ML_K = 256, ML_V = 512, ML_O = 768, HG_Q = 1024, HG_F = 1280, HG_I = 1792, HG_G = 2048, DA_Q = 2304, DA_K = 2816, DA_V = 3328;
constexpr int WIN_LD = 3856;
constexpr int FF = 2816, FE = 3584, NE = 8;
constexpr int NKEYS = SEQ + CTXL;
constexpr float EPS = 1e-6f;
constexpr float LOG2E = 1.4426950408889634f;
constexpr float C2 = 0.125f * LOG2E;
constexpr int NWAVES = 8, NTHR = 512;

constexpr size_t MiB = 1u << 20;
constexpr size_t WS_CTL = 0, CTL_ZERO_BYTES = 2 * MiB;
constexpr size_t WS_SMALL = 2 * MiB;
constexpr size_t WS_WIN = 3 * MiB;
constexpr size_t WS_WOUT = 18 * MiB;
constexpr size_t WS_WGU = 22 * MiB;
constexpr size_t WS_WD = 33 * MiB;
constexpr size_t WS_XC = 39 * MiB;
constexpr size_t WS_MOE_SIDE = 43 * MiB;
constexpr size_t WS_HN = 43 * MiB;
constexpr size_t WS_GATES = 77 * MiB;
constexpr size_t WS_ROUTE = 79 * MiB;
constexpr size_t WS_MOE_D = 80 * MiB;
constexpr size_t WS_MOE_GU = 136 * MiB;
constexpr size_t WS_P = 248 * MiB;
constexpr size_t WS_MIX = 376 * MiB;
constexpr size_t WS_Y = 410 * MiB;
constexpr size_t WS_SCR = 444 * MiB;
constexpr size_t WS_END = 512 * MiB;
constexpr int MOE_ROWS_MAX = 34816;
constexpr int CW_BAR = 4096;
constexpr int CW_CNT = 8192;
constexpr int CW_LIST = 65536;
static_assert((CW_LIST + NE * NLAT) * 4 <= (int)CTL_ZERO_BYTES, "ctl");
constexpr size_t SM_MODV = 0, SM_COS = 256 * 1024, SM_SIN = 260 * 1024, SM_CONST = 264 * 1024, SM_LB = 268 * 1024;

constexpr int RING_BYTES = 131072, LDSCTL_OFF = RING_BYTES, MISC_OFF = LDSCTL_OFF + 320, LDS_BYTES = 147456;

#define RLX_AGENT __ATOMIC_RELAXED, __HIP_MEMORY_SCOPE_AGENT
#define PHASE_TID() int tid = threadIdx.x; asm volatile("" : "+v"(tid)); const int lane = tid & 63; const int wave = __builtin_amdgcn_readfirstlane(tid >> 6); (void)lane; (void)wave
#define LDS_WAIT() asm volatile("s_waitcnt lgkmcnt(0)" ::: "memory")
#define VM_WAIT() asm volatile("s_waitcnt vmcnt(0)" ::: "memory")
typedef float f32x2_t __attribute__((ext_vector_type(2))); typedef __bf16 bf16x2_t __attribute__((ext_vector_type(2)));
__device__ __forceinline__ unsigned cvt_pk_bf16(float lo, float hi) { const f32x2_t v = {lo, hi}; const bf16x2_t b = __builtin_convertvector(v, bf16x2_t); unsigned r = __builtin_bit_cast(unsigned, b); asm volatile("" : "+v"(r)); return r; }
__device__ __forceinline__ unsigned cvtpk_s(float lo, float hi) { const f32x2_t v = {lo, hi}; const bf16x2_t b = __builtin_convertvector(v, bf16x2_t); return __builtin_bit_cast(unsigned, b); }
__device__ __forceinline__ float dot2_ones(unsigned w, float acc) { return __builtin_amdgcn_fdot2_f32_bf16(__builtin_bit_cast(bf16x2_t, w), __builtin_bit_cast(bf16x2_t, 0x3F803F80u), acc, false); }
__device__ __forceinline__ float bf_lo(unsigned w) { return __uint_as_float(w << 16); }
__device__ __forceinline__ float bf_hi(unsigned w) { return __uint_as_float(w & 0xffff0000u); }
__device__ __forceinline__ float bf2f(bf16_t v) { return __uint_as_float((unsigned)v << 16); }
template <int CTRL, int ROWMASK>
__device__ __forceinline__ float dpp_get(float v) { return __int_as_float(__builtin_amdgcn_update_dpp(0, __float_as_int(v), CTRL, ROWMASK, 0xF, false)); }
__device__ __forceinline__ float sum8(float v) { v += dpp_get<0xB1, 0xF>(v); v += dpp_get<0x4E, 0xF>(v); v += dpp_get<0x141, 0xF>(v); return v; }
__device__ __forceinline__ float sum16(float v) { v = sum8(v); v += dpp_get<0x140, 0xF>(v); return v; }
__device__ __forceinline__ float sum32(float v) { v = sum16(v); const auto r = __builtin_amdgcn_permlane16_swap(__float_as_uint(v), __float_as_uint(v), false, false); return __uint_as_float(r[0]) + __uint_as_float(r[1]); }
__device__ __forceinline__ float wave_sum(float v) {
    v += dpp_get<0xB1, 0xF>(v); v += dpp_get<0x4E, 0xF>(v); v += dpp_get<0x141, 0xF>(v); v += dpp_get<0x140, 0xF>(v);
    v += dpp_get<0x142, 0xA>(v); v += dpp_get<0x143, 0xC>(v);
    return __int_as_float(__builtin_amdgcn_readlane(__float_as_int(v), 63)); }
__device__ __forceinline__ float fast_exp2(float x) { return __builtin_amdgcn_exp2f(x); }
__device__ __forceinline__ float fast_rcp(float x) { return __builtin_amdgcn_rcpf(x); }
__device__ __forceinline__ float sigmoidf_(float x) { return 1.0f / (1.0f + __expf(-x)); }
__device__ __forceinline__ float siluf_(float x) { return x / (1.0f + __expf(-x)); }
__device__ __forceinline__ float log_sigmoidf_(float x) { return fminf(x, 0.f) - log1pf(__expf(-fabsf(x))); }

#define XB_TMO      128
#define XB_XCNT(j)  (256  + 64 * (j))
#define XB_XSUB(j)  (1280 + 64 * (j))
#define XB_XGEN(j)  (2304 + 64 * (j))
#define XB_TOP      3328
#define XB_TOPGEN   3392
#define XCD_BAR_WORDS 3456
#define XB_SPIN_CAP (1u << 18)
__device__ __forceinline__ unsigned xb_ld(unsigned* p)              { return __hip_atomic_load(p, __ATOMIC_RELAXED, __HIP_MEMORY_SCOPE_AGENT); }
__device__ __forceinline__ unsigned xb_add(unsigned* p, unsigned v) { return __hip_atomic_fetch_add(p, v, __ATOMIC_RELAXED, __HIP_MEMORY_SCOPE_AGENT); }
__device__ __forceinline__ unsigned xb_xcc_id() { return (unsigned)__builtin_amdgcn_s_getreg((3 << 11) | 20) & 0xFu; }
#define XB_SPIN(cond, bar) do { unsigned _sp = 0; while (cond) { __builtin_amdgcn_s_sleep(1); \
    if ((++_sp & 255u) == 0u) { if (xb_ld(&(bar)[XB_TMO])) break; if (_sp > XB_SPIN_CAP) { atomicAdd(&(bar)[XB_TMO], 1u); break; } } } } while (0)
struct XcdBarrier { unsigned* bar; unsigned x; volatile LAS unsigned* st; };
__device__ __forceinline__ XcdBarrier xcd_barrier_post(unsigned* bar, volatile LAS unsigned* st) {
    XcdBarrier b; b.bar = bar; b.x = xb_xcc_id(); b.st = st;
    if (threadIdx.x == 0) (void)xb_add(&bar[XB_XCNT(b.x)], 1u);
    return b;
}
__device__ __forceinline__ void xcd_barrier_complete(unsigned* bar, unsigned x, unsigned& nloc, unsigned& nx) {
    const unsigned G = gridDim.x * gridDim.y * gridDim.z;
    unsigned sum, cnt, mine, sp = 0u;
    for (;;) {
        sum = 0u; cnt = 0u; mine = 0u;
#pragma unroll
        for (unsigned j = 0; j < 16; ++j) { const unsigned c = xb_ld(&bar[XB_XCNT(j)]); sum += c; cnt += (c > 0u) ? 1u : 0u; mine = (j == x) ? c : mine; }
        if (sum == G) break;
        __builtin_amdgcn_s_sleep(1);
        if ((++sp & 255u) == 0u) { if (xb_ld(&bar[XB_TMO])) break; if (sp > XB_SPIN_CAP) { atomicAdd(&bar[XB_TMO], 1u); break; } }
    }
    nloc = mine > 0u ? mine : 1u; nx = cnt > 0u ? cnt : 1u;
}
__device__ __forceinline__ void xcd_barrier(const XcdBarrier& b) {
    asm volatile("s_waitcnt vmcnt(0)" ::: "memory");
    __syncthreads();
    if (threadIdx.x == 0) {
        unsigned* bar = b.bar;
        __builtin_amdgcn_s_waitcnt(0);
        unsigned nloc = b.st[0], nx = b.st[1];
        if (nloc == 0u) { xcd_barrier_complete(bar, b.x, nloc, nx); b.st[0] = nloc; b.st[1] = nx; }
        const unsigned old = xb_add(&bar[XB_XSUB(b.x)], 1u);
        const unsigned gen = old / nloc;
        if (old + 1u == (gen + 1u) * nloc) {
            __builtin_amdgcn_fence(__ATOMIC_RELEASE, "agent");
            asm volatile("s_waitcnt vmcnt(0)" ::: "memory");
            const unsigned og = xb_add(&bar[XB_TOP], 1u);
            const unsigned tg = og / nx;
            if (og + 1u == (tg + 1u) * nx) xb_add(&bar[XB_TOPGEN], 1u);
            else XB_SPIN(xb_ld(&bar[XB_TOPGEN]) == tg, bar);
            __builtin_amdgcn_fence(__ATOMIC_ACQUIRE, "agent");
            xb_add(&bar[XB_XGEN(b.x)], 1u);
            asm volatile("s_waitcnt vmcnt(0)" ::: "memory");
        } else {
            XB_SPIN(xb_ld(&bar[XB_XGEN(b.x)]) == gen, bar);
            __builtin_amdgcn_fence(__ATOMIC_ACQUIRE, "agent");
            asm volatile("s_waitcnt vmcnt(0)" ::: "memory");
        }
    }
    __syncthreads();
}

namespace pg8 {
constexpr int BM = 256, BK = 64, HALF = 128, HTB = HALF * BK * 2, STAGE_BYTES = 8 * HTB, NXCD = 8, WGM = 8;
__host__ __device__ __forceinline__ int lds_byte(int r, int c) { const int st = (r >> 4) * 2 + (c >> 5), rr = r & 15, cc = c & 31, ob = rr * 64 + cc * 2; return st * 1024 + (ob ^ (((ob >> 9) & 1) << 5)); }
__host__ __device__ __forceinline__ void stage_rc(int b, int& R, int& C) { const int st = b / 1024, sb = b % 1024, swz = sb ^ (((sb >> 9) & 1) << 5); R = (st >> 1) * 16 + swz / 64; C = (st & 1) * 32 + (swz % 64) / 2; }
__host__ __device__ __forceinline__ int perm32(int rho) { const int n = rho >> 4, i = rho & 15; return 8 * (i >> 2) + 4 * n + (i & 3); }

struct Unit { int pm, pn, e, lt; };

__device__ __forceinline__ int xcd_remap(int wgid, int nwg) { const int q = nwg / NXCD, r = nwg % NXCD, xcd = wgid % NXCD, off = wgid / NXCD; return (xcd < r ? xcd * (q + 1) : r * (q + 1) + (xcd - r) * q) + off; }

struct DenseOrder {
    static constexpr bool GATHER = false;
    int nM, nN, nwg, G, c, K; const char* Bt;
    __device__ __forceinline__ void init(int M, int N, int K_, const bf16_t* Bt_, int G_, int c_) { nM = M / BM; nN = N / BM; nwg = nM * nN; G = G_; c = c_; K = K_; Bt = (const char*)Bt_; }
    __device__ __forceinline__ bool next(int i, Unit& u) const {
        const long L = (long)i * G + c; if (L >= nwg) return false;
        const int wgid = xcd_remap((int)L, nwg);
        const int nig = WGM * nN, gid = wgid / nig, fm = gid * WGM, gsz = (nM - fm) < WGM ? (nM - fm) : WGM;
        u.pm = fm + ((wgid % nig) % gsz); u.pn = (wgid % nig) / gsz; u.e = 0; u.lt = 0; return true;
    }
    __device__ __forceinline__ void a_offsets(const Unit&, const int (&)[2], const int (&)[2], unsigned (&)[2][2]) const {}
    __device__ __forceinline__ size_t a_tile(const Unit& u) const { return (size_t)u.pm * BM * K * 2; }
    __device__ __forceinline__ const char* b_ptr(const Unit& u) const { return Bt + (size_t)u.pn * BM * K * 2; }
};

template <bool GATHER_> struct MoeOrder {
    static constexpr bool GATHER = GATHER_;
    int tb[9]; int nN, nU, G, c, K; const char* Bt; size_t bstride; const unsigned* list;
    __device__ __forceinline__ void init(const unsigned* cnt_words, int N, int K_, const bf16_t* Bt_, size_t bstride_elems, const unsigned* list_, int G_, int c_) {
        int acc = 0;
#pragma unroll
        for (int e = 0; e < 8; ++e) { tb[e] = acc; const int ce = __builtin_amdgcn_readfirstlane((int)__hip_atomic_load(cnt_words + 64 * e, RLX_AGENT)); acc += (ce + 255) >> 8; }
        tb[8] = acc; nN = N / BM; nU = acc * nN; G = G_; c = c_; K = K_; Bt = (const char*)Bt_; bstride = bstride_elems * 2; list = list_;
    }
    __device__ __forceinline__ bool next(int i, Unit& u) const {
        const long L = (long)i * G + c; if (L >= nU) return false;
        const int wgid = xcd_remap((int)L, nU);
        int e = 0, t0 = 0, t1 = tb[1];
#pragma unroll
        for (int k = 1; k < 8; ++k) { if (wgid >= tb[k] * nN) { e = k; t0 = tb[k]; t1 = tb[k + 1]; } }
        const int local = wgid - t0 * nN, te = t1 - t0;
        u.pn = local / te; u.lt = local % te; u.pm = t0 + u.lt; u.e = e; return true;
    }
    __device__ __forceinline__ void a_offsets(const Unit& u, const int (&R)[2], const int (&C)[2], unsigned (&o)[2][2]) const {
#pragma unroll
        for (int h = 0; h < 2; ++h)
#pragma unroll
            for (int i = 0; i < 2; ++i) {
                if (GATHER) { const unsigned tok = list[(size_t)u.e * NLAT + u.lt * BM + h * HALF + R[i]]; o[h][i] = (unsigned)(((size_t)tok * K + C[i]) * 2); }
            }
    }
    __device__ __forceinline__ size_t a_tile(const Unit& u) const { return (size_t)u.pm * BM * K * 2; }
    __device__ __forceinline__ const char* b_ptr(const Unit& u) const { return Bt + (size_t)u.e * bstride + (size_t)u.pn * BM * K * 2; }
};

constexpr int KSW = 512, KSL = FE / KSW;
static_assert(KSL * KSW == FE && (KSW / BK) % 2 == 0, "K slices");
template <int MODE> struct MoeDown {
    static constexpr bool GATHER = false;
    int tb[9]; unsigned pmask; int nN, nU, G, c; const char* Bt; size_t bstride;
    __device__ __forceinline__ void init(const unsigned* cnt_words, const bf16_t* Bt_, size_t bstride_elems, int G_, int c_) {
        int acc = 0, accf = 0; unsigned pm_ = 0u;
#pragma unroll
        for (int e = 0; e < 8; ++e) { tb[e] = acc | (accf << 16); const int ce = __builtin_amdgcn_readfirstlane((int)__hip_atomic_load(cnt_words + 64 * e, RLX_AGENT)); acc += (ce + 255) >> 8; accf += ce >> 8; pm_ |= (ce & 255) ? (1u << e) : 0u; }
        tb[8] = acc | (accf << 16); pmask = pm_; nN = D / BM; G = G_; c = c_; Bt = (const char*)Bt_; bstride = bstride_elems * 2;
        nU = MODE == 0 ? accf * nN : __builtin_popcount(pm_) * nN * KSL;
    }
    __device__ __forceinline__ bool next(int i, Unit& u) const {
        const long L = (long)i * G + (MODE == 0 ? c : G - 1 - c); if (L >= nU) return false;
        if (MODE == 0) {
            const int wgid = xcd_remap((int)L, nU);
            int e = 0, f0 = 0, f1 = tb[1] >> 16, t0 = 0;
#pragma unroll
            for (int k = 1; k < 8; ++k) { if (wgid >= (tb[k] >> 16) * nN) { e = k; f0 = tb[k] >> 16; f1 = tb[k + 1] >> 16; t0 = tb[k] & 0xffff; } }
            const int local = wgid - f0 * nN, te = f1 - f0;
            u.pn = local / te; u.lt = t0 + local % te; u.pm = u.lt; u.e = e; return true;
        } else {
            const int wgid = (int)L, pidx = wgid / (nN * KSL), rem = wgid - pidx * (nN * KSL), ks = rem / nN;
            int e = 0, lt = 0, seen = 0;
#pragma unroll
            for (int k = 0; k < 8; ++k) { if ((pmask >> k) & 1u) { if (seen == pidx) { e = k; lt = (tb[k] & 0xffff) + ((tb[k + 1] >> 16) - (tb[k] >> 16)); } ++seen; } }
            u.pn = rem - ks * nN; u.lt = lt; u.pm = ks * 8 + e; u.e = e | (ks << 8); return true;
        }
    }
    __device__ __forceinline__ void a_offsets(const Unit&, const int (&)[2], const int (&)[2], unsigned (&)[2][2]) const {}
    __device__ __forceinline__ size_t a_tile(const Unit& u) const { return (size_t)u.lt * BM * FE * 2 + (MODE == 0 ? (size_t)0 : (size_t)(u.e >> 8) * KSW * 2); }
    __device__ __forceinline__ const char* b_ptr(const Unit& u) const { return Bt + (size_t)(u.e & 255) * bstride + (size_t)u.pn * BM * FE * 2 + (MODE == 0 ? (size_t)0 : (size_t)(u.e >> 8) * KSW * 2); }
};

__device__ __forceinline__ u32x4 widen16(u32x2 p0, u32x2 p1) {
    const auto a = __builtin_amdgcn_permlane16_swap(p0.x, p1.x, false, false); const auto b = __builtin_amdgcn_permlane16_swap(p0.y, p1.y, false, false);
    return (u32x4){a[0], b[0], a[1], b[1]}; }
struct EpiBf16 {
    static constexpr bool PERM = true;
    bf16_t* O; int ldc;
    __device__ __forceinline__ void operator()(const f32x4 (&acc)[2][2][4][2], const Unit& u, int wr, int wc, int fr, int fq) const {
        const int row0 = u.pm * BM + wr * 64 + fr; const int col0 = u.pn * BM + wc * 32 + 8 * fq;
#pragma unroll
        for (int ai = 0; ai < 2; ++ai)
#pragma unroll
            for (int m = 0; m < 4; ++m) { bf16_t* rowp = O + (size_t)(row0 + ai * HALF + m * 16) * ldc + col0;
#pragma unroll
                for (int bj = 0; bj < 2; ++bj) { const f32x4 v0 = acc[ai][bj][m][0], v1 = acc[ai][bj][m][1];
                    u32x4 w; w.x = cvt_pk_bf16(v0[0], v0[1]); w.y = cvt_pk_bf16(v0[2], v0[3]); w.z = cvt_pk_bf16(v1[0], v1[1]); w.w = cvt_pk_bf16(v1[2], v1[3]);
                    *(u32x4*)(rowp + bj * HALF) = w; } }
    }
};
struct EpiProj {
    static constexpr bool PERM = false;
    bf16_t* O; const float* cosT; const float* sinT;
    __device__ __forceinline__ void operator()(const f32x4 (&acc)[2][2][4][2], const Unit& u, int wr, int wc, int fr, int fq) const {
        const int row0 = u.pm * BM + wr * 64 + fr; const int col0 = u.pn * BM + wc * 32 + 4 * fq;
        const int wofs = (fq & 1) ? 12 : 0;
        const bool rope = (u.pn >= 9) && (u.pn <= 12) && (u.pm < NLAT / BM);
#pragma unroll
        for (int ai = 0; ai < 2; ++ai)
#pragma unroll
            for (int m = 0; m < 4; ++m) { const int row = row0 + ai * HALF + m * 16; bf16_t* rowp = O + (size_t)row * PW + col0;
                const int l = row & (SEQ - 1);
#pragma unroll
                for (int bj = 0; bj < 2; ++bj) { f32x4 t1 = acc[ai][bj][m][0], t2 = acc[ai][bj][m][1];
                    if (rope) { const int axis = ((col0 + bj * HALF) >> 5) & 1; const int pos = axis ? (l & 63) : (l >> 6);
                        const f32x4 cs = *(const f32x4*)(cosT + pos * 16 + 4 * fq), sn = *(const f32x4*)(sinT + pos * 16 + 4 * fq);
                        const f32x4 o1 = t1 * cs - t2 * sn, o2 = t1 * sn + t2 * cs; t1 = o1; t2 = o2; }
                    u32x2 w1, w2; w1.x = cvt_pk_bf16(t1[0], t1[1]); w1.y = cvt_pk_bf16(t1[2], t1[3]); w2.x = cvt_pk_bf16(t2[0], t2[1]); w2.y = cvt_pk_bf16(t2[2], t2[3]);
                    *(u32x4*)(rowp + bj * HALF + wofs) = widen16(w1, w2); } }
    }
};
struct EpiSwiGLU {
    static constexpr bool PERM = false;
    bf16_t* O; int ldc;
    __device__ __forceinline__ void operator()(const f32x4 (&acc)[2][2][4][2], const Unit& u, int wr, int wc, int fr, int fq) const {
        const int row0 = u.pm * BM + wr * 64 + fr;
#pragma unroll
        for (int ai = 0; ai < 2; ++ai)
#pragma unroll
            for (int m = 0; m < 4; ++m) { bf16_t* rowp = O + (size_t)(row0 + ai * HALF + m * 16) * ldc + u.pn * 128 + 4 * fq;
                u32x2 w[2];
#pragma unroll
                for (int bj = 0; bj < 2; ++bj) { const f32x4 g = acc[ai][bj][m][0], up = acc[ai][bj][m][1]; f32x4 h;
#pragma unroll
                    for (int j = 0; j < 4; ++j) h[j] = g[j] * fast_rcp(1.0f + fast_exp2(-LOG2E * g[j])) * up[j];
                    w[bj].x = cvt_pk_bf16(h[0], h[1]); w[bj].y = cvt_pk_bf16(h[2], h[3]); }
                *(u32x4*)(rowp + ((fq & 1) ? (4 + wc) * 16 - 4 : wc * 16)) = widen16(w[0], w[1]); }
    }
};

template <class Epi, class Sched, bool ALIGN_EPI>
__device__ __forceinline__ void gemm_phase(LAS unsigned char* lds, const char* Abase, const int K, const Sched& S, const Epi& E, const int LD_ = 0) {
    int tid = threadIdx.x; asm volatile("" : "+v"(tid));
    const int wid = __builtin_amdgcn_readfirstlane(tid >> 6), lane = tid & 63, wr = wid >> 2, wc = wid & 3, fr = lane & 15, fq = lane >> 4;
    const int nt = K / BK, LD = LD_ ? LD_ : K;
    constexpr bool GA = Sched::GATHER;
    int Rr[2], Cc[2]; unsigned voffA[2], voffB[2];
#pragma unroll
    for (int i = 0; i < 2; ++i) { int R, C; stage_rc(tid * 16 + i * 8192, R, C); const int Rb = Epi::PERM ? ((R & ~31) + perm32(R & 31)) : R; Rr[i] = R; Cc[i] = C; voffA[i] = (unsigned)(R * LD + C) * 2u; voffB[i] = (unsigned)(Rb * LD + C) * 2u; }
    const size_t kstep = (size_t)(BK * 2);
    const size_t hstep = (size_t)HALF * LD * 2;
    const unsigned ldsw = (unsigned)wid * 1024u;
    const int aoff = lds_byte(wr * 64 + fr, fq * 8), boff = lds_byte(wc * 32 + fr, fq * 8);
#define PG8_SA(b, h) (((b) * 2 + (h)) * HTB)
#define PG8_SB(b, h) ((4 + (b) * 2 + (h)) * HTB)
#define PG8_STAGE(bufoff, gbase, voff) do { _Pragma("unroll") for (int _i = 0; _i < 2; ++_i) \
        __builtin_amdgcn_global_load_lds((const unsigned*)((const char*)(gbase) + (voff)[_i]), (LAS unsigned*)(lds + (bufoff) + ldsw + _i * 8192), 16, 0, 0); } while (0)
#define PG8_STAGE_A(bufoff, uptr, oarr, h, kofs) do { if constexpr (GA) { PG8_STAGE(bufoff, Abase + (kofs), (oarr)[h]); } else { PG8_STAGE(bufoff, (uptr) + (h) * hstep + (kofs), voffA); } } while (0)
#define PG8_LDA(dst, b, h) do { _Pragma("unroll") for (int m = 0; m < 4; ++m) _Pragma("unroll") for (int k = 0; k < 2; ++k) dst[m][k] = *(const LAS bf16x8*)(lds + PG8_SA(b, h) + aoff + m * 2048 + k * 1024); } while (0)
#define PG8_LDB(dst, b, h) do { _Pragma("unroll") for (int n = 0; n < 2; ++n) _Pragma("unroll") for (int k = 0; k < 2; ++k) dst[n][k] = *(const LAS bf16x8*)(lds + PG8_SB(b, h) + boff + n * 2048 + k * 1024); } while (0)
#define PG8_MMA(ai, bj, At, Bt) do { __builtin_amdgcn_s_setprio(1); _Pragma("unroll") for (int m = 0; m < 4; ++m) _Pragma("unroll") for (int n = 0; n < 2; ++n) _Pragma("unroll") for (int k = 0; k < 2; ++k) \
        acc[ai][bj][m][n] = __builtin_amdgcn_mfma_f32_16x16x32_bf16(Bt[n][k], At[m][k], acc[ai][bj][m][n], 0, 0, 0); __builtin_amdgcn_s_setprio(0); } while (0)
#define PG8_WAIT_V(n) asm volatile("s_waitcnt vmcnt(" #n ")" ::: "memory")
#define PG8_WAIT_L(n) asm volatile("s_waitcnt lgkmcnt(" #n ")" ::: "memory")
#define PG8_BAR __builtin_amdgcn_s_barrier()
#define PG8_SCHED __builtin_amdgcn_sched_barrier(0)
    Unit cur, nxt; int ui = 0;
    if (!S.next(0, cur)) return;
    f32x4 acc[2][2][4][2];
#pragma unroll
    for (int a = 0; a < 2; ++a)
#pragma unroll
        for (int b = 0; b < 2; ++b)
#pragma unroll
            for (int m = 0; m < 4; ++m)
#pragma unroll
                for (int n = 0; n < 2; ++n) acc[a][b][m][n] = (f32x4){0.f, 0.f, 0.f, 0.f};
    bf16x8 At[4][2], B0[2][2], B1[2][2];
    unsigned oA[2][2], oN[2][2];
    if constexpr (GA) S.a_offsets(cur, Rr, Cc, oA);
    const char* cA = Abase + S.a_tile(cur);
    const char* cB = S.b_ptr(cur);
    PG8_STAGE(PG8_SB(0, 0), cB, voffB); PG8_STAGE(PG8_SB(0, 1), cB + hstep, voffB); PG8_STAGE_A(PG8_SA(0, 0), cA, oA, 0, 0); PG8_STAGE_A(PG8_SA(0, 1), cA, oA, 1, 0);
    if (wr == 1) PG8_BAR;
    PG8_WAIT_V(2); PG8_BAR;
    PG8_STAGE(PG8_SB(1, 0), cB + kstep, voffB); PG8_STAGE_A(PG8_SA(1, 0), cA, oA, 0, kstep); PG8_STAGE(PG8_SB(1, 1), cB + hstep + kstep, voffB);
    PG8_WAIT_V(6); PG8_BAR;
    for (;;) {
        const bool has_next = S.next(ui + 1, nxt);
        const char* nB = cB; const char* nA = cA;
        if (has_next) { if constexpr (GA) S.a_offsets(nxt, Rr, Cc, oN); nB = S.b_ptr(nxt); nA = Abase + S.a_tile(nxt); }
        else if constexpr (GA) {
#pragma unroll
            for (int h = 0; h < 2; ++h)
#pragma unroll
                for (int i = 0; i < 2; ++i) oN[h][i] = oA[h][i];
        }
        for (int t = 0; t < nt; t += 2) {
            const bool last = (t == nt - 2);
            const size_t k1 = (size_t)(t + 1) * kstep, k2 = last ? (size_t)0 : (size_t)(t + 2) * kstep, k3 = k2 + kstep;
            const char* ua = last ? nA : cA; const char* b2 = last ? nB : cB + (size_t)(t + 2) * kstep; const char* b3 = b2 + kstep;
            unsigned o2[2][2];
            if constexpr (GA) {
#pragma unroll
                for (int h = 0; h < 2; ++h)
#pragma unroll
                    for (int i = 0; i < 2; ++i) o2[h][i] = last ? oN[h][i] : oA[h][i];
            }
            PG8_LDB(B0, 0, 0); PG8_LDB(B1, 0, 1); PG8_SCHED; PG8_LDA(At, 0, 0); PG8_STAGE_A(PG8_SA(1, 1), cA, oA, 1, k1);
            PG8_WAIT_V(8); PG8_WAIT_L(0); PG8_BAR; PG8_MMA(0, 0, At, B0); PG8_MMA(0, 1, At, B1); PG8_BAR; PG8_SCHED;
            PG8_LDA(At, 0, 1); PG8_STAGE(PG8_SB(0, 0), b2, voffB); PG8_STAGE(PG8_SB(0, 1), b2 + hstep, voffB); PG8_STAGE_A(PG8_SA(0, 0), ua, o2, 0, k2);
            PG8_WAIT_V(8); PG8_WAIT_L(0); PG8_BAR; PG8_MMA(1, 0, At, B0); PG8_MMA(1, 1, At, B1); PG8_BAR; PG8_SCHED;
            PG8_LDB(B0, 1, 0); PG8_LDB(B1, 1, 1); PG8_SCHED; PG8_LDA(At, 1, 0); PG8_STAGE_A(PG8_SA(0, 1), ua, o2, 1, k2);
            PG8_WAIT_V(8); PG8_WAIT_L(0); PG8_BAR; PG8_MMA(0, 0, At, B0); PG8_MMA(0, 1, At, B1); PG8_BAR; PG8_SCHED;
            PG8_LDA(At, 1, 1); PG8_STAGE(PG8_SB(1, 0), b3, voffB); PG8_STAGE(PG8_SB(1, 1), b3 + hstep, voffB); PG8_STAGE_A(PG8_SA(1, 0), ua, o2, 0, k3);
            PG8_WAIT_V(8); PG8_WAIT_L(0); PG8_BAR; PG8_MMA(1, 0, At, B0); PG8_MMA(1, 1, At, B1); PG8_BAR; PG8_SCHED;
        }
        if constexpr (ALIGN_EPI) { if (wr == 0) PG8_BAR; }
        E(acc, cur, wr, wc, fr, fq);
        if (!has_next) break;
#pragma unroll
        for (int a = 0; a < 2; ++a)
#pragma unroll
            for (int b = 0; b < 2; ++b)
#pragma unroll
                for (int m = 0; m < 4; ++m)
#pragma unroll
                    for (int n = 0; n < 2; ++n) acc[a][b][m][n] = (f32x4){0.f, 0.f, 0.f, 0.f};
        cur = nxt; cB = nB; cA = nA; ++ui;
        if constexpr (GA) {
#pragma unroll
            for (int h = 0; h < 2; ++h)
#pragma unroll
                for (int i = 0; i < 2; ++i) oA[h][i] = oN[h][i];
        }
        if constexpr (ALIGN_EPI) { if (wr == 1) PG8_BAR; }
    }
    PG8_WAIT_V(0);
    if constexpr (!ALIGN_EPI) { if (wr == 0) PG8_BAR; }
    PG8_BAR;
#undef PG8_SA
#undef PG8_SB
#undef PG8_STAGE
#undef PG8_STAGE_A
#undef PG8_LDA
#undef PG8_LDB
#undef PG8_MMA
#undef PG8_WAIT_V
#undef PG8_WAIT_L
#undef PG8_BAR
#undef PG8_SCHED
}
}

struct Args { const float* in[26]; float* out; unsigned char* ws; int ph_lo, ph_hi; };
struct Frame {
    LAS unsigned char* lds;
    volatile LAS unsigned* MISC;
    unsigned* ctl;
    int G, bid;
    const struct Args* a;
    float* out; unsigned char* ws;
};
enum { I_X = 0, I_C, I_CTX, I_CCTX, I_WMOD, I_BMOD, I_NPREMIX, I_NPOSTMIX, I_NPREFFN, I_NPOSTFFN, I_WIN, I_WOUT, I_MLGB, I_MLNORM, I_HGLB, I_HGNORM, I_DALAM, I_DANORM,
       I_FWG, I_FWU, I_FWD, I_RW, I_RB, I_MWG, I_MWU, I_MWD };

__device__ __forceinline__ void transpose_item(const float* colptr, float scale, int ld, int K, bf16_t* WT, int n0, int k0, LAS float* scr, int lane) {
#pragma unroll 8
    for (int i = 0; i < 32; ++i) { const int kk = 2 * i + (lane >> 5); scr[kk * 33 + (lane & 31)] = colptr[(size_t)(k0 + kk) * ld] * scale; }
    LDS_WAIT(); asm volatile("" ::: "memory");
    const int c = lane & 7;
#pragma unroll
    for (int j = 0; j < 4; ++j) { const int n = (lane >> 3) + 8 * j; const LAS float* s = scr + (8 * c) * 33 + n;
        u32x4 o; o.x = cvt_pk_bf16(s[0 * 33], s[1 * 33]); o.y = cvt_pk_bf16(s[2 * 33], s[3 * 33]); o.z = cvt_pk_bf16(s[4 * 33], s[5 * 33]); o.w = cvt_pk_bf16(s[6 * 33], s[7 * 33]);
        *(GAS u32x4*)(WT + (size_t)(n0 + n) * K + k0 + 8 * c) = o; }
    LDS_WAIT(); asm volatile("" ::: "memory");
}
__device__ __forceinline__ void p_mod_vectors(Frame& F) {
    PHASE_TID();
    if (F.bid >= 192) return;
    LAS float* sv = (LAS float*)(F.lds);
    LAS float* red = (LAS float*)(F.lds + 20480);
    for (int idx = tid; idx < 5 * D; idx += NTHR) { const int r = idx >> 10, k = idx & 1023; const float v = r < 4 ? F.a->in[I_C][r * D + k] : F.a->in[I_CCTX][k]; sv[idx] = siluf_(v); }
    __syncthreads();
    const int l = F.bid / 96, cb = (F.bid % 96) * 64;
    const float* W = F.a->in[I_WMOD] + (size_t)l * D * 6144 + cb + lane;
    float a[5] = {0.f, 0.f, 0.f, 0.f, 0.f};
    const int kb = wave * 128;
#pragma unroll 4
    for (int k = 0; k < 128; ++k) { const float wv = W[(size_t)(kb + k) * 6144];
#pragma unroll
        for (int r = 0; r < 5; ++r) a[r] += sv[r * 1024 + kb + k] * wv; }
#pragma unroll
    for (int r = 0; r < 5; ++r) red[(wave * 5 + r) * 64 + lane] = a[r];
    __syncthreads();
    if (tid < 320) { const int r = tid >> 6, ln = tid & 63; float s = 0.f;
#pragma unroll
        for (int w = 0; w < 8; ++w) s += red[(w * 5 + r) * 64 + ln];
        float* MODV = (float*)(F.ws + WS_SMALL + SM_MODV);
        MODV[(size_t)(l * 5 + r) * 6144 + cb + ln] = s + F.a->in[I_BMOD][l * 6144 + cb + ln]; }
    __syncthreads();
}
__device__ __forceinline__ void p_consts(Frame& F) {
    PHASE_TID();
    if (F.bid != 255 % F.G) return;
    float* COS = (float*)(F.ws + WS_SMALL + SM_COS); float* SIN = (float*)(F.ws + WS_SMALL + SM_SIN);
    float* CST = (float*)(F.ws + WS_SMALL + SM_CONST); float* LB = (float*)(F.ws + WS_SMALL + SM_LB);
    for (int idx = tid; idx < 1024; idx += NTHR) { const int pos = idx >> 4, f = idx & 15;
        const double frac[4] = {1.0, 0.5623413251903491, 0.31622776601683794, 0.1778279410038923};
        double inv = (f & 3) == 0 ? frac[0] : ((f & 3) == 1 ? frac[1] : ((f & 3) == 2 ? frac[2] : frac[3]));
        const int dec = f >> 2; inv *= (dec == 0 ? 1.0 : (dec == 1 ? 0.1 : (dec == 2 ? 0.01 : 0.001)));
        const double ang = (double)pos * inv; const double kq = __builtin_rint(ang * 0.15915494309189535); const float r = (float)(ang - kq * 6.283185307179586);
        COS[idx] = __cosf(r); SIN[idx] = __sinf(r); }
    if (tid < 2) { const int l = tid; const float* lp = F.a->in[I_DALAM] + l * 256; float s1 = 0.f, s2 = 0.f;
        for (int i = 0; i < 64; ++i) { s1 += lp[i] * lp[64 + i]; s2 += lp[128 + i] * lp[192 + i]; }
        const float lam_init = 0.8f - 0.6f * expf(-0.3f * (float)l);
        CST[l * 4 + 0] = expf(s1) - expf(s2) + lam_init; CST[l * 4 + 1] = lam_init; }
    if (tid < 256) { const float z0 = F.a->in[I_HGLB][tid], z1 = F.a->in[I_HGLB][256 + tid]; const float mx = fmaxf(z0, z1); const float e0 = expf(z0 - mx), e1 = expf(z1 - mx);
        LB[tid] = 0.f; LB[256 + tid] = e1 / (e0 + e1); }
}
__device__ __forceinline__ void p_weights(Frame& F) {
    PHASE_TID();
    LAS float* scr = (LAS float*)(F.lds + 32768 + wave * 12288);
    const int gw = F.bid * NWAVES + wave, NGW = F.G * NWAVES, nl = lane & 31;
    constexpr int I_IN = 16 * (PW / 32), I_OUT = 16 * 32, I_GU = 16 * (2 * FF / 32), I_DN = (FF / 64) * 32, I_MGU = 16 * (2 * FE / 32), I_MDN = (FE / 64) * 32;
    constexpr int NITEMS = 2 * I_IN + 2 * I_OUT + I_GU + I_DN + NE * I_MGU + NE * I_MDN;
    for (int it = gw; it < NITEMS; it += NGW) {
        int r = it;
        if (r < 2 * I_IN) { const int l = r / I_IN; r %= I_IN; const int nblk = PW / 32, kb = r / nblk, nb = r % nblk, np = nb * 32 + nl; const int col = np < 1024 ? np : np + 16;
            const float sc = (np >= ML_K && np < ML_V) ? 0.125f : ((np >= DA_Q && np < DA_K) ? C2 : 1.0f);
            transpose_item(F.a->in[I_WIN] + (size_t)l * D * WIN_LD + col, sc, WIN_LD, D, (bf16_t*)(F.ws + WS_WIN) + (size_t)l * PW * D, nb * 32, kb * 64, scr, lane); continue; }
        r -= 2 * I_IN;
        if (r < 2 * I_OUT) { const int l = r / I_OUT; r %= I_OUT; const int kb = r / 32, nb = r % 32;
            transpose_item(F.a->in[I_WOUT] + (size_t)l * D * D + nb * 32 + nl, 1.0f, D, D, (bf16_t*)(F.ws + WS_WOUT) + (size_t)l * D * D, nb * 32, kb * 64, scr, lane); continue; }
        r -= 2 * I_OUT;
        if (r < I_GU) { const int nblk = 2 * FF / 32, kb = r / nblk, nb = r % nblk; const float* src = (nl < 16 ? F.a->in[I_FWG] : F.a->in[I_FWU]) + nb * 16 + (nl & 15);
            transpose_item(src, 1.0f, FF, D, (bf16_t*)(F.ws + WS_WGU), nb * 32, kb * 64, scr, lane); continue; }
        r -= I_GU;
        if (r < I_DN) { const int kb = r / 32, nb = r % 32;
            transpose_item(F.a->in[I_FWD] + nb * 32 + nl, 1.0f, D, FF, (bf16_t*)(F.ws + WS_WD), nb * 32, kb * 64, scr, lane); continue; }
        r -= I_DN;
        if (r < NE * I_MGU) { const int e = r / I_MGU; r %= I_MGU; const int nblk = 2 * FE / 32, kb = r / nblk, nb = r % nblk;
            const float* src = (nl < 16 ? F.a->in[I_MWG] : F.a->in[I_MWU]) + (size_t)e * D * FE + nb * 16 + (nl & 15);
            transpose_item(src, 1.0f, FE, D, (bf16_t*)(F.ws + WS_MOE_GU) + (size_t)e * 2 * FE * D, nb * 32, kb * 64, scr, lane); continue; }
        r -= NE * I_MGU;
        { const int e = r / I_MDN; r %= I_MDN; const int kb = r / 32, nb = r % 32;
            transpose_item(F.a->in[I_MWD] + (size_t)e * FE * D + nb * 32 + nl, 1.0f, D, FE, (bf16_t*)(F.ws + WS_MOE_D) + (size_t)e * D * FE, nb * 32, kb * 64, scr, lane); }
    }
}

struct RowCfg {
    const float* xlat; const float* xctx;
    float* olat; float* octx;
    const bf16_t* Y;
    const float* wpost; int lg, gi;
    const float* wpre; int lm, si;
    int xib, xob;
};
__device__ __forceinline__ const float* modv_row(Frame& F, int layer, int row) { const int r = row < NLAT ? (row >> 12) : 4; return (const float*)(F.ws + WS_SMALL + SM_MODV) + (size_t)(layer * 5 + r) * 6144; }
__device__ __forceinline__ void load_bf16_row(const bf16_t* p, int lane, f32x4 (&v)[4]) {
#pragma unroll
    for (int j = 0; j < 4; ++j) { const u32x2 w = *(const GAS u32x2*)(p + 4 * lane + 256 * j); v[j] = (f32x4){bf_lo(w.x), bf_hi(w.x), bf_lo(w.y), bf_hi(w.y)}; }
}
__device__ __forceinline__ float sumsq4(const f32x4 (&v)[4]) { float s = 0.f;
#pragma unroll
    for (int j = 0; j < 4; ++j) s += (v[j].x * v[j].x + v[j].y * v[j].y) + (v[j].z * v[j].z + v[j].w * v[j].w);
    return s; }
struct RowRegs { f32x4 wpost[4], wpre[4], g[4], sh[4], sc[4]; int rb; };
template <bool HAS_Y, bool WRITE_HN>
__device__ __forceinline__ void row_regs_init(const RowCfg& c, int lane, RowRegs& R) { R.rb = -1;
#pragma unroll
    for (int j = 0; j < 4; ++j) { if (HAS_Y) R.wpost[j] = *(const GAS f32x4*)(c.wpost + 4 * lane + 256 * j); if (WRITE_HN) R.wpre[j] = *(const GAS f32x4*)(c.wpre + 4 * lane + 256 * j); } }
template <bool HAS_Y, bool WRITE_X, bool WRITE_HN>
__device__ __forceinline__ void row_core(Frame& F, const RowCfg& c, int row, int lane, f32x4 (&yv)[4], f32x4 (&hv)[4], RowRegs& R) {
    { const int r = row < NLAT ? (row >> 12) : 4;
        if (r != R.rb) { R.rb = r;
            if (HAS_Y) { const float* gate = modv_row(F, c.lg, row) + c.gi * 1024;
#pragma unroll
                for (int j = 0; j < 4; ++j) R.g[j] = *(const GAS f32x4*)(gate + 4 * lane + 256 * j); }
            if (WRITE_HN) { const float* mv = modv_row(F, c.lm, row); const float* shift = mv + c.si * 1024; const float* scale = mv + (c.si + 1) * 1024;
#pragma unroll
                for (int j = 0; j < 4; ++j) { R.sh[j] = *(const GAS f32x4*)(shift + 4 * lane + 256 * j); R.sc[j] = *(const GAS f32x4*)(scale + 4 * lane + 256 * j); } } } }
    f32x4 xv[4];
    if (row < NLAT && c.xib) load_bf16_row((const bf16_t*)(c.xlat + (size_t)row * D) + D, lane, xv);
    else { const float* xs = row < NLAT ? c.xlat + (size_t)row * D : c.xctx + (size_t)(row - NLAT) * D;
#pragma unroll
        for (int j = 0; j < 4; ++j) xv[j] = *(const GAS f32x4*)(xs + 4 * lane + 256 * j); }
    if (HAS_Y) {
        const float ry = 1.0f / sqrtf(wave_sum(sumsq4(yv)) * (1.0f / D) + EPS);
#pragma unroll
        for (int j = 0; j < 4; ++j) xv[j] = xv[j] + R.g[j] * (yv[j] * ry * R.wpost[j]);
    }
    if (WRITE_X) {
        if (row < NLAT && c.xob) { bf16_t* xb = (bf16_t*)(c.olat + (size_t)row * D) + D;
#pragma unroll
            for (int j = 0; j < 4; ++j) { u32x2 o; o.x = cvt_pk_bf16(xv[j].x, xv[j].y); o.y = cvt_pk_bf16(xv[j].z, xv[j].w); *(GAS u32x2*)(xb + 4 * lane + 256 * j) = o; } }
        else { float* xd = row < NLAT ? c.olat + (size_t)row * D : c.octx + (size_t)(row - NLAT) * D;
#pragma unroll
            for (int j = 0; j < 4; ++j) *(GAS f32x4*)(xd + 4 * lane + 256 * j) = xv[j]; } }
    if (WRITE_HN) {
        const float rx = 1.0f / sqrtf(wave_sum(sumsq4(xv)) * (1.0f / D) + EPS);
        bf16_t* hn = (bf16_t*)(F.ws + WS_HN) + (size_t)row * D;
#pragma unroll
        for (int j = 0; j < 4; ++j) { hv[j] = (xv[j] * rx * R.wpre[j]) * (1.0f + R.sc[j]) + R.sh[j];
            u32x2 o; o.x = cvt_pk_bf16(hv[j].x, hv[j].y); o.y = cvt_pk_bf16(hv[j].z, hv[j].w); *(GAS u32x2*)(hn + 4 * lane + 256 * j) = o; }
    }
}
template <bool HAS_Y, bool WRITE_X, bool WRITE_HN, bool GATES>
__device__ __forceinline__ void row_phase(Frame& F, const RowCfg& c, int nrows) {
    PHASE_TID();
    LAS float* wgT = (LAS float*)F.lds;
    if (GATES) { const float* wg = F.a->in[I_WIN] + (size_t)c.lm * D * WIN_LD + 1024;
        for (int idx = tid; idx < 16 * D; idx += NTHR) { const int k = idx >> 4, i = idx & 15; wgT[i * D + k] = wg[(size_t)k * WIN_LD + i]; }
        __syncthreads(); }
    const int gw = F.bid * NWAVES + wave, NGW = F.G * NWAVES;
    RowRegs R; row_regs_init<HAS_Y, WRITE_HN>(c, lane, R);
    for (int row = gw; row < nrows; row += NGW) {
        f32x4 yv[4], hv[4];
        if (HAS_Y) load_bf16_row(c.Y + (size_t)row * D, lane, yv);
        row_core<HAS_Y, WRITE_X, WRITE_HN>(F, c, row, lane, yv, hv, R);
        if (GATES) { float* G = (float*)(F.ws + WS_GATES) + (size_t)row * 16; float mine = 0.f;
#pragma unroll
            for (int i = 0; i < 16; ++i) { float s = 0.f;
#pragma unroll
                for (int j = 0; j < 4; ++j) { const f32x4 w = *(const LAS f32x4*)(wgT + i * D + 4 * lane + 256 * j); s += (hv[j].x * w.x + hv[j].y * w.y) + (hv[j].z * w.z + hv[j].w * w.w); }
                s = wave_sum(s); if (lane == i) mine = s; }
            if (lane < 16) G[lane] = mine; }
    }
    if (GATES) __syncthreads();
}
__device__ __forceinline__ void route_phase(Frame& F, const RowCfg& c) {
    PHASE_TID();
    LAS float* wrT = (LAS float*)F.lds;
    LAS unsigned* lcnt = (LAS unsigned*)(F.lds + 32768);
    LAS unsigned* rec = (LAS unsigned*)(F.lds + 32768 + 256);
    for (int idx = tid; idx < 8 * D; idx += NTHR) { const int k = idx >> 3, e = idx & 7; wrT[e * D + k] = F.a->in[I_RW][(size_t)k * 8 + e]; }
    unsigned* cntw = F.ctl + CW_CNT; unsigned* lists = F.ctl + CW_LIST; unsigned* route = (unsigned*)(F.ws + WS_ROUTE);
    RowRegs R; row_regs_init<true, true>(c, lane, R);
    for (int blk = F.bid; blk < NLAT / 64; blk += F.G) {
        if (tid < 16) lcnt[tid] = 0u;
        __syncthreads();
        for (int q = 0; q < 8; ++q) { const int tl = wave * 8 + q, row = blk * 64 + tl;
            f32x4 yv[4], hv[4]; load_bf16_row(c.Y + (size_t)row * D, lane, yv);
            row_core<true, true, true>(F, c, row, lane, yv, hv, R);
            float lg[8];
#pragma unroll
            for (int e = 0; e < 8; ++e) { float s = 0.f;
#pragma unroll
                for (int j = 0; j < 4; ++j) { const f32x4 w = *(const LAS f32x4*)(wrT + e * D + 4 * lane + 256 * j); s += (hv[j].x * w.x + hv[j].y * w.y) + (hv[j].z * w.z + hv[j].w * w.w); }
                lg[e] = wave_sum(s) + F.a->in[I_RB][e]; }
            int e1 = 0; float v1 = lg[0];
#pragma unroll
            for (int e = 1; e < 8; ++e) if (lg[e] > v1) { v1 = lg[e]; e1 = e; }
            int e2 = (e1 + 1) & 7; float v2 = -3.0e38f;
#pragma unroll
            for (int e = 0; e < 8; ++e) if (e != e1 && lg[e] > v2) { v2 = lg[e]; e2 = e; }
            const float ex = __expf(v2 - v1), g1 = 1.0f / (1.0f + ex), g2 = ex * g1;
            if (lane == 0) { const unsigned p1 = __hip_atomic_fetch_add(&lcnt[e1], 1u, __ATOMIC_RELAXED, __HIP_MEMORY_SCOPE_WORKGROUP), p2 = __hip_atomic_fetch_add(&lcnt[e2], 1u, __ATOMIC_RELAXED, __HIP_MEMORY_SCOPE_WORKGROUP);
                rec[tl * 6 + 0] = (unsigned)e1; rec[tl * 6 + 1] = (unsigned)e2; rec[tl * 6 + 2] = p1; rec[tl * 6 + 3] = p2; rec[tl * 6 + 4] = __float_as_uint(g1); rec[tl * 6 + 5] = __float_as_uint(g2); }
        }
        __syncthreads();
        if (tid < 8) lcnt[8 + tid] = __hip_atomic_fetch_add(cntw + 64 * tid, lcnt[tid], RLX_AGENT);
        __syncthreads();
        if (tid < 64) { const int tok = blk * 64 + tid; const unsigned e1 = rec[tid * 6 + 0], e2 = rec[tid * 6 + 1];
            const unsigned p1 = lcnt[8 + e1] + rec[tid * 6 + 2], p2 = lcnt[8 + e2] + rec[tid * 6 + 3];
            lists[(size_t)e1 * NLAT + p1] = (unsigned)tok; lists[(size_t)e2 * NLAT + p2] = (unsigned)tok;
            u32x4 r0 = {e1, p1, rec[tid * 6 + 4], 0u}, r1 = {e2, p2, rec[tid * 6 + 5], 0u};
            *(u32x4*)(route + (size_t)tok * 8) = r0; *(u32x4*)(route + (size_t)tok * 8 + 4) = r1; }
        __syncthreads();
    }
}
__device__ __forceinline__ void final_phase(Frame& F, const RowCfg& c) {
    PHASE_TID();
    const unsigned* cntw = F.ctl + CW_CNT; int tb[8]; { int acc = 0;
#pragma unroll
        for (int e = 0; e < 8; ++e) { const int ce = (int)__hip_atomic_load(cntw + 64 * e, RLX_AGENT); tb[e] = acc | ((ce >> 8) << 16); acc += (ce + 255) >> 8; } }
    const bf16_t* SIDE = (const bf16_t*)(F.ws + WS_MOE_SIDE);
    const unsigned* route = (const unsigned*)(F.ws + WS_ROUTE); const bf16_t* YM = (const bf16_t*)(F.ws + WS_MOE_GU);
    const int gw = F.bid * NWAVES + wave, NGW = F.G * NWAVES;
    RowRegs R; row_regs_init<true, false>(c, lane, R);
    for (int row = gw; row < NLAT; row += NGW) {
        const u32x4 r0 = *(const GAS u32x4*)(route + (size_t)row * 8), r1 = *(const GAS u32x4*)(route + (size_t)row * 8 + 4);
        int t1 = 0, t2 = 0;
#pragma unroll
        for (int e = 0; e < 8; ++e) { if ((int)r0.x == e) t1 = tb[e]; if ((int)r1.x == e) t2 = tb[e]; }
        const size_t s1 = (size_t)(t1 & 0xffff) * 256 + r0.y, s2 = (size_t)(t2 & 0xffff) * 256 + r1.y; const float g1 = __uint_as_float(r0.z), g2 = __uint_as_float(r1.z);
        const int p1 = (int)r0.y - (t1 >> 16) * 256, p2 = (int)r1.y - (t2 >> 16) * 256;
        f32x4 ya[4], yb[4], yv[4], hv[4];
        if (p1 < 0) load_bf16_row(YM + s1 * D, lane, ya);
        else { load_bf16_row(SIDE + ((size_t)r0.x * 256 + p1) * D, lane, ya);
            for (int ks = 1; ks < pg8::KSL; ++ks) { f32x4 t[4]; load_bf16_row(SIDE + ((size_t)(ks * 8 + (int)r0.x) * 256 + p1) * D, lane, t);
#pragma unroll
                for (int j = 0; j < 4; ++j) ya[j] += t[j]; } }
        if (p2 < 0) load_bf16_row(YM + s2 * D, lane, yb);
        else { load_bf16_row(SIDE + ((size_t)r1.x * 256 + p2) * D, lane, yb);
            for (int ks = 1; ks < pg8::KSL; ++ks) { f32x4 t[4]; load_bf16_row(SIDE + ((size_t)(ks * 8 + (int)r1.x) * 256 + p2) * D, lane, t);
#pragma unroll
                for (int j = 0; j < 4; ++j) yb[j] += t[j]; } }
#pragma unroll
        for (int j = 0; j < 4; ++j) yv[j] = ya[j] * g1 + yb[j] * g2;
        row_core<true, true, false>(F, c, row, lane, yv, hv, R);
    }
}

__device__ __forceinline__ int seq_row(int b, int dir, int n) {
    if (n < CTXL) { const int j = dir ? (CTXL - 1 - n) : n; return NLAT + b * CTXL + j; }
    const int l = dir ? (SEQ - 1 - (n - CTXL)) : (n - CTXL); return b * SEQ + l;
}
constexpr int LCH = 68, NCH = 64, NSEQ = 64, NUNIT = NSEQ * NCH;
constexpr size_t WS_DC = WS_Y;
constexpr size_t WS_C0 = WS_HN;
constexpr size_t WS_DN = WS_Y + 32 * MiB;
constexpr size_t WS_N0 = WS_Y + 33 * MiB;
constexpr size_t SM_SCAL = 512 * 1024;
template <int MODE>
__device__ __forceinline__ void mix_rec_phase(Frame& F, int layer, bool need_ctx) {
    PHASE_TID();
    const bf16_t* P = (const bf16_t*)(F.ws + WS_P); const float* GT = (const float*)(F.ws + WS_GATES); float* SCR = (float*)(F.ws + WS_SCR);
    bf16_t* DC = (bf16_t*)(F.ws + WS_DC); const bf16_t* C0 = (const bf16_t*)(F.ws + WS_C0); float* DN = (float*)(F.ws + WS_DN); const float* N0 = (const float*)(F.ws + WS_N0);
    float* SCAL = (float*)(F.ws + WS_SMALL + SM_SCAL);
    LAS float* tq = (LAS float*)(F.lds + wave * 13312); LAS float* tk = tq + 17 * 64; LAS float* tv = tk + 17 * 64; LAS float* tg = tv + 17 * 64;
    const int dblk = lane >> 3, eblk = lane & 7;
    const int gw = F.bid * NWAVES + wave, NGW = F.G * NWAVES;
    for (int unit = NUNIT / 2 + gw; unit < NUNIT; unit += NGW) {
        const int sq = unit >> 6, j = unit & 63, kind = sq >> 5, b = (sq >> 3) & 3, h = (sq >> 1) & 3, dir = sq & 1;
        float C[8][8], n8[8];
        float mrun = (MODE == 0) ? -1e30f : 0.f, bsum = 0.f;
        if (MODE == 0) {
#pragma unroll
            for (int i = 0; i < 8; ++i) { n8[i] = (kind == 0) ? 0.f : 1.f;
#pragma unroll
                for (int jj = 0; jj < 8; ++jj) C[i][jj] = 0.f; }
        } else {
            const bf16_t* c0 = C0 + (size_t)unit * 4096 + (8 * dblk) * 64 + 8 * eblk;
#pragma unroll
            for (int i = 0; i < 8; ++i) { const u32x4 w = *(const GAS u32x4*)(c0 + i * 64);
                C[i][0] = bf_lo(w.x); C[i][1] = bf_hi(w.x); C[i][2] = bf_lo(w.y); C[i][3] = bf_hi(w.y); C[i][4] = bf_lo(w.z); C[i][5] = bf_hi(w.z); C[i][6] = bf_lo(w.w); C[i][7] = bf_hi(w.w);
                n8[i] = N0[(size_t)unit * 64 + 8 * dblk + i]; }
            mrun = SCAL[2 * 4096 + unit];
        }
        float* outp = SCR + (size_t)(kind * 2 + dir) * ROWS * 256 + h * 64 + 8 * eblk + dblk;
        const float gb_i = F.a->in[I_MLGB][layer * 16 + (2 * dir) * 4 + h], gb_f = F.a->in[I_MLGB][layer * 16 + (2 * dir + 1) * 4 + h];
        const float lb = ((const float*)(F.ws + WS_SMALL + SM_LB))[layer * 256 + h * 64 + lane];
        for (int n0 = 0; n0 < LCH; n0 += 17) {
            const int nb = j * LCH + n0;
            if (kind == 0) {
#pragma unroll
                for (int tt = 0; tt < 17; ++tt) { const bf16_t* pr = P + (size_t)seq_row(b, dir, nb + tt) * PW + h * 64 + lane;
                    tq[tt * 64 + lane] = bf2f(pr[ML_Q]); tk[tt * 64 + lane] = bf2f(pr[ML_K]); tv[tt * 64 + lane] = bf2f(pr[ML_V]); }
                if (lane < 17) { const float* g = GT + (size_t)seq_row(b, dir, nb + lane) * 16; tg[lane] = g[(2 * dir) * 4 + h] + gb_i; tg[17 + lane] = log_sigmoidf_(g[(2 * dir + 1) * 4 + h] + gb_f); }
            } else {
#pragma unroll
                for (int tt = 0; tt < 17; ++tt) { const bf16_t* pr = P + (size_t)seq_row(b, dir, nb + tt) * PW + h * 64 + lane;
                    const float sg = sigmoidf_(bf2f(pr[HG_F + dir * 256]));
                    tq[tt * 64 + lane] = siluf_(bf2f(pr[HG_Q])); tk[tt * 64 + lane] = fmaxf(lb, 1e-30f) + (1.0f - lb) * sg; tv[tt * 64 + lane] = bf2f(pr[HG_I]); }
            }
            LDS_WAIT(); asm volatile("" ::: "memory");
            for (int tt = 0; tt < 17; ++tt) {
                const f32x4 ka = *(const LAS f32x4*)(tk + tt * 64 + 8 * dblk), kb = *(const LAS f32x4*)(tk + tt * 64 + 8 * dblk + 4);
                const f32x4 va = *(const LAS f32x4*)(tv + tt * 64 + 8 * eblk), vb = *(const LAS f32x4*)(tv + tt * 64 + 8 * eblk + 4);
                const float k8[8] = {ka.x, ka.y, ka.z, ka.w, kb.x, kb.y, kb.z, kb.w}, v8[8] = {va.x, va.y, va.z, va.w, vb.x, vb.y, vb.z, vb.w};
                float q8[8];
                if (MODE == 2) { const f32x4 qa = *(const LAS f32x4*)(tq + tt * 64 + 8 * dblk), qb = *(const LAS f32x4*)(tq + tt * 64 + 8 * dblk + 4);
                    q8[0] = qa.x; q8[1] = qa.y; q8[2] = qa.z; q8[3] = qa.w; q8[4] = qb.x; q8[5] = qb.y; q8[6] = qb.z; q8[7] = qb.w; }
                float po[8], dpart = 0.f, floorv = 0.f;
#pragma unroll
                for (int jj = 0; jj < 8; ++jj) po[jj] = 0.f;
                if (kind == 0) {
                    const float li = tg[tt], lf = tg[17 + tt];
                    const float mnew = fmaxf(lf + mrun, li); const float fs = __expf(lf + mrun - mnew), is = __expf(li - mnew); mrun = mnew; bsum += lf;
#pragma unroll
                    for (int i = 0; i < 8; ++i) { const float ik = is * k8[i]; n8[i] = fs * n8[i] + ik;
#pragma unroll
                        for (int jj = 0; jj < 8; ++jj) { C[i][jj] = fs * C[i][jj] + ik * v8[jj]; if (MODE == 2) po[jj] += q8[i] * C[i][jj]; }
                        if (MODE == 2) dpart += q8[i] * n8[i]; }
                    if (MODE == 2) floorv = __expf(-mnew);
                } else {
#pragma unroll
                    for (int i = 0; i < 8; ++i) { const float f = k8[i], kk = 1.0f - f; n8[i] *= f;
#pragma unroll
                        for (int jj = 0; jj < 8; ++jj) { C[i][jj] = f * C[i][jj] + kk * v8[jj]; if (MODE == 2) po[jj] += q8[i] * C[i][jj]; } }
                }
                if (MODE == 2) {
                    float r4[4], r2[2], o;
                    const bool b5 = (lane & 32) != 0, b4 = (lane & 16) != 0, b3 = (lane & 8) != 0;
#pragma unroll
                    for (int x = 0; x < 4; ++x) { const float keep = b5 ? po[4 + x] : po[x], send = b5 ? po[x] : po[4 + x]; r4[x] = keep + __shfl_xor(send, 32); }
#pragma unroll
                    for (int x = 0; x < 2; ++x) { const float keep = b4 ? r4[2 + x] : r4[x], send = b4 ? r4[x] : r4[2 + x]; r2[x] = keep + __shfl_xor(send, 16); }
                    { const float keep = b3 ? r2[1] : r2[0], send = b3 ? r2[0] : r2[1]; o = keep + __shfl_xor(send, 8); }
                    if (kind == 0) { dpart += __shfl_xor(dpart, 8); dpart += __shfl_xor(dpart, 16); dpart += __shfl_xor(dpart, 32); o = o / fmaxf(fabsf(dpart), floorv); }
                    const int row = seq_row(b, dir, nb + tt);
                    if (need_ctx || row < NLAT) outp[(size_t)row * 256] = o;
                }
            }
            LDS_WAIT(); asm volatile("" ::: "memory");
        }
        if (MODE == 0) {
            bf16_t* dc = DC + (size_t)unit * 4096 + (8 * dblk) * 64 + 8 * eblk;
#pragma unroll
            for (int i = 0; i < 8; ++i) { u32x4 w; w.x = cvt_pk_bf16(C[i][0], C[i][1]); w.y = cvt_pk_bf16(C[i][2], C[i][3]); w.z = cvt_pk_bf16(C[i][4], C[i][5]); w.w = cvt_pk_bf16(C[i][6], C[i][7]); *(GAS u32x4*)(dc + i * 64) = w; }
            if (eblk == 0) {
#pragma unroll
                for (int i = 0; i < 8; ++i) DN[(size_t)unit * 64 + 8 * dblk + i] = n8[i]; }
            if (lane == 0) { SCAL[unit] = mrun; SCAL[4096 + unit] = bsum; }
        }
    }
}
__device__ __forceinline__ void mix_scan_phase(Frame& F) {
    PHASE_TID();
    const bf16_t* DC = (const bf16_t*)(F.ws + WS_DC); bf16_t* C0 = (bf16_t*)(F.ws + WS_C0); const float* DN = (const float*)(F.ws + WS_DN); float* N0 = (float*)(F.ws + WS_N0);
    float* SCAL = (float*)(F.ws + WS_SMALL + SM_SCAL);
    LAS float* sml = (LAS float*)F.lds; LAS float* sbl = sml + 64;
    for (int it = NSEQ * 2 + F.bid; it < NSEQ * 4; it += F.G) {
        const int sq = it >> 2, qtr = it & 3, kind = sq >> 5, d = 16 * qtr + (tid >> 5), e2 = (tid & 31) * 2;
        __syncthreads();
        if (tid < 64) { sml[tid] = SCAL[sq * 64 + tid]; sbl[tid] = SCAL[4096 + sq * 64 + tid]; }
        __syncthreads();
        float c0 = 0.f, c1 = 0.f, nn = 0.f, m = 0.f;
        const bf16_t* dcp = DC + (size_t)(sq * 64) * 4096 + d * 64 + e2; bf16_t* c0p = C0 + (size_t)(sq * 64) * 4096 + d * 64 + e2;
        const float* dnp = DN + (size_t)(sq * 64) * 64 + d; float* n0p = N0 + (size_t)(sq * 64) * 64 + d;
        for (int jb = 0; jb < 64; jb += 16) {
            unsigned dcv[16]; float dnv[16];
#pragma unroll
            for (int j = 0; j < 16; ++j) { dcv[j] = *(const GAS unsigned*)(dcp + (size_t)(jb + j) * 4096); dnv[j] = dnp[(size_t)(jb + j) * 64]; }
#pragma unroll
            for (int j = 0; j < 16; ++j) {
                *(GAS unsigned*)(c0p + (size_t)(jb + j) * 4096) = cvt_pk_bf16(c0, c1);
                if (kind == 0) {
                    if (e2 == 0) n0p[(size_t)(jb + j) * 64] = nn;
                    if (qtr == 0 && tid == 0) SCAL[2 * 4096 + sq * 64 + jb + j] = m;
                    const float ml = sml[jb + j], bl = sbl[jb + j]; const float mnew = fmaxf(bl + m, ml); const float so = __expf(bl + m - mnew), sn = __expf(ml - mnew); m = mnew;
                    c0 = so * c0 + sn * bf_lo(dcv[j]); c1 = so * c1 + sn * bf_hi(dcv[j]); nn = so * nn + sn * dnv[j];
                } else { const float a = dnv[j]; c0 = a * c0 + bf_lo(dcv[j]); c1 = a * c1 + bf_hi(dcv[j]); }
            }
        }
    }
}
constexpr int NC2 = 68;
constexpr size_t WS_DCM = WS_SCR;
constexpr size_t WS_C0M = WS_SCR + 34 * MiB;
constexpr size_t WS_DNM = WS_Y;
constexpr size_t WS_N0M = WS_Y + 2 * MiB;
constexpr size_t SM_SCALM = 768 * 1024;
__device__ __forceinline__ f32x16 zero16() { f32x16 v;
#pragma unroll
    for (int r = 0; r < 16; ++r) v[r] = 0.f;
    asm volatile("" : "+v"(v)); return v; }
__device__ __forceinline__ f32x16 mfma32(bf16x8 a, bf16x8 b, f32x16 c) { const f32x16 d = __builtin_amdgcn_mfma_f32_32x32x16_bf16(a, b, c, 0, 0, 0); asm volatile("" :: "v"(a), "v"(b)); return d; }
__device__ __forceinline__ f32x4 mfma16(bf16x8 a, bf16x8 b, f32x4 c) {
    asm volatile("s_nop 1\n\tv_mfma_f32_16x16x32_bf16 %0, %1, %2, %0\n\ts_nop 7\n\ts_nop 7" : "+v"(c) : "v"(a), "v"(b));
    return c; }
__device__ __forceinline__ int crow(int r, int hi) { return (r & 3) + 8 * (r >> 2) + 4 * hi; }
__device__ __forceinline__ float wave_prefix_sum(float x, int lane) {
#pragma unroll
    for (int o = 1; o < 64; o <<= 1) { const float y = __shfl_up(x, o); if (lane >= o) x += y; }
    return x; }
__device__ __forceinline__ float wave_suffix_sum(float x, int lane) {
#pragma unroll
    for (int o = 1; o < 64; o <<= 1) { const float y = __shfl_down(x, o); if (lane + o < 64) x += y; }
    return x; }
__device__ __forceinline__ float wave_prefix_max(float x, int lane) {
#pragma unroll
    for (int o = 1; o < 64; o <<= 1) { const float y = __shfl_up(x, o); if (lane >= o) x = fmaxf(x, y); }
    return x; }
__device__ __forceinline__ float wave_suffix_max(float x, int lane) {
#pragma unroll
    for (int o = 1; o < 64; o <<= 1) { const float y = __shfl_down(x, o); if (lane + o < 64) x = fmaxf(x, y); }
    return x; }
__device__ __forceinline__ float wave_max(float v) {
#pragma unroll
    for (int o = 1; o < 64; o <<= 1) v = fmaxf(v, __shfl_xor(v, o));
    return v; }
__device__ __forceinline__ bf16x8 tr_frag(const LAS unsigned char* p) {
    const s16x4 lo = __builtin_bit_cast(s16x4, __builtin_amdgcn_ds_read_tr16_b64_v4i16((LAS s16x4*)(p)));
    const s16x4 hh = __builtin_bit_cast(s16x4, __builtin_amdgcn_ds_read_tr16_b64_v4i16((LAS s16x4*)(p + 512)));
    return (bf16x8){lo[0], lo[1], lo[2], lo[3], hh[0], hh[1], hh[2], hh[3]}; }
__device__ __forceinline__ u32x4 scale_bf16x8(u32x4 w, float sc) { u32x4 o; o.x = cvt_pk_bf16(bf_lo(w.x) * sc, bf_hi(w.x) * sc); o.y = cvt_pk_bf16(bf_lo(w.y) * sc, bf_hi(w.y) * sc); o.z = cvt_pk_bf16(bf_lo(w.z) * sc, bf_hi(w.z) * sc); o.w = cvt_pk_bf16(bf_lo(w.w) * sc, bf_hi(w.w) * sc); return o; }
__device__ __forceinline__ void ml_unit(int unit, int& b, int& h, int& c, int& row0, int& jf, int& jb) {
    const int bh = unit / NC2; c = unit - bh * NC2; b = bh >> 2; h = bh & 3;
    row0 = c < 4 ? NLAT + b * CTXL + 64 * c : b * SEQ + 64 * (c - 4); jf = c; jb = c < 4 ? 3 - c : 71 - c; }
__device__ __forceinline__ void mlstm_a_phase(Frame& F, int layer) {
    PHASE_TID();
    const bf16_t* P = (const bf16_t*)(F.ws + WS_P); const float* GT = (const float*)(F.ws + WS_GATES);
    bf16_t* DCM = (bf16_t*)(F.ws + WS_DCM); float* DNM = (float*)(F.ws + WS_DNM); float* SC = (float*)(F.ws + WS_SMALL + SM_SCALM);
    LAS unsigned char* Vimg = F.lds; LAS unsigned char* Kimg = F.lds + 8192; LAS float* wv = (LAS float*)(F.lds + 24576);
    const int r32 = lane & 31, hi = lane >> 5;
    const int vrd = ((lane >> 4) & 1) * 32 + (lane & 3) * 8 + (4 * hi + ((lane & 15) >> 2)) * 64;
    const int ps = tid >> 3, pc = tid & 7, pst = (pc >> 2) * 4096 + ps * 64 + (pc & 3) * 16;
    const bf16x8 ones = {0x3F80, 0x3F80, 0x3F80, 0x3F80, 0x3F80, 0x3F80, 0x3F80, 0x3F80};
    for (int unit = F.bid; unit < 16 * NC2; unit += F.G) {
        int b, h, c, row0, jf, jb; ml_unit(unit, b, h, c, row0, jf, jb);
        __syncthreads();
        const u32x4 kraw = *(const GAS u32x4*)(P + (size_t)(row0 + ps) * PW + ML_K + h * 64 + pc * 8);
        *(LAS u32x4*)(Vimg + pst) = *(const GAS u32x4*)(P + (size_t)(row0 + ps) * PW + ML_V + h * 64 + pc * 8);
        if (wave < 2) { const int dir = wave; const float* g = GT + (size_t)(row0 + lane) * 16;
            const float li = g[(2 * dir) * 4 + h] + F.a->in[I_MLGB][layer * 16 + (2 * dir) * 4 + h], lf = log_sigmoidf_(g[(2 * dir + 1) * 4 + h] + F.a->in[I_MLGB][layer * 16 + (2 * dir + 1) * 4 + h]);
            const float bt = dir == 0 ? wave_prefix_sum(lf, lane) : wave_suffix_sum(lf, lane);
            const float btot = __shfl(bt, dir == 0 ? 63 : 0);
            const float a = btot - bt + li; const float mloc = wave_max(a);
            wv[dir * 64 + lane] = __expf(a - mloc);
            if (lane == 0) { const int si = ((b * 4 + h) * 2 + dir) * NC2 + (dir == 0 ? jf : jb); SC[si] = mloc; SC[32 * NC2 + si] = btot; } }
        __syncthreads();
        *(LAS u32x4*)(Kimg + pst) = scale_bf16x8(kraw, wv[ps]); *(LAS u32x4*)(Kimg + 8192 + pst) = scale_bf16x8(kraw, wv[64 + ps]);
        __syncthreads();
        { const int dir = wave >> 2, eblk = (wave >> 1) & 1, dblk = wave & 1;
            f32x16 acc = zero16(), dn = zero16();
#pragma unroll
            for (int ks = 0; ks < 4; ++ks) { const bf16x8 va = tr_frag(Vimg + eblk * 4096 + ks * 1024 + vrd), kb = tr_frag(Kimg + dir * 8192 + dblk * 4096 + ks * 1024 + vrd);
                acc = mfma32(va, kb, acc); if (eblk == 0) dn = mfma32(ones, kb, dn); }
            const size_t si = (size_t)((b * 4 + h) * 2 + dir) * NC2 + (dir == 0 ? jf : jb);
            bf16_t* dst = DCM + si * 4096 + (32 * eblk) * 64 + 32 * dblk + r32;
#pragma unroll
            for (int r = 0; r < 16; ++r) dst[crow(r, hi) * 64] = (bf16_t)(cvt_pk_bf16(acc[r], 0.f) & 0xffffu);
            if (eblk == 0 && hi == 0) DNM[si * 64 + 32 * dblk + r32] = dn[0];
        }
    }
}
__device__ __forceinline__ void mix_scan2_phase(Frame& F) {
    PHASE_TID();
    const bf16_t* DCM = (const bf16_t*)(F.ws + WS_DCM); bf16_t* C0M = (bf16_t*)(F.ws + WS_C0M); const float* DNM = (const float*)(F.ws + WS_DNM); float* N0M = (float*)(F.ws + WS_N0M);
    float* SC = (float*)(F.ws + WS_SMALL + SM_SCALM);
    LAS float* sml = (LAS float*)(F.lds + 120 * 1024); LAS float* sbl = sml + NC2;
    for (int it = F.bid; it < 64 * 4; it += F.G) {
        const int sq = it >> 2, qtr = it & 3, kind = sq >> 5, e = 16 * qtr + (tid >> 5), d2 = (tid & 31) * 2;
        __syncthreads();
        if (kind == 0 && tid < NC2) { sml[tid] = SC[sq * NC2 + tid]; sbl[tid] = SC[32 * NC2 + sq * NC2 + tid]; }
        __syncthreads();
        float c0 = 0.f, c1 = 0.f, n0 = 0.f, n1 = 0.f, m = 0.f;
        const bf16_t* dcp = DCM + (size_t)(sq * NC2) * 4096 + e * 64 + d2; bf16_t* c0p = C0M + (size_t)(sq * NC2) * 4096 + e * 64 + d2;
        const float* dnp = DNM + (size_t)(sq * NC2) * 64 + d2; float* n0p = N0M + (size_t)(sq * NC2) * 64 + d2;
        const bool nrow = (kind == 0) && (qtr == 0) && ((tid >> 5) == 0);
#define SCAN_LOAD(DC, DN, jb) do { _Pragma("unroll") for (int j = 0; j < 17; ++j) { DC[j] = *(const GAS unsigned*)(dcp + (size_t)((jb) + j) * 4096); DN[j] = (nrow || kind == 1) ? *(const GAS f32x2*)(dnp + (size_t)((jb) + j) * 64) : (f32x2){0.f, 0.f}; } } while (0)
#define SCAN_STEP(DC, DN, jb) do { _Pragma("unroll") for (int j = 0; j < 17; ++j) { \
                *(GAS unsigned*)(c0p + (size_t)((jb) + j) * 4096) = cvt_pk_bf16(c0, c1); \
                if (kind == 0) { \
                    if (nrow) { *(GAS f32x2*)(n0p + (size_t)((jb) + j) * 64) = (f32x2){n0, n1}; if (tid == 0) SC[64 * NC2 + sq * NC2 + (jb) + j] = m; } \
                    const float ml = sml[(jb) + j], bl = sbl[(jb) + j]; const float mnew = fmaxf(bl + m, ml); const float so = __expf(bl + m - mnew), sn = __expf(ml - mnew); m = mnew; \
                    c0 = so * c0 + sn * bf_lo(DC[j]); c1 = so * c1 + sn * bf_hi(DC[j]); n0 = so * n0 + sn * DN[j].x; n1 = so * n1 + sn * DN[j].y; \
                } else { c0 = DN[j].x * c0 + bf_lo(DC[j]); c1 = DN[j].y * c1 + bf_hi(DC[j]); } } } while (0)
        { unsigned dca[17], dcb[17]; f32x2 dna[17], dnb[17];
            SCAN_LOAD(dca, dna, 0); SCAN_LOAD(dcb, dnb, 17); SCAN_STEP(dca, dna, 0);
            SCAN_LOAD(dca, dna, 34); SCAN_STEP(dcb, dnb, 17);
            SCAN_LOAD(dcb, dnb, 51); SCAN_STEP(dca, dna, 34);
            SCAN_STEP(dcb, dnb, 51); }
#undef SCAN_LOAD
#undef SCAN_STEP
    }
}
__device__ __forceinline__ void mlstm_c_phase(Frame& F, int layer, bool need_ctx) {
    PHASE_TID();
    const bf16_t* P = (const bf16_t*)(F.ws + WS_P); const float* GT = (const float*)(F.ws + WS_GATES); bf16_t* MIX = (bf16_t*)(F.ws + WS_MIX);
    const bf16_t* C0M = (const bf16_t*)(F.ws + WS_C0M); const float* N0M = (const float*)(F.ws + WS_N0M); const float* SC = (const float*)(F.ws + WS_SMALL + SM_SCALM);
    LAS unsigned char* Qimg = F.lds; LAS unsigned char* Kimg = F.lds + 8192; LAS unsigned char* Vimg = F.lds + 16384;
    LAS float* vec = (LAS float*)(F.lds + 24576);
    LAS float* Hx = (LAS float*)(F.lds + 26624);
    const int r32 = lane & 31, hi = lane >> 5;
    const int vrd = ((lane >> 4) & 1) * 32 + (lane & 3) * 8 + (4 * hi + ((lane & 15) >> 2)) * 64;
    const int ps = tid >> 3, pc = tid & 7, pst = (pc >> 2) * 4096 + ps * 64 + (pc & 3) * 16, prm = ps * 128 + ((pc ^ ((ps >> 1) & 7)) << 4);
    const bf16x8 ones = {0x3F80, 0x3F80, 0x3F80, 0x3F80, 0x3F80, 0x3F80, 0x3F80, 0x3F80};
    const int nunit = need_ctx ? 16 * NC2 : 16 * 64;
    const int vb = F.G == 256 ? ((F.bid + 192) & 255) : F.bid;
    u32x4 rq, rk, rv, ro;
#define ML_LOAD(uu) do { const int un_ = need_ctx ? (uu) : ((uu) >> 6) * NC2 + 4 + ((uu) & 63); int b_, h_, c_, r_, j_, k_; ml_unit(un_, b_, h_, c_, r_, j_, k_); \
        const bf16_t* pr_ = P + (size_t)(r_ + ps) * PW + h_ * 64 + pc * 8; rq = *(const GAS u32x4*)(pr_ + ML_Q); rk = *(const GAS u32x4*)(pr_ + ML_K); rv = *(const GAS u32x4*)(pr_ + ML_V); ro = *(const GAS u32x4*)(pr_ + ML_O); } while (0)
    if (vb < nunit) ML_LOAD(vb);
    for (int u0 = vb; u0 < nunit; u0 += F.G) {
        const int unit = need_ctx ? u0 : (u0 >> 6) * NC2 + 4 + (u0 & 63);
        int b, h, c, row0, jf, jb; ml_unit(unit, b, h, c, row0, jf, jb);
        __syncthreads();
        *(LAS u32x4*)(Qimg + prm) = rq; *(LAS u32x4*)(Kimg + prm) = rk; *(LAS u32x4*)(Vimg + pst) = rv; const u32x4 ow = ro;
        if (u0 + F.G < nunit) ML_LOAD(u0 + F.G);
        if (wave < 2) { const int dir = wave; const float* g = GT + (size_t)(row0 + lane) * 16;
            const float li = g[(2 * dir) * 4 + h] + F.a->in[I_MLGB][layer * 16 + (2 * dir) * 4 + h], lf = log_sigmoidf_(g[(2 * dir + 1) * 4 + h] + F.a->in[I_MLGB][layer * 16 + (2 * dir + 1) * 4 + h]);
            const float m0 = SC[64 * NC2 + ((b * 4 + h) * 2 + dir) * NC2 + (dir == 0 ? jf : jb)];
            const float bt = dir == 0 ? wave_prefix_sum(lf, lane) : wave_suffix_sum(lf, lane);
            const float cv = li - bt; const float pm = dir == 0 ? wave_prefix_max(cv, lane) : wave_suffix_max(cv, lane);
            const float gv = fmaxf(m0, pm);
            LAS float* vd = vec + dir * 256; vd[lane] = cv; vd[64 + lane] = gv; vd[128 + lane] = __expf(m0 - gv); vd[192 + lane] = __expf(-(bt + gv)); }
        __syncthreads();
        { const int dir = wave >> 2, tblk = (wave >> 1) & 1, eblk = wave & 1;
            const LAS float* vd = vec + dir * 256;
            const int tl = 32 * tblk + r32; const float g_t = vd[64 + tl];
            bf16x8 qf[4];
#pragma unroll
            for (int ks = 0; ks < 4; ++ks) qf[ks] = *(const LAS bf16x8*)(Qimg + tl * 128 + (((2 * ks + hi) ^ ((tl >> 1) & 7)) << 4));
            f32x16 O = zero16(), L = zero16(), Oi = zero16(), Li = zero16();
#pragma unroll
            for (int sblk = 0; sblk < 2; ++sblk) {
                const bool valid = dir == 0 ? (sblk <= tblk) : (sblk >= tblk);
                if (valid) {
                    f32x16 S = zero16();
                    const int sl = 32 * sblk + r32;
#pragma unroll
                    for (int ks = 0; ks < 4; ++ks) { const bf16x8 ka = *(const LAS bf16x8*)(Kimg + sl * 128 + (((2 * ks + hi) ^ ((sl >> 1) & 7)) << 4)); S = mfma32(ka, qf[ks], S); }
#pragma unroll
                    for (int r = 0; r < 16; ++r) { const int s = 32 * sblk + crow(r, hi); const float w = __expf(vd[s] - g_t); const bool ok = dir == 0 ? (s <= tl) : (s >= tl); S[r] = ok ? S[r] * w : 0.f; }
                    u32x4 w0, w1;
                    w0.x = cvt_pk_bf16(S[0], S[1]); w0.y = cvt_pk_bf16(S[2], S[3]); w0.z = cvt_pk_bf16(S[4], S[5]); w0.w = cvt_pk_bf16(S[6], S[7]);
                    w1.x = cvt_pk_bf16(S[8], S[9]); w1.y = cvt_pk_bf16(S[10], S[11]); w1.z = cvt_pk_bf16(S[12], S[13]); w1.w = cvt_pk_bf16(S[14], S[15]);
                    const bf16x8 p0 = __builtin_bit_cast(bf16x8, w0), p1 = __builtin_bit_cast(bf16x8, w1);
                    const bf16x8 v0 = tr_frag(Vimg + eblk * 4096 + (2 * sblk) * 1024 + vrd), v1 = tr_frag(Vimg + eblk * 4096 + (2 * sblk + 1) * 1024 + vrd);
                    O = mfma32(p0, v0, O); O = mfma32(p1, v1, O);
                    L = mfma32(p0, ones, L); L = mfma32(p1, ones, L);
                }
            }
            { const size_t si = (size_t)((b * 4 + h) * 2 + dir) * NC2 + (dir == 0 ? jf : jb);
                const bf16_t* c0 = C0M + si * 4096 + (size_t)(32 * eblk + r32) * 64 + 8 * hi; const float* n0 = N0M + si * 64 + 8 * hi;
#pragma unroll
                for (int ks = 0; ks < 4; ++ks) { const bf16x8 cb = __builtin_bit_cast(bf16x8, *(const GAS u32x4*)(c0 + 16 * ks));
                    const f32x4 na = *(const GAS f32x4*)(n0 + 16 * ks), nb = *(const GAS f32x4*)(n0 + 16 * ks + 4);
                    u32x4 nw; nw.x = cvt_pk_bf16(na.x, na.y); nw.y = cvt_pk_bf16(na.z, na.w); nw.z = cvt_pk_bf16(nb.x, nb.y); nw.w = cvt_pk_bf16(nb.z, nb.w);
                    Oi = mfma32(qf[ks], cb, Oi); Li = mfma32(qf[ks], __builtin_bit_cast(bf16x8, nw), Li); } }
#pragma unroll
            for (int r = 0; r < 16; ++r) { const int t = 32 * tblk + crow(r, hi); const float wi = vd[128 + t], fl = vd[192 + t];
                const float num = O[r] + wi * Oi[r], den = L[r] + wi * Li[r];
                Hx[(dir * 64 + t) * 65 + 32 * eblk + r32] = num / fmaxf(fabsf(den), fl); }
        }
        __syncthreads();
        { const int t = tid >> 3, e8 = (tid & 7) * 8; float v[8]; float ss = 0.f;
#pragma unroll
            for (int i = 0; i < 8; ++i) { v[i] = Hx[t * 65 + e8 + i] + Hx[(64 + t) * 65 + e8 + i]; ss += v[i] * v[i]; }
            ss = sum8(ss);
            const float rs = 1.0f / sqrtf(ss * (1.0f / 64.0f) + EPS);
            const float og[8] = {bf_lo(ow.x), bf_hi(ow.x), bf_lo(ow.y), bf_hi(ow.y), bf_lo(ow.z), bf_hi(ow.z), bf_lo(ow.w), bf_hi(ow.w)};
            const float* nw = F.a->in[I_MLNORM] + layer * 256 + h * 64 + e8; float o[8];
#pragma unroll
            for (int i = 0; i < 8; ++i) o[i] = v[i] * rs * nw[i] * sigmoidf_(og[i]);
            u32x4 w; w.x = cvt_pk_bf16(o[0], o[1]); w.y = cvt_pk_bf16(o[2], o[3]); w.z = cvt_pk_bf16(o[4], o[5]); w.w = cvt_pk_bf16(o[6], o[7]);
            *(GAS u32x4*)(MIX + (size_t)(row0 + t) * D + h * 64 + e8) = w; }
    }
#undef ML_LOAD
    __syncthreads();
}
constexpr int HG_QR = 0, HG_VI = 8192, HG_GS = 16384, HG_KK = 49152, HG_QH = 65536, HG_KH = 81920, HG_AD = 98304, HG_LT = 106496, HG_C0 = 110592;
__device__ __forceinline__ int rm_off(int row, int ch) { return row * 128 + ((ch ^ ((row >> 1) & 7)) << 4); }
struct HgRaw { u32x4 v, q, f0, f1; };
template <bool WITH_Q>
__device__ __forceinline__ void hg_load(Frame& F, int h, int row0, int tid, HgRaw& r) {
    const bf16_t* pr = (const bf16_t*)(F.ws + WS_P) + (size_t)(row0 + (tid >> 3)) * PW + h * 64 + (tid & 7) * 8;
    r.v = *(const GAS u32x4*)(pr + HG_I); if (WITH_Q) r.q = *(const GAS u32x4*)(pr + HG_Q); r.f0 = *(const GAS u32x4*)(pr + HG_F); r.f1 = *(const GAS u32x4*)(pr + HG_F + 256);
}
template <bool WITH_Q>
__device__ __forceinline__ void hg_stage(Frame& F, int layer, int h, const HgRaw& raw, int tid) {
    const int ps = tid >> 3, pc = tid & 7;
    {
        const f32x4 lba = *(const GAS f32x4*)((const float*)(F.ws + WS_SMALL + SM_LB) + layer * 256 + h * 64 + pc * 8), lbb = *(const GAS f32x4*)((const float*)(F.ws + WS_SMALL + SM_LB) + layer * 256 + h * 64 + pc * 8 + 4);
        const float lb[8] = {lba.x, lba.y, lba.z, lba.w, lbb.x, lbb.y, lbb.z, lbb.w};
        *(LAS u32x4*)(F.lds + HG_VI + (pc >> 2) * 4096 + ps * 64 + (pc & 3) * 16) = raw.v;
        if (WITH_Q) { const u32x4 w = raw.q; u32x4 o;
            o.x = cvt_pk_bf16(siluf_(bf_lo(w.x)), siluf_(bf_hi(w.x))); o.y = cvt_pk_bf16(siluf_(bf_lo(w.y)), siluf_(bf_hi(w.y))); o.z = cvt_pk_bf16(siluf_(bf_lo(w.z)), siluf_(bf_hi(w.z))); o.w = cvt_pk_bf16(siluf_(bf_lo(w.w)), siluf_(bf_hi(w.w)));
            *(LAS u32x4*)(F.lds + HG_QR + rm_off(ps, pc)) = o; }
#pragma unroll
        for (int dir = 0; dir < 2; ++dir) { const u32x4 w = dir == 0 ? raw.f0 : raw.f1;
            const float fr[8] = {bf_lo(w.x), bf_hi(w.x), bf_lo(w.y), bf_hi(w.y), bf_lo(w.z), bf_hi(w.z), bf_lo(w.w), bf_hi(w.w)}; float g8[8], k8[8];
            float f8[8];
#pragma unroll
            for (int i = 0; i < 8; ++i) { const float sg = sigmoidf_(fr[i]); const float f = fmaxf(lb[i], 1e-30f) + (1.0f - lb[i]) * sg; f8[i] = f; g8[i] = __log2f(f);     k8[i] = (1.0f - lb[i]) * (1.0f - sg); }
            if (WITH_Q) { LAS float* fd = (LAS float*)(F.lds + HG_QH) + dir * 4096 + ps * 64 + pc * 8;
                *(LAS f32x4*)fd = (f32x4){f8[0], f8[1], f8[2], f8[3]}; *(LAS f32x4*)(fd + 4) = (f32x4){f8[4], f8[5], f8[6], f8[7]}; }
            LAS float* gs = (LAS float*)(F.lds + HG_GS) + dir * 4096 + ps * 64 + pc * 8;
            *(LAS f32x4*)gs = (f32x4){g8[0], g8[1], g8[2], g8[3]}; *(LAS f32x4*)(gs + 4) = (f32x4){g8[4], g8[5], g8[6], g8[7]};
            u32x4 o; o.x = cvt_pk_bf16(k8[0], k8[1]); o.y = cvt_pk_bf16(k8[2], k8[3]); o.z = cvt_pk_bf16(k8[4], k8[5]); o.w = cvt_pk_bf16(k8[6], k8[7]);
            *(LAS u32x4*)(F.lds + HG_KK + dir * 8192 + rm_off(ps, pc)) = o; }
    }
    __syncthreads();
    { const int dir = tid >> 8, grp = (tid >> 6) & 3, k = tid & 63; LAS float* gs = (LAS float*)(F.lds + HG_GS) + dir * 4096 + k; float acc = 0.f;
#pragma unroll
        for (int x = 0; x < 16; ++x) { const int tok = 16 * grp + (dir == 0 ? x : 15 - x); acc += gs[tok * 64]; gs[tok * 64] = acc; }
        ((LAS float*)(F.lds + HG_LT))[(dir * 4 + grp) * 64 + k] = acc; }
    __syncthreads();
}
__device__ __forceinline__ void hg_a_phase(Frame& F, int layer) {
    PHASE_TID();
    bf16_t* DCM = (bf16_t*)(F.ws + WS_DCM); float* DNM = (float*)(F.ws + WS_DNM);
    const int r32 = lane & 31, hi = lane >> 5;
    const int vrd = ((lane >> 4) & 1) * 32 + (lane & 3) * 8 + (4 * hi + ((lane & 15) >> 2)) * 64;
    const int ps = tid >> 3, pc = tid & 7;
    HgRaw cur; if (F.bid < 16 * NC2) { int b, h, c, row0, jf, jb; ml_unit(F.bid, b, h, c, row0, jf, jb); hg_load<false>(F, h, row0, tid, cur); }
    for (int unit = F.bid; unit < 16 * NC2; unit += F.G) {
        int b, h, c, row0, jf, jb; ml_unit(unit, b, h, c, row0, jf, jb);
        HgRaw nxt = cur; if (unit + F.G < 16 * NC2) { int b2, h2, c2, r2, j2, j3; ml_unit(unit + F.G, b2, h2, c2, r2, j2, j3); hg_load<false>(F, h2, r2, tid, nxt); }
        __syncthreads();
        hg_stage<false>(F, layer, h, cur, tid); cur = nxt;
        const LAS float* LT = (const LAS float*)(F.lds + HG_LT);
#pragma unroll
        for (int dir = 0; dir < 2; ++dir) { const int grp = ps >> 4; const LAS float* gs = (const LAS float*)(F.lds + HG_GS) + dir * 4096 + ps * 64 + pc * 8;
            const u32x4 kw = *(const LAS u32x4*)(F.lds + HG_KK + dir * 8192 + rm_off(ps, pc));
            const float kk8[8] = {bf_lo(kw.x), bf_hi(kw.x), bf_lo(kw.y), bf_hi(kw.y), bf_lo(kw.z), bf_hi(kw.z), bf_lo(kw.w), bf_hi(kw.w)}; float o8[8];
#pragma unroll
            for (int i = 0; i < 8; ++i) { float ex = LT[(dir * 4 + grp) * 64 + pc * 8 + i] - gs[i];
#pragma unroll
                for (int g2 = 0; g2 < 4; ++g2) { const bool after = dir == 0 ? (g2 > grp) : (g2 < grp); if (after) ex += LT[(dir * 4 + g2) * 64 + pc * 8 + i]; }
                o8[i] = kk8[i] * fast_exp2(ex); }
            u32x4 o; o.x = cvt_pk_bf16(o8[0], o8[1]); o.y = cvt_pk_bf16(o8[2], o8[3]); o.z = cvt_pk_bf16(o8[4], o8[5]); o.w = cvt_pk_bf16(o8[6], o8[7]);
            *(LAS u32x4*)(F.lds + HG_QH + dir * 8192 + (pc >> 2) * 4096 + ps * 64 + (pc & 3) * 16) = o; }
        if (tid < 128) { const int dir = tid >> 6, k = tid & 63; const float tot = (LT[(dir * 4 + 0) * 64 + k] + LT[(dir * 4 + 1) * 64 + k]) + (LT[(dir * 4 + 2) * 64 + k] + LT[(dir * 4 + 3) * 64 + k]);
            DNM[((size_t)(32 + (b * 4 + h) * 2 + dir) * NC2 + (dir == 0 ? jf : jb)) * 64 + k] = fast_exp2(tot); }
        __syncthreads();
        { const int dir = wave >> 2, eblk = (wave >> 1) & 1, dblk = wave & 1;
            f32x16 acc = zero16();
#pragma unroll
            for (int ks = 0; ks < 4; ++ks) { const bf16x8 va = tr_frag(F.lds + HG_VI + eblk * 4096 + ks * 1024 + vrd), kb = tr_frag(F.lds + HG_QH + dir * 8192 + dblk * 4096 + ks * 1024 + vrd);
                acc = mfma32(va, kb, acc); }
            const size_t si = (size_t)(32 + (b * 4 + h) * 2 + dir) * NC2 + (dir == 0 ? jf : jb);
            bf16_t* dst = DCM + si * 4096 + (32 * eblk) * 64 + 32 * dblk + r32;
#pragma unroll
            for (int r = 0; r < 16; ++r) dst[crow(r, hi) * 64] = (bf16_t)(cvt_pk_bf16(acc[r], 0.f) & 0xffffu);
        }
    }
}
__device__ __forceinline__ bf16x8 scale_frag(bf16x8 v, const LAS float* e0, const LAS float* e1, const LAS float* e2, int n) {
    const u32x4 w = __builtin_bit_cast(u32x4, v);
    f32x4 a = *(const LAS f32x4*)e0, bq = *(const LAS f32x4*)(e0 + 4);
    if (n > 1) { a = a + *(const LAS f32x4*)e1; bq = bq + *(const LAS f32x4*)(e1 + 4); }
    if (n > 2) { a = a + *(const LAS f32x4*)e2; bq = bq + *(const LAS f32x4*)(e2 + 4); }
    u32x4 o; o.x = cvt_pk_bf16(bf_lo(w.x) * fast_exp2(a.x), bf_hi(w.x) * fast_exp2(a.y)); o.y = cvt_pk_bf16(bf_lo(w.y) * fast_exp2(a.z), bf_hi(w.y) * fast_exp2(a.w));
    o.z = cvt_pk_bf16(bf_lo(w.z) * fast_exp2(bq.x), bf_hi(w.z) * fast_exp2(bq.y)); o.w = cvt_pk_bf16(bf_lo(w.w) * fast_exp2(bq.z), bf_hi(w.w) * fast_exp2(bq.w));
    return __builtin_bit_cast(bf16x8, o); }
__device__ __forceinline__ void hg_c_phase(Frame& F, int layer, bool need_ctx) {
    PHASE_TID();
    const bf16_t* P = (const bf16_t*)(F.ws + WS_P); bf16_t* MIX = (bf16_t*)(F.ws + WS_MIX); const bf16_t* C0M = (const bf16_t*)(F.ws + WS_C0M);
    const int ps = tid >> 3, pc = tid & 7;
    const int l16 = lane & 15, g4 = lane >> 4;
    const int nunit = need_ctx ? 16 * NC2 : 16 * 64;
    const int vb = F.G == 256 ? ((F.bid + 128) & 255) : F.bid;
    HgRaw cur; if (vb < nunit) { const int un = need_ctx ? vb : (vb >> 6) * NC2 + 4 + (vb & 63); int b, h, c, row0, jf, jb; ml_unit(un, b, h, c, row0, jf, jb); hg_load<true>(F, h, row0, tid, cur); }
    for (int u0 = vb; u0 < nunit; u0 += F.G) {
        const int unit = need_ctx ? u0 : (u0 >> 6) * NC2 + 4 + (u0 & 63);
        int b, h, c, row0, jf, jb; ml_unit(unit, b, h, c, row0, jf, jb);
        HgRaw nxt = cur; if (u0 + F.G < nunit) { const int un = need_ctx ? u0 + F.G : ((u0 + F.G) >> 6) * NC2 + 4 + ((u0 + F.G) & 63); int b2, h2, c2, r2, j2, j3; ml_unit(un, b2, h2, c2, r2, j2, j3); hg_load<true>(F, h2, r2, tid, nxt); }
        u32x4 c0raw[2];
#pragma unroll
        for (int dir = 0; dir < 2; ++dir) { const size_t sid = (size_t)(32 + (b * 4 + h) * 2 + dir) * NC2 + (dir == 0 ? jf : jb); c0raw[dir] = *(const GAS u32x4*)(C0M + sid * 4096 + ps * 64 + pc * 8); }
        const u32x4 owraw = *(const GAS u32x4*)(P + (size_t)(row0 + (tid >> 3)) * PW + HG_G + h * 64 + (tid & 7) * 8);
        __syncthreads();
        hg_stage<true>(F, layer, h, cur, tid); cur = nxt;
        const LAS float* LT = (const LAS float*)(F.lds + HG_LT);
        { const int dir = wave >> 2, grp = wave & 3, pl = lane >> 3, kc = lane & 7, n1 = 16 - pl;
            LAS float* AD = (LAS float*)(F.lds + HG_AD) + (dir * 4 + grp) * 256;
            const LAS float* FD = (const LAS float*)(F.lds + HG_QH) + dir * 4096 + kc * 8;
            const int s1 = dir == 0 ? pl : 15 - pl, s2 = 15 - s1;
            const u32x4 kw1 = *(const LAS u32x4*)(F.lds + HG_KK + dir * 8192 + rm_off(16 * grp + s1, kc)), kw2 = *(const LAS u32x4*)(F.lds + HG_KK + dir * 8192 + rm_off(16 * grp + s2, kc));
            float kd[8] = {bf_lo(kw1.x), bf_hi(kw1.x), bf_lo(kw1.y), bf_hi(kw1.y), bf_lo(kw1.z), bf_hi(kw1.z), bf_lo(kw1.w), bf_hi(kw1.w)};
            for (int it = 0; it < 17; ++it) {
                const bool second = it >= n1; const int x = second ? (15 - pl) + (it - n1) : pl + it;
                const int tl = dir == 0 ? x : 15 - x, sl = second ? s2 : s1, tr = 16 * grp + tl;
                const f32x4 fa = *(const LAS f32x4*)(FD + tr * 64), fb = *(const LAS f32x4*)(FD + tr * 64 + 4);
                const u32x4 qw = *(const LAS u32x4*)(F.lds + HG_QR + rm_off(tr, kc));
                kd[0] *= fa.x; kd[1] *= fa.y; kd[2] *= fa.z; kd[3] *= fa.w; kd[4] *= fb.x; kd[5] *= fb.y; kd[6] *= fb.z; kd[7] *= fb.w;
                if (it == 0 || it == n1) { const u32x4 kw = second ? kw2 : kw1;
                    kd[0] = bf_lo(kw.x); kd[1] = bf_hi(kw.x); kd[2] = bf_lo(kw.y); kd[3] = bf_hi(kw.y); kd[4] = bf_lo(kw.z); kd[5] = bf_hi(kw.z); kd[6] = bf_lo(kw.w); kd[7] = bf_hi(kw.w); }
                float sum = (bf_lo(qw.x) * kd[0] + bf_hi(qw.x) * kd[1]) + (bf_lo(qw.y) * kd[2] + bf_hi(qw.y) * kd[3]);
                sum += (bf_lo(qw.z) * kd[4] + bf_hi(qw.z) * kd[5]) + (bf_lo(qw.w) * kd[6] + bf_hi(qw.w) * kd[7]);
                sum = sum8(sum);
                if (kc == 0) AD[tl * 16 + sl] = sum; }
        }
        __syncthreads();
        { const u32x4 qw = *(const LAS u32x4*)(F.lds + HG_QR + rm_off(ps, pc));
            const float q8[8] = {bf_lo(qw.x), bf_hi(qw.x), bf_lo(qw.y), bf_hi(qw.y), bf_lo(qw.z), bf_hi(qw.z), bf_lo(qw.w), bf_hi(qw.w)};
#pragma unroll
            for (int dir = 0; dir < 2; ++dir) { const int grp = ps >> 4; const LAS float* gs = (const LAS float*)(F.lds + HG_GS) + dir * 4096 + ps * 64 + pc * 8;
                const u32x4 kw = *(const LAS u32x4*)(F.lds + HG_KK + dir * 8192 + rm_off(ps, pc));
                const float kk8[8] = {bf_lo(kw.x), bf_hi(kw.x), bf_lo(kw.y), bf_hi(kw.y), bf_lo(kw.z), bf_hi(kw.z), bf_lo(kw.w), bf_hi(kw.w)}; float qo[8], ko[8];
#pragma unroll
                for (int i = 0; i < 8; ++i) { const float gv = gs[i]; qo[i] = q8[i] * fast_exp2(gv); ko[i] = kk8[i] * fast_exp2(LT[(dir * 4 + grp) * 64 + pc * 8 + i] - gv); }
                u32x4 o; o.x = cvt_pk_bf16(qo[0], qo[1]); o.y = cvt_pk_bf16(qo[2], qo[3]); o.z = cvt_pk_bf16(qo[4], qo[5]); o.w = cvt_pk_bf16(qo[6], qo[7]);
                *(LAS u32x4*)(F.lds + HG_QH + dir * 8192 + rm_off(ps, pc)) = o;
                o.x = cvt_pk_bf16(ko[0], ko[1]); o.y = cvt_pk_bf16(ko[2], ko[3]); o.z = cvt_pk_bf16(ko[4], ko[5]); o.w = cvt_pk_bf16(ko[6], ko[7]);
                *(LAS u32x4*)(F.lds + HG_KH + dir * 8192 + rm_off(ps, pc)) = o;
                *(LAS u32x4*)(F.lds + HG_C0 + dir * 8192 + rm_off(ps, pc)) = c0raw[dir]; } }
        __syncthreads();
        { const int dir = wave >> 2, isub = wave & 3;
#define HG_GRP(j) (dir == 0 ? (j) : 3 - (j))
            const int gt_ = HG_GRP(isub); const int tt = 16 * gt_ + l16;
            const LAS float* LTd = LT + dir * 256;
            bf16x8 qh[2];
#pragma unroll
            for (int k2 = 0; k2 < 2; ++k2) qh[k2] = *(const LAS bf16x8*)(F.lds + HG_QH + dir * 8192 + rm_off(tt, 4 * k2 + g4));
            f32x4 S[4];
#pragma unroll
            for (int j = 0; j < 4; ++j) { S[j] = (f32x4){0.f, 0.f, 0.f, 0.f};
                if (j < isub) { const int gsrc = HG_GRP(j); const int ts = 16 * gsrc + l16; const int nd = isub - j - 1;
#pragma unroll
                    for (int k2 = 0; k2 < 2; ++k2) { const bf16x8 ka = *(const LAS bf16x8*)(F.lds + HG_KH + dir * 8192 + rm_off(ts, 4 * k2 + g4));
                        const int ko = 32 * k2 + 8 * g4;
                        const bf16x8 qb = nd == 0 ? qh[k2] : scale_frag(qh[k2], LTd + HG_GRP(j + 1) * 64 + ko, LTd + HG_GRP(j + 2 > 3 ? 3 : j + 2) * 64 + ko, LTd, nd);
                        S[j] = mfma16(ka, qb, S[j]); }
                } else if (j == isub) { const f32x4 ad = *(const LAS f32x4*)((const LAS float*)(F.lds + HG_AD) + (dir * 4 + gt_) * 256 + l16 * 16 + 4 * g4);
#pragma unroll
                    for (int r = 0; r < 4; ++r) { const int sl = 4 * g4 + r; const bool ok = dir == 0 ? (sl <= l16) : (sl >= l16); S[j][r] = ok ? ad[r] : 0.f; } }
            }
            f32x4 O[4];
#pragma unroll
            for (int et = 0; et < 4; ++et) O[et] = (f32x4){0.f, 0.f, 0.f, 0.f};
#pragma unroll
            for (int pr2 = 0; pr2 < 2; ++pr2) { if (2 * pr2 <= isub) {
                u32x4 pw; pw.x = cvt_pk_bf16(S[2 * pr2][0], S[2 * pr2][1]); pw.y = cvt_pk_bf16(S[2 * pr2][2], S[2 * pr2][3]); pw.z = cvt_pk_bf16(S[2 * pr2 + 1][0], S[2 * pr2 + 1][1]); pw.w = cvt_pk_bf16(S[2 * pr2 + 1][2], S[2 * pr2 + 1][3]);
                const bf16x8 pa = __builtin_bit_cast(bf16x8, pw);
                const int ra = 16 * HG_GRP(2 * pr2) + 4 * g4 + (l16 >> 2), rb = 16 * HG_GRP(2 * pr2 + 1) + 4 * g4 + (l16 >> 2);
#pragma unroll
                for (int et = 0; et < 4; ++et) { const int cb = 16 * et + 4 * (l16 & 3); const int co = (cb >> 5) * 4096 + (cb & 31) * 2;
                    const s16x4 lo = __builtin_bit_cast(s16x4, __builtin_amdgcn_ds_read_tr16_b64_v4i16((LAS s16x4*)(F.lds + HG_VI + co + ra * 64)));
                    const s16x4 hh = __builtin_bit_cast(s16x4, __builtin_amdgcn_ds_read_tr16_b64_v4i16((LAS s16x4*)(F.lds + HG_VI + co + rb * 64)));
                    const bf16x8 vf = {lo[0], lo[1], lo[2], lo[3], hh[0], hh[1], hh[2], hh[3]};
                    O[et] = mfma16(pa, vf, O[et]); } } }
            { const size_t si = (size_t)(32 + (b * 4 + h) * 2 + dir) * NC2 + (dir == 0 ? jf : jb);
#pragma unroll
                for (int k2 = 0; k2 < 2; ++k2) { const int ko = 32 * k2 + 8 * g4;
                    const bf16x8 qi = isub == 0 ? qh[k2] : scale_frag(qh[k2], LTd + HG_GRP(0) * 64 + ko, LTd + HG_GRP(1) * 64 + ko, LTd + HG_GRP(2) * 64 + ko, isub);
#pragma unroll
                    for (int et = 0; et < 4; ++et) { const bf16x8 cb = *(const LAS bf16x8*)(F.lds + HG_C0 + dir * 8192 + rm_off(16 * et + l16, 4 * k2 + g4));
                        O[et] = mfma16(qi, cb, O[et]); } } }
            LAS float* Hx = (LAS float*)(F.lds + HG_GS);
#pragma unroll
            for (int et = 0; et < 4; ++et)
#pragma unroll
                for (int r = 0; r < 4; ++r) Hx[(dir * 64 + 16 * gt_ + 4 * g4 + r) * 64 + 16 * et + l16] = O[et][r];
#undef HG_GRP
        }
        __syncthreads();
        { const int t = tid >> 3, e8 = (tid & 7) * 8; const LAS float* Hx = (const LAS float*)(F.lds + HG_GS); float v[8]; float ss = 0.f;
            const f32x4 a0 = *(const LAS f32x4*)(Hx + t * 64 + e8), a1 = *(const LAS f32x4*)(Hx + t * 64 + e8 + 4), b0 = *(const LAS f32x4*)(Hx + (64 + t) * 64 + e8), b1 = *(const LAS f32x4*)(Hx + (64 + t) * 64 + e8 + 4);
            v[0] = a0.x + b0.x; v[1] = a0.y + b0.y; v[2] = a0.z + b0.z; v[3] = a0.w + b0.w; v[4] = a1.x + b1.x; v[5] = a1.y + b1.y; v[6] = a1.z + b1.z; v[7] = a1.w + b1.w;
#pragma unroll
            for (int i = 0; i < 8; ++i) ss += v[i] * v[i];
            ss = sum8(ss);
            const float rs = 1.0f / sqrtf(ss * (1.0f / 64.0f) + EPS);
            const u32x4 ow = owraw;
            const float og[8] = {bf_lo(ow.x), bf_hi(ow.x), bf_lo(ow.y), bf_hi(ow.y), bf_lo(ow.z), bf_hi(ow.z), bf_lo(ow.w), bf_hi(ow.w)};
            const float* nw = F.a->in[I_HGNORM] + layer * 256 + h * 64 + e8; float o[8];
#pragma unroll
            for (int i = 0; i < 8; ++i) o[i] = v[i] * rs * nw[i] * siluf_(og[i]);
            u32x4 w; w.x = cvt_pk_bf16(o[0], o[1]); w.y = cvt_pk_bf16(o[2], o[3]); w.z = cvt_pk_bf16(o[4], o[5]); w.w = cvt_pk_bf16(o[6], o[7]);
            *(GAS u32x4*)(MIX + (size_t)(row0 + t) * D + 256 + h * 64 + e8) = w; }
    }
    __syncthreads();
}
__device__ __forceinline__ void finish_phase(Frame& F, int layer, int nrows) {
    PHASE_TID();
    const bf16_t* P = (const bf16_t*)(F.ws + WS_P); const float* SCR = (const float*)(F.ws + WS_SCR); bf16_t* MIX = (bf16_t*)(F.ws + WS_MIX);
    const int gw = F.bid * NWAVES + wave, NGW = F.G * NWAVES, c0 = 4 * lane;
    for (int row = gw; row < nrows; row += NGW) {
#pragma unroll
        for (int kind = 1; kind < 2; ++kind) {
            const f32x4 a = *(const GAS f32x4*)(SCR + ((size_t)(kind * 2 + 0) * ROWS + row) * 256 + c0), bq = *(const GAS f32x4*)(SCR + ((size_t)(kind * 2 + 1) * ROWS + row) * 256 + c0);
            const f32x4 v = a + bq; float ss = (v.x * v.x + v.y * v.y) + (v.z * v.z + v.w * v.w);
            ss = sum16(ss);
            const float r = 1.0f / sqrtf(ss * (1.0f / 64.0f) + EPS);
            const f32x4 w = *(const GAS f32x4*)(F.a->in[kind == 0 ? I_MLNORM : I_HGNORM] + layer * 256 + c0);
            const u32x2 gw2 = *(const GAS u32x2*)(P + (size_t)row * PW + (kind == 0 ? ML_O : HG_G) + c0);
            const f32x4 gr = {bf_lo(gw2.x), bf_hi(gw2.x), bf_lo(gw2.y), bf_hi(gw2.y)}; f32x4 o;
#pragma unroll
            for (int j = 0; j < 4; ++j) { const float gt = kind == 0 ? sigmoidf_(gr[j]) : siluf_(gr[j]); o[j] = v[j] * r * w[j] * gt; }
            u32x2 ow; ow.x = cvt_pk_bf16(o[0], o[1]); ow.y = cvt_pk_bf16(o[2], o[3]);
            *(GAS u32x2*)(MIX + (size_t)row * D + kind * 256 + c0) = ow;
        }
    }
}
#if 0
__device__ __forceinline__ void attn_naive_phase(Frame& F, int layer, bool need_ctx) {
    PHASE_TID();
    const bf16_t* P = (const bf16_t*)(F.ws + WS_P); bf16_t* MIX = (bf16_t*)(F.ws + WS_MIX);
    LAS float* Kt = (LAS float*)F.lds;
    LAS float* Vt = (LAS float*)(F.lds + 32 * 136 * 4);
    const float lam = ((const float*)(F.ws + WS_SMALL + SM_CONST))[layer * 4 + 0], lam_init = ((const float*)(F.ws + WS_SMALL + SM_CONST))[layer * 4 + 1];
    const int ql = tid >> 2, s = (tid >> 1) & 1, hf = tid & 1;
    const int nu = 512 + (need_ctx ? 32 : 0);
    for (int u = F.bid; u < nu; u += F.G) {
        int b, h, qrow0, k0, nk;
        if (u < 512) { const int bh = u >> 5, qb = u & 31; b = bh >> 2; h = bh & 3; qrow0 = b * SEQ + qb * 128; k0 = 0; nk = NKEYS; }
        else { const int bh = (u - 512) >> 1, qb = (u - 512) & 1; b = bh >> 2; h = bh & 3; qrow0 = NLAT + b * CTXL + qb * 128; k0 = SEQ; nk = CTXL; }
        const int row = qrow0 + ql;
        unsigned qp[32];
        { const bf16_t* qptr = P + (size_t)row * PW + DA_Q + h * 128 + s * 64;
#pragma unroll
            for (int i = 0; i < 8; ++i) { const u32x4 w = *(const GAS u32x4*)(qptr + 8 * i); qp[4 * i] = w.x; qp[4 * i + 1] = w.y; qp[4 * i + 2] = w.z; qp[4 * i + 3] = w.w; } }
        const int skey = tid >> 4, sch = tid & 15;
        float mx = -3.0e38f;
        for (int t0 = 0; t0 < nk; t0 += 32) {
            __syncthreads();
            { const int kidx = k0 + t0 + skey; const int krow = kidx < SEQ ? b * SEQ + kidx : NLAT + b * CTXL + (kidx - SEQ);
                const u32x4 w = *(const GAS u32x4*)(P + (size_t)krow * PW + DA_K + h * 128 + sch * 8);
                LAS float* d = Kt + skey * 136 + (sch >> 3) * 68 + (sch & 7) * 8;
                *(LAS f32x4*)d = (f32x4){bf_lo(w.x), bf_hi(w.x), bf_lo(w.y), bf_hi(w.y)}; *(LAS f32x4*)(d + 4) = (f32x4){bf_lo(w.z), bf_hi(w.z), bf_lo(w.w), bf_hi(w.w)}; }
            __syncthreads();
            for (int j = 0; j < 32; ++j) { const LAS float* kr = Kt + j * 136 + s * 68; float d0 = 0.f, d1 = 0.f;
#pragma unroll
                for (int i = 0; i < 16; i += 2) { const f32x4 ka = *(const LAS f32x4*)(kr + 4 * i), kb = *(const LAS f32x4*)(kr + 4 * i + 4);
                    d0 += (bf_lo(qp[2 * i]) * ka.x + bf_hi(qp[2 * i]) * ka.y) + (bf_lo(qp[2 * i + 1]) * ka.z + bf_hi(qp[2 * i + 1]) * ka.w);
                    d1 += (bf_lo(qp[2 * i + 2]) * kb.x + bf_hi(qp[2 * i + 2]) * kb.y) + (bf_lo(qp[2 * i + 3]) * kb.z + bf_hi(qp[2 * i + 3]) * kb.w); }
                mx = fmaxf(mx, d0 + d1); }
        }
        float acc[64];
#pragma unroll
        for (int i = 0; i < 64; ++i) acc[i] = 0.f;
        float lsum = 0.f;
        for (int t0 = 0; t0 < nk; t0 += 32) {
            __syncthreads();
            { const int kidx = k0 + t0 + skey; const int krow = kidx < SEQ ? b * SEQ + kidx : NLAT + b * CTXL + (kidx - SEQ);
                const u32x4 w = *(const GAS u32x4*)(P + (size_t)krow * PW + DA_K + h * 128 + sch * 8);
                LAS float* d = Kt + skey * 136 + (sch >> 3) * 68 + (sch & 7) * 8;
                *(LAS f32x4*)d = (f32x4){bf_lo(w.x), bf_hi(w.x), bf_lo(w.y), bf_hi(w.y)}; *(LAS f32x4*)(d + 4) = (f32x4){bf_lo(w.z), bf_hi(w.z), bf_lo(w.w), bf_hi(w.w)};
                const u32x4 wv = *(const GAS u32x4*)(P + (size_t)krow * PW + DA_V + h * 128 + sch * 8);
                LAS float* dv = Vt + skey * 136 + (sch >> 3) * 68 + (sch & 7) * 8;
                *(LAS f32x4*)dv = (f32x4){bf_lo(wv.x), bf_hi(wv.x), bf_lo(wv.y), bf_hi(wv.y)}; *(LAS f32x4*)(dv + 4) = (f32x4){bf_lo(wv.z), bf_hi(wv.z), bf_lo(wv.w), bf_hi(wv.w)}; }
            __syncthreads();
            for (int j = 0; j < 32; ++j) { const LAS float* kr = Kt + j * 136 + s * 68; float d0 = 0.f, d1 = 0.f;
#pragma unroll
                for (int i = 0; i < 16; i += 2) { const f32x4 ka = *(const LAS f32x4*)(kr + 4 * i), kb = *(const LAS f32x4*)(kr + 4 * i + 4);
                    d0 += (bf_lo(qp[2 * i]) * ka.x + bf_hi(qp[2 * i]) * ka.y) + (bf_lo(qp[2 * i + 1]) * ka.z + bf_hi(qp[2 * i + 1]) * ka.w);
                    d1 += (bf_lo(qp[2 * i + 2]) * kb.x + bf_hi(qp[2 * i + 2]) * kb.y) + (bf_lo(qp[2 * i + 3]) * kb.z + bf_hi(qp[2 * i + 3]) * kb.w); }
                const float p = fast_exp2((d0 + d1) - mx); lsum += p;
                const LAS float* vr = Vt + j * 136 + hf * 68;
#pragma unroll
                for (int i = 0; i < 16; ++i) { const f32x4 v4 = *(const LAS f32x4*)(vr + 4 * i); acc[4 * i] += p * v4.x; acc[4 * i + 1] += p * v4.y; acc[4 * i + 2] += p * v4.z; acc[4 * i + 3] += p * v4.w; } }
        }
        const float inv = 1.0f / lsum; float ss = 0.f;
#pragma unroll
        for (int i = 0; i < 64; ++i) { const float o = acc[i] * inv; const float other = __shfl_xor(o, 2); acc[i] = o - lam * other; ss += acc[i] * acc[i]; }
        ss += __shfl_xor(ss, 1);
        if (s == 0) { const float r = (1.0f - lam_init) / sqrtf(ss * (1.0f / 128.0f) + EPS); const float* nw = F.a->in[I_DANORM] + layer * 128 + hf * 64;
            bf16_t* op = MIX + (size_t)row * D + 512 + h * 128 + hf * 64;
#pragma unroll
            for (int i = 0; i < 8; ++i) { u32x4 w; w.x = cvt_pk_bf16(acc[8 * i] * r * nw[8 * i], acc[8 * i + 1] * r * nw[8 * i + 1]); w.y = cvt_pk_bf16(acc[8 * i + 2] * r * nw[8 * i + 2], acc[8 * i + 3] * r * nw[8 * i + 3]);
                w.z = cvt_pk_bf16(acc[8 * i + 4] * r * nw[8 * i + 4], acc[8 * i + 5] * r * nw[8 * i + 5]); w.w = cvt_pk_bf16(acc[8 * i + 6] * r * nw[8 * i + 6], acc[8 * i + 7] * r * nw[8 * i + 7]);
                *(GAS u32x4*)(op + 8 * i) = w; } }
    }
    __syncthreads();
}

#endif
__device__ __forceinline__ void glds16s(const void* sbase, unsigned voff, unsigned lds_dst) { unsigned keep;
    asm volatile("s_mov_b32 %0, m0\n\ts_mov_b32 m0, %3\n\ts_nop 0\n\tglobal_load_lds_dwordx4 %1, %2\n\ts_mov_b32 m0, %0" : "=&s"(keep) : "v"(voff), "s"(sbase), "s"(lds_dst) : "memory"); }
__device__ __forceinline__ void glds16(const void* gsrc, unsigned lds_dst) { unsigned keep;
    asm volatile("s_mov_b32 %0, m0\n\ts_mov_b32 m0, %2\n\ts_nop 0\n\tglobal_load_lds_dwordx4 %1, off\n\ts_mov_b32 m0, %0" : "=&s"(keep) : "v"(gsrc), "s"(lds_dst) : "memory"); }
constexpr int CW_KMAX = 12288;
__device__ __forceinline__ void kmax_phase(Frame& F, int layer) {
    PHASE_TID();
    const bf16_t* P = (const bf16_t*)(F.ws + WS_P);
    LAS float* red = (LAS float*)(F.lds);
    for (int it = F.bid; it < 256; it += F.G) {
        const int bhs = it >> 3, sl = it & 7, b = bhs >> 3, h = (bhs >> 1) & 3, sub = bhs & 1;
        float mx = 0.f;
        for (int k0 = sl * 544; k0 < sl * 544 + 544; k0 += 64) {
            const int key = k0 + (tid >> 3), ch = tid & 7;
            const int krow = key < SEQ ? b * SEQ + key : NLAT + b * CTXL + (key - SEQ);
            float ss = 0.f;
            if (key < sl * 544 + 544) { const u32x4 w = *(const GAS u32x4*)(P + (size_t)krow * PW + DA_K + h * 128 + sub * 64 + ch * 8);
                const float a0 = bf_lo(w.x), a1 = bf_hi(w.x), a2 = bf_lo(w.y), a3 = bf_hi(w.y), a4 = bf_lo(w.z), a5 = bf_hi(w.z), a6 = bf_lo(w.w), a7 = bf_hi(w.w);
                ss = ((a0 * a0 + a1 * a1) + (a2 * a2 + a3 * a3)) + ((a4 * a4 + a5 * a5) + (a6 * a6 + a7 * a7)); }
            ss = sum8(ss);
            mx = fmaxf(mx, ss);
        }
#pragma unroll
        for (int o = 8; o < 64; o <<= 1) mx = fmaxf(mx, __shfl_xor(mx, o));
        if (lane == 0) red[wave] = mx;
        __syncthreads();
        if (tid == 0) { float m = red[0];
#pragma unroll
            for (int w = 1; w < 8; ++w) m = fmaxf(m, red[w]);
            atomicMax(F.ctl + CW_KMAX + layer * 64 + bhs, __float_as_uint(m)); }
        __syncthreads();
    }
}
__device__ __forceinline__ void attn_phase(Frame& F, int layer, bool need_ctx) {
    PHASE_TID();
    const bf16_t* P = (const bf16_t*)(F.ws + WS_P); bf16_t* MIX = (bf16_t*)(F.ws + WS_MIX);
    const float lam = ((const float*)(F.ws + WS_SMALL + SM_CONST))[layer * 4 + 0], lam_init = ((const float*)(F.ws + WS_SMALL + SM_CONST))[layer * 4 + 1];
    const int r32 = lane & 31, hi = lane >> 5, sub = wave & 1, rg = wave >> 1;
    LAS unsigned char* Kb = F.lds;
    LAS unsigned char* Vb = F.lds + 16384;
    const unsigned ldsb = (unsigned)(size_t)F.lds;
    LAS float* Xb = (LAS float*)(F.lds);
    const int krd = r32 * 256, kx = r32 & 15;
    const int vrd = ((lane >> 4) & 1) * 32 + (lane & 3) * 8 + (4 * hi + ((lane & 15) >> 2)) * 64;
    unsigned voK[2], voV[2];
#pragma unroll
    for (int i_ = 0; i_ < 2; ++i_) { const int rowk = 4 * (2 * wave + i_) + (lane >> 4), chk = (lane & 15) ^ (rowk & 15); voK[i_] = (unsigned)((rowk * PW + chk * 8) * 2);
        const int j_ = 2 * wave + i_, rowv = 16 * (j_ & 3) + (lane >> 2), colv = (j_ >> 2) * 32 + (lane & 3) * 8; voV[i_] = (unsigned)((rowv * PW + colv) * 2); }
    const int nu = 512 + (need_ctx ? 32 : 0);
    if (wave >= 4) __builtin_amdgcn_s_setprio(1);
    for (int i = 0;; ++i) {
        int u = i * F.G + ((i >= 2 && F.G == 256) ? ((F.bid + 64) & 255) : F.bid); if (u >= nu) break;
        int b, h, qrow0, t0, t1;
        if (u < 512) { int bh, qb; if (F.G == 256) { bh = (F.bid & 7) * 2 + i; qb = F.bid >> 3; } else { bh = u >> 5; qb = u & 31; }
            b = bh >> 2; h = bh & 3; qrow0 = b * SEQ + qb * 128; t0 = 0; t1 = NKEYS / 64; }
        else { const int bh = (u - 512) >> 1, qb = (u - 512) & 1; b = bh >> 2; h = bh & 3; qrow0 = NLAT + b * CTXL + qb * 128; t0 = SEQ / 64; t1 = NKEYS / 64; }
        const int row = qrow0 + rg * 32 + r32;
        bf16x8 qf[4]; float qn2 = 0.f;
        { const bf16_t* qp = P + (size_t)row * PW + DA_Q + h * 128 + sub * 64 + hi * 8;
#pragma unroll
            for (int ks = 0; ks < 4; ++ks) { const u32x4 w = *(const GAS u32x4*)(qp + 16 * ks); qf[ks] = __builtin_bit_cast(bf16x8, w);
                const float a0 = bf_lo(w.x), a1 = bf_hi(w.x), a2 = bf_lo(w.y), a3 = bf_hi(w.y), a4 = bf_lo(w.z), a5 = bf_hi(w.z), a6 = bf_lo(w.w), a7 = bf_hi(w.w);
                qn2 += ((a0 * a0 + a1 * a1) + (a2 * a2 + a3 * a3)) + ((a4 * a4 + a5 * a5) + (a6 * a6 + a7 * a7)); } }
        qn2 += __shfl_xor(qn2, 32);
        const float kmax2 = __uint_as_float(__hip_atomic_load(F.ctl + CW_KMAX + layer * 64 + (b * 4 + h) * 2 + sub, RLX_AGENT));
        const float nm = -(sqrtf(qn2 * kmax2) * 1.001f + 1e-20f);
        f32x16 O[4], NM16; float ls0 = 0.f, ls1 = 0.f;
#pragma unroll
        for (int r = 0; r < 16; ++r) { O[0][r] = 0.f; O[1][r] = 0.f; O[2][r] = 0.f; O[3][r] = 0.f; NM16[r] = nm; }
        asm volatile("" : "+v"(NM16));
#define ATT_TROW(t) ((t) < SEQ / 64 ? b * SEQ + (t) * 64 : NLAT + b * CTXL + ((t) - SEQ / 64) * 64)
#define ATT_DMAK(t, buf) do { const bf16_t* pk_ = P + (size_t)ATT_TROW(t) * PW + DA_K + h * 128; \
        _Pragma("unroll") for (int i_ = 0; i_ < 2; ++i_) glds16s(pk_, voK[i_], (unsigned)__builtin_amdgcn_readfirstlane((int)(ldsb + (buf) * 32768 + (2 * wave + i_) * 1024))); } while (0)
#define ATT_DMAV(t, buf) do { const bf16_t* pv_ = P + (size_t)ATT_TROW(t) * PW + DA_V + h * 128; \
        _Pragma("unroll") for (int i_ = 0; i_ < 2; ++i_) glds16s(pv_, voV[i_], (unsigned)__builtin_amdgcn_readfirstlane((int)(ldsb + 16384 + (buf) * 32768 + (2 * wave + i_) * 1024))); } while (0)
#define ATT_QK(SA, SB, buf) do { const LAS unsigned char* kb_ = Kb + (buf) * 32768 + krd; bf16x8 kf_[8]; \
        _Pragma("unroll") for (int ks = 0; ks < 4; ++ks) { const int co = ((sub * 8 + 2 * ks + hi) ^ kx) << 4; kf_[2 * ks] = *(const LAS bf16x8*)(kb_ + co); kf_[2 * ks + 1] = *(const LAS bf16x8*)(kb_ + 32 * 256 + co); } \
        __builtin_amdgcn_sched_barrier(0);     \
        __builtin_amdgcn_s_setprio(2); SA = mfma32(kf_[0], qf[0], NM16); SB = mfma32(kf_[1], qf[0], NM16);     \
        _Pragma("unroll") for (int ks = 1; ks < 4; ++ks) { SA = mfma32(kf_[2 * ks], qf[ks], SA); SB = mfma32(kf_[2 * ks + 1], qf[ks], SB); } if (wave >= 4) __builtin_amdgcn_s_setprio(1); else __builtin_amdgcn_s_setprio(0); } while (0)
#define ATT_STEP(CA, CB, t) do { const int cur = ((t) - t0) % 3, nx2 = ((t) + 2 - t0) % 3; \
        if ((t) + 2 < t1) { ATT_DMAK((t) + 2, nx2); ATT_DMAV((t) + 2, nx2); if (ATT_DBL & 8) { ATT_DMAK((t) + 2, nx2); ATT_DMAV((t) + 2, nx2); } } \
        f32x16 CA, CB; ATT_QK(CA, CB, cur); if (ATT_DBL & 1) { ATT_QK(CA, CB, cur); } \
        bf16x8 pf[4]; \
        _Pragma("unroll") for (int s2 = 0; s2 < 2; ++s2) { u32x4 w0, w1; \
            w0.x = cvtpk_s(fast_exp2(CA[8 * s2 + 0]), fast_exp2(CA[8 * s2 + 1])); w0.y = cvtpk_s(fast_exp2(CA[8 * s2 + 2]), fast_exp2(CA[8 * s2 + 3])); \
            w0.z = cvtpk_s(fast_exp2(CA[8 * s2 + 4]), fast_exp2(CA[8 * s2 + 5])); w0.w = cvtpk_s(fast_exp2(CA[8 * s2 + 6]), fast_exp2(CA[8 * s2 + 7])); \
            w1.x = cvtpk_s(fast_exp2(CB[8 * s2 + 0]), fast_exp2(CB[8 * s2 + 1])); w1.y = cvtpk_s(fast_exp2(CB[8 * s2 + 2]), fast_exp2(CB[8 * s2 + 3])); \
            w1.z = cvtpk_s(fast_exp2(CB[8 * s2 + 4]), fast_exp2(CB[8 * s2 + 5])); w1.w = cvtpk_s(fast_exp2(CB[8 * s2 + 6]), fast_exp2(CB[8 * s2 + 7])); \
            ls0 = dot2_ones(w0.x, ls0); ls1 = dot2_ones(w1.x, ls1); ls0 = dot2_ones(w0.y, ls0); ls1 = dot2_ones(w1.y, ls1); \
            ls0 = dot2_ones(w0.z, ls0); ls1 = dot2_ones(w1.z, ls1); ls0 = dot2_ones(w0.w, ls0); ls1 = dot2_ones(w1.w, ls1);     \
            pf[s2] = __builtin_bit_cast(bf16x8, w0); pf[2 + s2] = __builtin_bit_cast(bf16x8, w1); } \
        const LAS unsigned char* vb_ = Vb + cur * 32768 + vrd; \
        bf16x8 vfa_[4], vfb_[4]; \
        _Pragma("unroll") for (int blk = 0; blk < 4; ++blk) vfa_[blk] = tr_frag(vb_ + blk * 4096); \
        _Pragma("unroll") for (int blk = 0; blk < 4; ++blk) vfb_[blk] = tr_frag(vb_ + blk * 4096 + 1024); \
        __builtin_amdgcn_sched_barrier(0); \
        __builtin_amdgcn_s_setprio(2); \
        _Pragma("unroll") for (int blk = 0; blk < 4; ++blk) O[blk] = mfma32(pf[0], vfa_[blk], O[blk]); \
        _Pragma("unroll") for (int blk = 0; blk < 4; ++blk) vfa_[blk] = tr_frag(vb_ + blk * 4096 + 2048); \
        __builtin_amdgcn_sched_barrier(0); \
        _Pragma("unroll") for (int blk = 0; blk < 4; ++blk) O[blk] = mfma32(pf[1], vfb_[blk], O[blk]); \
        _Pragma("unroll") for (int blk = 0; blk < 4; ++blk) vfb_[blk] = tr_frag(vb_ + blk * 4096 + 3072); \
        __builtin_amdgcn_sched_barrier(0); \
        _Pragma("unroll") for (int blk = 0; blk < 4; ++blk) O[blk] = mfma32(pf[2], vfa_[blk], O[blk]); \
        _Pragma("unroll") for (int blk = 0; blk < 4; ++blk) O[blk] = mfma32(pf[3], vfb_[blk], O[blk]); \
        if (wave >= 4) __builtin_amdgcn_s_setprio(1); else __builtin_amdgcn_s_setprio(0); \
        if ((t) + 2 < t1) { if (ATT_DBL & 8) asm volatile("s_waitcnt vmcnt(8) lgkmcnt(0)" ::: "memory"); else asm volatile("s_waitcnt vmcnt(4) lgkmcnt(0)" ::: "memory"); } else asm volatile("s_waitcnt vmcnt(0) lgkmcnt(0)" ::: "memory"); \
        __builtin_amdgcn_s_barrier(); asm volatile("" ::: "memory"); } while (0)
        __syncthreads();
        ATT_DMAK(t0, 0); ATT_DMAV(t0, 0); ATT_DMAK(t0 + 1, 1); ATT_DMAV(t0 + 1, 1);
        asm volatile("s_waitcnt vmcnt(4)" ::: "memory"); __builtin_amdgcn_s_barrier(); asm volatile("" ::: "memory");
        for (int t = t0; t < t1; ++t) { ATT_STEP(sa_, sb_, t); }
#undef ATT_TROW
#undef ATT_DMAK
#undef ATT_DMAV
#undef ATT_QK
#undef ATT_STEP
        { float lsum = ls0 + ls1; lsum += __shfl_xor(lsum, 32);
            LAS float* lw = (LAS float*)(F.lds + 65536) + wave * 32;
            if (hi == 0) lw[r32] = 1.0f / lsum;
            asm volatile("s_waitcnt lgkmcnt(0)" ::: "memory");
#pragma unroll
            for (int g = 0; g < 4; ++g) { const f32x4 iv = *(const LAS f32x4*)(lw + 8 * g + 4 * hi);
#pragma unroll
                for (int j = 0; j < 4; ++j) { const float inv = iv[j]; O[0][4 * g + j] *= inv; O[1][4 * g + j] *= inv; O[2][4 * g + j] *= inv; O[3][4 * g + j] *= inv; } } }
        LAS float* xw = Xb + rg * 4096 + lane;
        if (sub == 1) {
#pragma unroll
            for (int blk = 0; blk < 4; ++blk)
#pragma unroll
                for (int r = 0; r < 16; ++r) xw[(blk * 16 + r) * 64] = O[blk][r];
        }
        __syncthreads();
        if (sub == 0) {
            const float* nw = F.a->in[I_DANORM] + layer * 128 + r32;
            const float w0 = nw[0], w1 = nw[32], w2 = nw[64], w3 = nw[96];
#pragma unroll
            for (int r = 0; r < 16; ++r) {
                const float d0 = O[0][r] - lam * xw[(0 * 16 + r) * 64], d1 = O[1][r] - lam * xw[(1 * 16 + r) * 64], d2 = O[2][r] - lam * xw[(2 * 16 + r) * 64], d3 = O[3][r] - lam * xw[(3 * 16 + r) * 64];
                float ss = (d0 * d0 + d1 * d1) + (d2 * d2 + d3 * d3);
                ss = sum32(ss);
                const float sc2 = (1.0f - lam_init) / sqrtf(ss * (1.0f / 128.0f) + EPS);
                const int qr = (r & 3) + 8 * (r >> 2) + 4 * hi;
                bf16_t* op = MIX + (size_t)(qrow0 + rg * 32 + qr) * D + 512 + h * 128 + r32;
                op[0] = (bf16_t)(cvt_pk_bf16(d0 * sc2 * w0, 0.f) & 0xffffu); op[32] = (bf16_t)(cvt_pk_bf16(d1 * sc2 * w1, 0.f) & 0xffffu);
                op[64] = (bf16_t)(cvt_pk_bf16(d2 * sc2 * w2, 0.f) & 0xffffu); op[96] = (bf16_t)(cvt_pk_bf16(d3 * sc2 * w3, 0.f) & 0xffffu);
            }
        }
    }
    __builtin_amdgcn_s_setprio(0);
    __syncthreads();
}

template <int K>
__device__ __forceinline__ void ctx_gemm_phase(Frame& F, const bf16_t* A, const bf16_t* Bt, bf16_t* C) {
    PHASE_TID();
    LAS float* part = (LAS float*)F.lds;
    const int l16 = lane & 15, g4 = lane >> 4; constexpr int kw = K >> 3;
    for (int tile = F.bid; tile < 256; tile += F.G) {
        const int tm = tile >> 4, tn = tile & 15;
        const bf16_t* ap = A + (size_t)(tm * 64 + l16) * K + wave * kw + 8 * g4;
        const bf16_t* bp = Bt + (size_t)(tn * 64 + l16) * K + wave * kw + 8 * g4;
        f32x4 acc[4][4];
#pragma unroll
        for (int m = 0; m < 4; ++m)
#pragma unroll
            for (int n = 0; n < 4; ++n) { acc[m][n] = (f32x4){0.f, 0.f, 0.f, 0.f}; asm volatile("" : "+v"(acc[m][n])); }
#pragma unroll
        for (int k0 = 0; k0 < kw; k0 += 32) {
            bf16x8 a[4], b[4];
#pragma unroll
            for (int m = 0; m < 4; ++m) { a[m] = __builtin_bit_cast(bf16x8, *(const GAS u32x4*)(ap + (size_t)(16 * m) * K + k0)); b[m] = __builtin_bit_cast(bf16x8, *(const GAS u32x4*)(bp + (size_t)(16 * m) * K + k0)); }
#pragma unroll
            for (int m = 0; m < 4; ++m)
                asm volatile("s_nop 1\n\tv_mfma_f32_16x16x32_bf16 %0, %4, %5, %0\n\tv_mfma_f32_16x16x32_bf16 %1, %4, %6, %1\n\tv_mfma_f32_16x16x32_bf16 %2, %4, %7, %2\n\tv_mfma_f32_16x16x32_bf16 %3, %4, %8, %3\n\ts_nop 7\n\ts_nop 7"
                             : "+v"(acc[m][0]), "+v"(acc[m][1]), "+v"(acc[m][2]), "+v"(acc[m][3]) : "v"(a[m]), "v"(b[0]), "v"(b[1]), "v"(b[2]), "v"(b[3]));
        }
        __syncthreads();
#pragma unroll
        for (int m = 0; m < 4; ++m)
#pragma unroll
            for (int n = 0; n < 4; ++n)
#pragma unroll
                for (int r = 0; r < 4; ++r) part[wave * 4096 + ((m * 4 + n) * 4 + r) * 64 + lane] = acc[m][n][r];
        __syncthreads();
#pragma unroll
        for (int j = 0; j < 8; ++j) { const int idx = tid + 512 * j; float sum = 0.f;
#pragma unroll
            for (int w = 0; w < 8; ++w) sum += part[w * 4096 + idx];
            const int ln = idx & 63, r = (idx >> 6) & 3, mn = idx >> 8, m = mn >> 2, n = mn & 3;
            C[(size_t)(tm * 64 + 16 * m + 4 * (ln >> 4) + r) * D + tn * 64 + 16 * n + (ln & 15)] = (bf16_t)(cvt_pk_bf16(sum, 0.f) & 0xffffu); }
    }
    __syncthreads();
}
constexpr int NPHASE = 25;

#define IN(k) (lo <= (k) && (k) < hi)
#define SEAM(k) do { if (N_LAUNCHES == 1 && (k) + 1 < hi) xcd_barrier(bar); } while (0)
template <int l>
__device__ __forceinline__ void layer_body(Frame& F, const XcdBarrier& bar, const int lo, const int hi) {
    float* XC = (float*)(F.ws + WS_XC);
    bf16_t* HN = (bf16_t*)(F.ws + WS_HN); bf16_t* Pb = (bf16_t*)(F.ws + WS_P); bf16_t* MIX = (bf16_t*)(F.ws + WS_MIX); bf16_t* Yb = (bf16_t*)(F.ws + WS_Y);
    const float* COS = (const float*)(F.ws + WS_SMALL + SM_COS); const float* SIN = (const float*)(F.ws + WS_SMALL + SM_SIN);
        constexpr int pb = 1 + 12 * l; constexpr bool need_ctx = (l == 0); constexpr int nrows = need_ctx ? ROWS : NLAT;
        if (l == 0 && IN(pb + 0)) {
            RowCfg c{F.a->in[I_X], F.a->in[I_CTX], nullptr, nullptr, nullptr, nullptr, 0, 0, F.a->in[I_NPREMIX], 0, 0, 0, 0};
            if (EN(1)) { row_phase<false, false, true, true>(F, c, ROWS); if (REP(1)) { row_phase<false, false, true, true>(F, c, ROWS); } } SEAM(pb + 0); }
        if (IN(pb + 1)) {
            pg8::DenseOrder S; S.init(ROWS, PW, D, (const bf16_t*)(F.ws + WS_WIN) + (size_t)l * PW * D, F.G, F.bid);
            pg8::EpiProj E{Pb, COS, SIN};
            if (EN(2)) { pg8::gemm_phase<pg8::EpiProj, pg8::DenseOrder, true>(F.lds, (const char*)HN, D, S, E); if (REP(2)) { pg8::gemm_phase<pg8::EpiProj, pg8::DenseOrder, true>(F.lds, (const char*)HN, D, S, E); } } SEAM(pb + 1); }
        if (IN(pb + 2)) { if (EN(3)) { kmax_phase(F, l); if (REP(15)) kmax_phase(F, l); mlstm_a_phase(F, l); if (REP(16)) mlstm_a_phase(F, l); hg_a_phase(F, l); if (REP(17)) hg_a_phase(F, l); } SEAM(pb + 2); }
        if (IN(pb + 3)) { if (EN(3)) { mix_scan2_phase(F); if (REP(18)) mix_scan2_phase(F); } SEAM(pb + 3); }
        if (IN(pb + 4)) { if (EN(3)) { mlstm_c_phase(F, l, need_ctx); if (REP(19)) mlstm_c_phase(F, l, need_ctx); hg_c_phase(F, l, need_ctx); if (REP(20)) hg_c_phase(F, l, need_ctx); }
            if (EN(4)) { attn_phase(F, l, need_ctx); if (REP(4)) { attn_phase(F, l, need_ctx); } } SEAM(pb + 4); }

        if (IN(pb + 7)) {
            pg8::DenseOrder S; S.init(NLAT, D, D, (const bf16_t*)(F.ws + WS_WOUT) + (size_t)l * D * D, F.G, F.bid);
            pg8::EpiBf16 E{Yb, D};
            if (EN(6)) { pg8::gemm_phase<pg8::EpiBf16, pg8::DenseOrder, true>(F.lds, (const char*)MIX, D, S, E); if (REP(6)) { pg8::gemm_phase<pg8::EpiBf16, pg8::DenseOrder, true>(F.lds, (const char*)MIX, D, S, E); } }
            if (need_ctx && EN(6)) ctx_gemm_phase<D>(F, MIX + (size_t)NLAT * D, (const bf16_t*)(F.ws + WS_WOUT) + (size_t)l * D * D, Yb + (size_t)NLAT * D);
            SEAM(pb + 7); }
        if constexpr (l == 0) {
            if (IN(pb + 8)) { RowCfg c{F.a->in[I_X], F.a->in[I_CTX], F.out, XC, Yb, F.a->in[I_NPOSTMIX], 0, 2, F.a->in[I_NPREFFN], 0, 3, 0, 1};
                if (EN(7)) { row_phase<true, true, true, false>(F, c, ROWS); if (REP(7)) { row_phase<true, true, true, false>(F, c, ROWS); } } SEAM(pb + 8); }
            if (IN(pb + 9)) { pg8::DenseOrder S; S.init(ROWS, 2 * FF, D, (const bf16_t*)(F.ws + WS_WGU), F.G, F.bid);
                pg8::EpiSwiGLU E{Pb, FF};
                if (EN(8)) { pg8::gemm_phase<pg8::EpiSwiGLU, pg8::DenseOrder, true>(F.lds, (const char*)HN, D, S, E); if (REP(8)) { pg8::gemm_phase<pg8::EpiSwiGLU, pg8::DenseOrder, true>(F.lds, (const char*)HN, D, S, E); } } SEAM(pb + 9); }
            if (IN(pb + 10)) { pg8::DenseOrder S; S.init(NLAT, D, FF, (const bf16_t*)(F.ws + WS_WD), F.G, F.bid);
                pg8::EpiBf16 E{Yb, D};
                if (EN(9)) { pg8::gemm_phase<pg8::EpiBf16, pg8::DenseOrder, true>(F.lds, (const char*)Pb, FF, S, E); if (REP(9)) { pg8::gemm_phase<pg8::EpiBf16, pg8::DenseOrder, true>(F.lds, (const char*)Pb, FF, S, E); } }
                if (EN(9)) ctx_gemm_phase<FF>(F, Pb + (size_t)NLAT * FF, (const bf16_t*)(F.ws + WS_WD), Yb + (size_t)NLAT * D);
                SEAM(pb + 10); }
            if (IN(pb + 11)) { RowCfg c{F.out, XC, F.out, XC, Yb, F.a->in[I_NPOSTFFN], 0, 5, F.a->in[I_NPREMIX] + D, 1, 0, 1, 1};
                if (EN(10)) { row_phase<true, true, true, true>(F, c, ROWS); if (REP(10)) { row_phase<true, true, true, true>(F, c, ROWS); } } SEAM(pb + 11); }
        } else {
            if (IN(pb + 8)) { RowCfg c{F.out, XC, F.out, XC, Yb, F.a->in[I_NPOSTMIX] + D, 1, 2, F.a->in[I_NPREFFN] + D, 1, 3, 1, 1};
                if (EN(11)) { route_phase(F, c); if (REP(11)) { route_phase(F, c); } } SEAM(pb + 8); }
            if (IN(pb + 9)) { pg8::MoeOrder<true> S; S.init(F.ctl + CW_CNT, 2 * FE, D, (const bf16_t*)(F.ws + WS_MOE_GU), (size_t)2 * FE * D, F.ctl + CW_LIST, F.G, F.bid);
                pg8::EpiSwiGLU E{Pb, FE};
                if (EN(12)) { pg8::gemm_phase<pg8::EpiSwiGLU, pg8::MoeOrder<true>, true>(F.lds, (const char*)HN, D, S, E); if (REP(12)) { pg8::gemm_phase<pg8::EpiSwiGLU, pg8::MoeOrder<true>, true>(F.lds, (const char*)HN, D, S, E); } } SEAM(pb + 9); }
            if (IN(pb + 10)) {
                if (EN(13)) { { pg8::MoeDown<0> S; S.init(F.ctl + CW_CNT, (const bf16_t*)(F.ws + WS_MOE_D), (size_t)D * FE, F.G, F.bid); pg8::EpiBf16 E{(bf16_t*)(F.ws + WS_MOE_GU), D};
                        pg8::gemm_phase<pg8::EpiBf16, pg8::MoeDown<0>, true>(F.lds, (const char*)Pb, FE, S, E); }
                    { pg8::MoeDown<1> S; S.init(F.ctl + CW_CNT, (const bf16_t*)(F.ws + WS_MOE_D), (size_t)D * FE, F.G, F.bid); pg8::EpiBf16 E{(bf16_t*)(F.ws + WS_MOE_SIDE), D};
                        pg8::gemm_phase<pg8::EpiBf16, pg8::MoeDown<1>, true>(F.lds, (const char*)Pb, pg8::KSW, S, E, FE); } } SEAM(pb + 10); }
            if (IN(pb + 11)) { RowCfg c{F.out, XC, F.out, XC, nullptr, F.a->in[I_NPOSTFFN] + D, 1, 5, nullptr, 0, 0, 1, 0};
                if (EN(14)) { final_phase(F, c); if (REP(14)) { final_phase(F, c); } } }
        }
    }
__global__ void __launch_bounds__(NTHR, 2) fwd(Args args) {
    extern __shared__ __attribute__((aligned(16))) unsigned char lds_raw[];
    Frame F;
    F.lds = (LAS unsigned char*)lds_raw; F.MISC = (volatile LAS unsigned*)(F.lds + MISC_OFF);
    F.G = gridDim.x; F.bid = blockIdx.x;
    F.a = &args;
    F.out = args.out; F.ws = args.ws; F.ctl = (unsigned*)(args.ws + WS_CTL);
    for (int u = threadIdx.x; u < (LDS_BYTES - LDSCTL_OFF) / 4; u += NTHR) ((LAS unsigned*)(F.lds + LDSCTL_OFF))[u] = 0u;
    __syncthreads();
    XcdBarrier bar; bar.bar = F.ctl + CW_BAR; bar.x = 0; bar.st = nullptr;
    if (N_LAUNCHES == 1) bar = xcd_barrier_post(F.ctl + CW_BAR, F.MISC + 8);
    const int lo = args.ph_lo, hi = args.ph_hi;

    if (IN(0)) { if (EN(0)) { p_mod_vectors(F); p_consts(F); p_weights(F); if (REP(0)) { p_mod_vectors(F); p_consts(F); p_weights(F); } } SEAM(0); }

    layer_body<0>(F, bar, lo, hi);
    layer_body<1>(F, bar, lo, hi);
#undef IN
#undef SEAM
}

extern "C" void kernel_launch(void* const* d_in, const int* in_sizes, int n_in, void* d_out, int out_size, void* d_ws, size_t ws_size, hipStream_t stream) {
    static int grid = 0;
    if (grid == 0) {
        if (n_in != 26 || out_size != NLAT * D || ws_size < WS_END) { fprintf(stderr, "kernel_launch: unexpected shapes: n_in %d out %d ws %zu (need %zu)\n", n_in, out_size, ws_size, (size_t)WS_END); grid = -1; return; }
        int dev = 0, cus = 0, per_cu = 0;
        if (hipGetDevice(&dev) != hipSuccess || hipDeviceGetAttribute(&cus, hipDeviceAttributeMultiprocessorCount, dev) != hipSuccess) { grid = -1; return; }
        if (hipFuncSetAttribute((const void*)fwd, hipFuncAttributeMaxDynamicSharedMemorySize, LDS_BYTES) != hipSuccess) { fprintf(stderr, "kernel_launch: hipFuncSetAttribute failed\n"); grid = -1; return; }
        if (hipOccupancyMaxActiveBlocksPerMultiprocessor(&per_cu, (const void*)fwd, NTHR, LDS_BYTES) != hipSuccess || per_cu < 1) { fprintf(stderr, "kernel_launch: occupancy query says %d\n", per_cu); }
        (void)hipGetLastError();
        grid = cus;
    }
    if (grid < 0) return;
    (void)hipMemsetAsync((char*)d_ws + WS_CTL, 0, CTL_ZERO_BYTES, stream);
    Args a{};
    for (int i = 0; i < 26; ++i) a.in[i] = (const float*)d_in[i];
    a.out = (float*)d_out; a.ws = (unsigned char*)d_ws;
    if (N_LAUNCHES == 1) { a.ph_lo = 0; a.ph_hi = NPHASE; hipLaunchKernelGGL(fwd, dim3(grid), dim3(NTHR), LDS_BYTES, stream, a); }
    else {
        for (int p = 0; p < NPHASE; ++p) { if (p == 13) continue; a.ph_lo = p; a.ph_hi = p + 1; hipLaunchKernelGGL(fwd, dim3(grid), dim3(NTHR), LDS_BYTES, stream, a); }
    }
}
```

```cpp
#include <hip/hip_runtime.h>
#include <cstdio>
#include <cstdint>

#ifndef N_LAUNCHES
#define N_LAUNCHES 1
#endif
#ifndef ENMASK
#define ENMASK 0xffffffffu
#endif
#define EN(b) ((ENMASK >> (b)) & 1u)
#ifndef ATT_DBL
#define ATT_DBL 0
#endif
#ifndef REPMASK
#define REPMASK 0u
#endif
#define REP(b) ((REPMASK >> (b)) & 1u)

#define GAS __attribute__((address_space(1)))
#define LAS __attribute__((address_space(3)))
typedef unsigned short bf16_t;
typedef short bf16x8 __attribute__((ext_vector_type(8)));
typedef float f32x4 __attribute__((ext_vector_type(4)));
typedef float f32x2 __attribute__((ext_vector_type(2)));
typedef unsigned u32x4 __attribute__((ext_vector_type(4)));
typedef unsigned u32x2 __attribute__((ext_vector_type(2)));
typedef float f32x16 __attribute__((ext_vector_type(16)));
typedef short s16x4 __attribute__((ext_vector_type(4)));

constexpr int D = 1024, NB = 4, SEQ = 4096, CTXL = 256, NLAT = NB * SEQ, NCTX = NB * CTXL, ROWS = NLAT + NCTX;
constexpr int PW = 3840;
constexpr int ML_Q = 0, ML_K = 256, ML_V = 512, ML_O = 768, HG_Q = 1024, HG_F = 1280, HG_I = 1792, HG_G = 2048, DA_Q = 2304, DA_K = 2816, DA_V = 3328;
constexpr int WIN_LD = 3856;
constexpr int FF = 2816, FE = 3584, NE = 8;
constexpr int NKEYS = SEQ + CTXL;
constexpr float EPS = 1e-6f;
constexpr float LOG2E = 1.4426950408889634f;
constexpr float C2 = 0.125f * LOG2E;
constexpr int NWAVES = 8, NTHR = 512;

constexpr size_t MiB = 1u << 20;
constexpr size_t WS_CTL = 0, CTL_ZERO_BYTES = 2 * MiB;
constexpr size_t WS_SMALL = 2 * MiB;
constexpr size_t WS_WIN = 3 * MiB;
constexpr size_t WS_WOUT = 18 * MiB;
constexpr size_t WS_WGU = 22 * MiB;
constexpr size_t WS_WD = 33 * MiB;
constexpr size_t WS_XC = 39 * MiB;
constexpr size_t WS_MOE_SIDE = 43 * MiB;
constexpr size_t WS_HN = 43 * MiB;
constexpr size_t WS_GATES = 77 * MiB;
constexpr size_t WS_ROUTE = 79 * MiB;
constexpr size_t WS_MOE_D = 80 * MiB;
constexpr size_t WS_MOE_GU = 136 * MiB;
constexpr size_t WS_P = 248 * MiB;
constexpr size_t WS_MIX = 376 * MiB;
constexpr size_t WS_Y = 410 * MiB;
constexpr size_t WS_SCR = 444 * MiB;
constexpr size_t WS_END = 512 * MiB;
constexpr int MOE_ROWS_MAX = 34816;
constexpr int CW_BAR = 4096;
constexpr int CW_CNT = 8192;
constexpr int CW_LIST = 65536;
static_assert((CW_LIST + NE * NLAT) * 4 <= (int)CTL_ZERO_BYTES, "ctl");
constexpr size_t SM_MODV = 0, SM_COS = 256 * 1024, SM_SIN = 260 * 1024, SM_CONST = 264 * 1024, SM_LB = 268 * 1024;
constexpr size_t SM_WGATE = 320 * 1024;

constexpr int RING_BYTES = 131072, LDSCTL_OFF = RING_BYTES, MISC_OFF = LDSCTL_OFF + 320, LDS_BYTES = 147456;

#define RLX_AGENT __ATOMIC_RELAXED, __HIP_MEMORY_SCOPE_AGENT
#define PHASE_TID() int tid = threadIdx.x; asm volatile("" : "+v"(tid)); const int lane = tid & 63; const int wave = __builtin_amdgcn_readfirstlane(tid >> 6); (void)lane; (void)wave
#define LDS_WAIT() asm volatile("s_waitcnt lgkmcnt(0)" ::: "memory")
#define VM_WAIT() asm volatile("s_waitcnt vmcnt(0)" ::: "memory")
typedef float f32x2_t __attribute__((ext_vector_type(2))); typedef __bf16 bf16x2_t __attribute__((ext_vector_type(2)));
__device__ __forceinline__ unsigned cvt_pk_bf16(float lo, float hi) { const f32x2_t v = {lo, hi}; const bf16x2_t b = __builtin_convertvector(v, bf16x2_t); unsigned r = __builtin_bit_cast(unsigned, b); asm volatile("" : "+v"(r)); return r; }
__device__ __forceinline__ unsigned cvtpk_s(float lo, float hi) { const f32x2_t v = {lo, hi}; const bf16x2_t b = __builtin_convertvector(v, bf16x2_t); return __builtin_bit_cast(unsigned, b); }
__device__ __forceinline__ float dot2_ones(unsigned w, float acc) { return __builtin_amdgcn_fdot2_f32_bf16(__builtin_bit_cast(bf16x2_t, w), __builtin_bit_cast(bf16x2_t, 0x3F803F80u), acc, false); }
__device__ __forceinline__ float bf_lo(unsigned w) { return __uint_as_float(w << 16); }
__device__ __forceinline__ float bf_hi(unsigned w) { return __uint_as_float(w & 0xffff0000u); }
__device__ __forceinline__ float bf2f(bf16_t v) { return __uint_as_float((unsigned)v << 16); }
template <int CTRL, int ROWMASK>
__device__ __forceinline__ float dpp_get(float v) { return __int_as_float(__builtin_amdgcn_update_dpp(0, __float_as_int(v), CTRL, ROWMASK, 0xF, false)); }
__device__ __forceinline__ float sum8(float v) { v += dpp_get<0xB1, 0xF>(v); v += dpp_get<0x4E, 0xF>(v); v += dpp_get<0x141, 0xF>(v); return v; }
__device__ __forceinline__ float sum16(float v) { v = sum8(v); v += dpp_get<0x140, 0xF>(v); return v; }
__device__ __forceinline__ float sum32(float v) { v = sum16(v); const auto r = __builtin_amdgcn_permlane16_swap(__float_as_uint(v), __float_as_uint(v), false, false); return __uint_as_float(r[0]) + __uint_as_float(r[1]); }
__device__ __forceinline__ float wave_sum(float v) {
    v += dpp_get<0xB1, 0xF>(v); v += dpp_get<0x4E, 0xF>(v); v += dpp_get<0x141, 0xF>(v); v += dpp_get<0x140, 0xF>(v);
    v += dpp_get<0x142, 0xA>(v); v += dpp_get<0x143, 0xC>(v);
    return __int_as_float(__builtin_amdgcn_readlane(__float_as_int(v), 63)); }
__device__ __forceinline__ float fast_exp2(float x) { return __builtin_amdgcn_exp2f(x); }
__device__ __forceinline__ float fast_rcp(float x) { return __builtin_amdgcn_rcpf(x); }
__device__ __forceinline__ float sigmoidf_(float x) { return fast_rcp(1.0f + __expf(-x)); }
__device__ __forceinline__ float siluf_(float x) { return x * fast_rcp(1.0f + __expf(-x)); }
__device__ __forceinline__ float log_sigmoidf_(float x) { return fminf(x, 0.f) - log1pf(__expf(-fabsf(x))); }

#define XB_TMO      128
#define XB_XCNT(j)  (256  + 64 * (j))
#define XB_XSUB(j)  (1280 + 64 * (j))
#define XB_XGEN(j)  (2304 + 64 * (j))
#define XB_TOP      3328
#define XB_TOPGEN   3392
#define XCD_BAR_WORDS 3456
#define XB_SPIN_CAP (1u << 18)
__device__ __forceinline__ unsigned xb_ld(unsigned* p)              { return __hip_atomic_load(p, __ATOMIC_RELAXED, __HIP_MEMORY_SCOPE_AGENT); }
__device__ __forceinline__ unsigned xb_add(unsigned* p, unsigned v) { return __hip_atomic_fetch_add(p, v, __ATOMIC_RELAXED, __HIP_MEMORY_SCOPE_AGENT); }
__device__ __forceinline__ unsigned xb_xcc_id() { return (unsigned)__builtin_amdgcn_s_getreg((3 << 11) | 20) & 0xFu; }
#define XB_SPIN(cond, bar) do { unsigned _sp = 0; while (cond) { __builtin_amdgcn_s_sleep(1); \
    if ((++_sp & 255u) == 0u) { if (xb_ld(&(bar)[XB_TMO])) break; if (_sp > XB_SPIN_CAP) { atomicAdd(&(bar)[XB_TMO], 1u); break; } } } } while (0)
struct XcdBarrier { unsigned* bar; unsigned x; volatile LAS unsigned* st; };
__device__ __forceinline__ XcdBarrier xcd_barrier_post(unsigned* bar, volatile LAS unsigned* st) {
    XcdBarrier b; b.bar = bar; b.x = xb_xcc_id(); b.st = st;
    if (threadIdx.x == 0) (void)xb_add(&bar[XB_XCNT(b.x)], 1u);
    return b;
}
__device__ __forceinline__ void xcd_barrier_complete(unsigned* bar, unsigned x, unsigned& nloc, unsigned& nx) {
    const unsigned G = gridDim.x * gridDim.y * gridDim.z;
    unsigned sum, cnt, mine, sp = 0u;
    for (;;) {
        sum = 0u; cnt = 0u; mine = 0u;
#pragma unroll
        for (unsigned j = 0; j < 16; ++j) { const unsigned c = xb_ld(&bar[XB_XCNT(j)]); sum += c; cnt += (c > 0u) ? 1u : 0u; mine = (j == x) ? c : mine; }
        if (sum == G) break;
        __builtin_amdgcn_s_sleep(1);
        if ((++sp & 255u) == 0u) { if (xb_ld(&bar[XB_TMO])) break; if (sp > XB_SPIN_CAP) { atomicAdd(&bar[XB_TMO], 1u); break; } }
    }
    nloc = mine > 0u ? mine : 1u; nx = cnt > 0u ? cnt : 1u;
}
__device__ __forceinline__ void xcd_barrier(const XcdBarrier& b) {
    asm volatile("s_waitcnt vmcnt(0)" ::: "memory");
    __syncthreads();
    if (threadIdx.x == 0) {
        unsigned* bar = b.bar;
        __builtin_amdgcn_s_waitcnt(0);
        unsigned nloc = b.st[0], nx = b.st[1];
        if (nloc == 0u) { xcd_barrier_complete(bar, b.x, nloc, nx); b.st[0] = nloc; b.st[1] = nx; }
        const unsigned old = xb_add(&bar[XB_XSUB(b.x)], 1u);
        const unsigned gen = old / nloc;
        if (old + 1u == (gen + 1u) * nloc) {
            __builtin_amdgcn_fence(__ATOMIC_RELEASE, "agent");
            asm volatile("s_waitcnt vmcnt(0)" ::: "memory");
            const unsigned og = xb_add(&bar[XB_TOP], 1u);
            const unsigned tg = og / nx;
            if (og + 1u == (tg + 1u) * nx) xb_add(&bar[XB_TOPGEN], 1u);
            else XB_SPIN(xb_ld(&bar[XB_TOPGEN]) == tg, bar);
            __builtin_amdgcn_fence(__ATOMIC_ACQUIRE, "agent");
            xb_add(&bar[XB_XGEN(b.x)], 1u);
            asm volatile("s_waitcnt vmcnt(0)" ::: "memory");
        } else {
            XB_SPIN(xb_ld(&bar[XB_XGEN(b.x)]) == gen, bar);
            __builtin_amdgcn_fence(__ATOMIC_ACQUIRE, "agent");
            asm volatile("s_waitcnt vmcnt(0)" ::: "memory");
        }
    }
    __syncthreads();
}

namespace pg8 {
constexpr int BM = 256, BK = 64, HALF = 128, HTB = HALF * BK * 2, STAGE_BYTES = 8 * HTB, NXCD = 8, WGM = 8;
__host__ __device__ __forceinline__ int lds_byte(int r, int c) { const int st = (r >> 4) * 2 + (c >> 5), rr = r & 15, cc = c & 31, ob = rr * 64 + cc * 2; return st * 1024 + (ob ^ (((ob >> 9) & 1) << 5)); }
__host__ __device__ __forceinline__ void stage_rc(int b, int& R, int& C) { const int st = b / 1024, sb = b % 1024, swz = sb ^ (((sb >> 9) & 1) << 5); R = (st >> 1) * 16 + swz / 64; C = (st & 1) * 32 + (swz % 64) / 2; }
__host__ __device__ __forceinline__ int perm32(int rho) { const int n = rho >> 4, i = rho & 15; return 8 * (i >> 2) + 4 * n + (i & 3); }

struct Unit { int pm, pn, e, lt; };

__device__ __forceinline__ int xcd_remap(int wgid, int nwg) { const int q = nwg / NXCD, r = nwg % NXCD, xcd = wgid % NXCD, off = wgid / NXCD; return (xcd < r ? xcd * (q + 1) : r * (q + 1) + (xcd - r) * q) + off; }

struct DenseOrder {
    static constexpr bool GATHER = false;
    int nM, nN, nwg, G, c, K; const char* Bt;
    __device__ __forceinline__ void init(int M, int N, int K_, const bf16_t* Bt_, int G_, int c_) { nM = M / BM; nN = N / BM; nwg = nM * nN; G = G_; c = c_; K = K_; Bt = (const char*)Bt_; }
    __device__ __forceinline__ bool next(int i, Unit& u) const {
        const long L = (long)i * G + c; if (L >= nwg) return false;
        const int wgid = xcd_remap((int)L, nwg);
        const int nig = WGM * nN, gid = wgid / nig, fm = gid * WGM, gsz = (nM - fm) < WGM ? (nM - fm) : WGM;
        u.pm = fm + ((wgid % nig) % gsz); u.pn = (wgid % nig) / gsz; u.e = 0; u.lt = 0; return true;
    }
    __device__ __forceinline__ void a_offsets(const Unit&, const int (&)[2], const int (&)[2], unsigned (&)[2][2]) const {}
    __device__ __forceinline__ size_t a_tile(const Unit& u) const { return (size_t)u.pm * BM * K * 2; }
    __device__ __forceinline__ const char* b_ptr(const Unit& u) const { return Bt + (size_t)u.pn * BM * K * 2; }
};

template <bool GATHER_> struct MoeOrder {
    static constexpr bool GATHER = GATHER_;
    int tb[9]; int nN, nU, G, c, K; const char* Bt; size_t bstride; const unsigned* list;
    __device__ __forceinline__ void init(const unsigned* cnt_words, int N, int K_, const bf16_t* Bt_, size_t bstride_elems, const unsigned* list_, int G_, int c_) {
        int acc = 0;
#pragma unroll
        for (int e = 0; e < 8; ++e) { tb[e] = acc; const int ce = __builtin_amdgcn_readfirstlane((int)__hip_atomic_load(cnt_words + 64 * e, RLX_AGENT)); acc += (ce + 255) >> 8; }
        tb[8] = acc; nN = N / BM; nU = acc * nN; G = G_; c = c_; K = K_; Bt = (const char*)Bt_; bstride = bstride_elems * 2; list = list_;
    }
    __device__ __forceinline__ bool next(int i, Unit& u) const {
        const long L = (long)i * G + c; if (L >= nU) return false;
        const int wgid = xcd_remap((int)L, nU);
        int e = 0, t0 = 0, t1 = tb[1];
#pragma unroll
        for (int k = 1; k < 8; ++k) { if (wgid >= tb[k] * nN) { e = k; t0 = tb[k]; t1 = tb[k + 1]; } }
        const int local = wgid - t0 * nN, te = t1 - t0;
        u.pn = local / te; u.lt = local % te; u.pm = t0 + u.lt; u.e = e; return true;
    }
    __device__ __forceinline__ void a_offsets(const Unit& u, const int (&R)[2], const int (&C)[2], unsigned (&o)[2][2]) const {
#pragma unroll
        for (int h = 0; h < 2; ++h)
#pragma unroll
            for (int i = 0; i < 2; ++i) {
                if (GATHER) { const unsigned tok = list[(size_t)u.e * NLAT + u.lt * BM + h * HALF + R[i]]; o[h][i] = (unsigned)(((size_t)tok * K + C[i]) * 2); }
            }
    }
    __device__ __forceinline__ size_t a_tile(const Unit& u) const { return (size_t)u.pm * BM * K * 2; }
    __device__ __forceinline__ const char* b_ptr(const Unit& u) const { return Bt + (size_t)u.e * bstride + (size_t)u.pn * BM * K * 2; }
};

constexpr int KSW = 512, KSL = FE / KSW;
static_assert(KSL * KSW == FE && (KSW / BK) % 2 == 0, "K slices");
template <int MODE> struct MoeDown {
    static constexpr bool GATHER = false;
    int tb[9]; unsigned pmask; int nN, nU, G, c; const char* Bt; size_t bstride;
    __device__ __forceinline__ void init(const unsigned* cnt_words, const bf16_t* Bt_, size_t bstride_elems, int G_, int c_) {
        int acc = 0, accf = 0; unsigned pm_ = 0u;
#pragma unroll
        for (int e = 0; e < 8; ++e) { tb[e] = acc | (accf << 16); const int ce = __builtin_amdgcn_readfirstlane((int)__hip_atomic_load(cnt_words + 64 * e, RLX_AGENT)); acc += (ce + 255) >> 8; accf += ce >> 8; pm_ |= (ce & 255) ? (1u << e) : 0u; }
        tb[8] = acc | (accf << 16); pmask = pm_; nN = D / BM; G = G_; c = c_; Bt = (const char*)Bt_; bstride = bstride_elems * 2;
        nU = MODE == 0 ? accf * nN : __builtin_popcount(pm_) * nN * KSL;
    }
    __device__ __forceinline__ bool next(int i, Unit& u) const {
        const long L = (long)i * G + (MODE == 0 ? c : G - 1 - c); if (L >= nU) return false;
        if (MODE == 0) {
            const int wgid = xcd_remap((int)L, nU);
            int e = 0, f0 = 0, f1 = tb[1] >> 16, t0 = 0;
#pragma unroll
            for (int k = 1; k < 8; ++k) { if (wgid >= (tb[k] >> 16) * nN) { e = k; f0 = tb[k] >> 16; f1 = tb[k + 1] >> 16; t0 = tb[k] & 0xffff; } }
            const int local = wgid - f0 * nN, te = f1 - f0;
            u.pn = local / te; u.lt = t0 + local % te; u.pm = u.lt; u.e = e; return true;
        } else {
            const int wgid = (int)L, pidx = wgid / (nN * KSL), rem = wgid - pidx * (nN * KSL), ks = rem / nN;
            int e = 0, lt = 0, seen = 0;
#pragma unroll
            for (int k = 0; k < 8; ++k) { if ((pmask >> k) & 1u) { if (seen == pidx) { e = k; lt = (tb[k] & 0xffff) + ((tb[k + 1] >> 16) - (tb[k] >> 16)); } ++seen; } }
            u.pn = rem - ks * nN; u.lt = lt; u.pm = ks * 8 + e; u.e = e | (ks << 8); return true;
        }
    }
    __device__ __forceinline__ void a_offsets(const Unit&, const int (&)[2], const int (&)[2], unsigned (&)[2][2]) const {}
    __device__ __forceinline__ size_t a_tile(const Unit& u) const { return (size_t)u.lt * BM * FE * 2 + (MODE == 0 ? (size_t)0 : (size_t)(u.e >> 8) * KSW * 2); }
    __device__ __forceinline__ const char* b_ptr(const Unit& u) const { return Bt + (size_t)(u.e & 255) * bstride + (size_t)u.pn * BM * FE * 2 + (MODE == 0 ? (size_t)0 : (size_t)(u.e >> 8) * KSW * 2); }
};

__device__ __forceinline__ u32x4 widen16(u32x2 p0, u32x2 p1) {
    const auto a = __builtin_amdgcn_permlane16_swap(p0.x, p1.x, false, false); const auto b = __builtin_amdgcn_permlane16_swap(p0.y, p1.y, false, false);
    return (u32x4){a[0], b[0], a[1], b[1]}; }
struct EpiBf16 {
    static constexpr bool PERM = true;
    bf16_t* O; int ldc;
    __device__ __forceinline__ void operator()(const f32x4 (&acc)[2][2][4][2], const Unit& u, int wr, int wc, int fr, int fq) const {
        const int row0 = u.pm * BM + wr * 64 + fr; const int col0 = u.pn * BM + wc * 32 + 8 * fq;
#pragma unroll
        for (int ai = 0; ai < 2; ++ai)
#pragma unroll
            for (int m = 0; m < 4; ++m) { bf16_t* rowp = O + (size_t)(row0 + ai * HALF + m * 16) * ldc + col0;
#pragma unroll
                for (int bj = 0; bj < 2; ++bj) { const f32x4 v0 = acc[ai][bj][m][0], v1 = acc[ai][bj][m][1];
                    u32x4 w; w.x = cvt_pk_bf16(v0[0], v0[1]); w.y = cvt_pk_bf16(v0[2], v0[3]); w.z = cvt_pk_bf16(v1[0], v1[1]); w.w = cvt_pk_bf16(v1[2], v1[3]);
                    *(u32x4*)(rowp + bj * HALF) = w; } }
    }
};
struct EpiProj {
    static constexpr bool PERM = false;
    bf16_t* O; const float* cosT; const float* sinT;
    __device__ __forceinline__ void operator()(const f32x4 (&acc)[2][2][4][2], const Unit& u, int wr, int wc, int fr, int fq) const {
        const int row0 = u.pm * BM + wr * 64 + fr; const int col0 = u.pn * BM + wc * 32 + 4 * fq;
        const int wofs = (fq & 1) ? 12 : 0;
        const bool rope = (u.pn >= 9) && (u.pn <= 12) && (u.pm < NLAT / BM);
#pragma unroll
        for (int ai = 0; ai < 2; ++ai)
#pragma unroll
            for (int m = 0; m < 4; ++m) { const int row = row0 + ai * HALF + m * 16; bf16_t* rowp = O + (size_t)row * PW + col0;
                const int l = row & (SEQ - 1);
#pragma unroll
                for (int bj = 0; bj < 2; ++bj) { f32x4 t1 = acc[ai][bj][m][0], t2 = acc[ai][bj][m][1];
                    if (rope) { const int axis = ((col0 + bj * HALF) >> 5) & 1; const int pos = axis ? (l & 63) : (l >> 6);
                        const f32x4 cs = *(const f32x4*)(cosT + pos * 16 + 4 * fq), sn = *(const f32x4*)(sinT + pos * 16 + 4 * fq);
                        const f32x4 o1 = t1 * cs - t2 * sn, o2 = t1 * sn + t2 * cs; t1 = o1; t2 = o2; }
                    u32x2 w1, w2; w1.x = cvt_pk_bf16(t1[0], t1[1]); w1.y = cvt_pk_bf16(t1[2], t1[3]); w2.x = cvt_pk_bf16(t2[0], t2[1]); w2.y = cvt_pk_bf16(t2[2], t2[3]);
                    *(u32x4*)(rowp + bj * HALF + wofs) = widen16(w1, w2); } }
    }
};
struct EpiSwiGLU {
    static constexpr bool PERM = false;
    bf16_t* O; int ldc;
    __device__ __forceinline__ void operator()(const f32x4 (&acc)[2][2][4][2], const Unit& u, int wr, int wc, int fr, int fq) const {
        const int row0 = u.pm * BM + wr * 64 + fr;
#pragma unroll
        for (int ai = 0; ai < 2; ++ai)
#pragma unroll
            for (int m = 0; m < 4; ++m) { bf16_t* rowp = O + (size_t)(row0 + ai * HALF + m * 16) * ldc + u.pn * 128 + 4 * fq;
                u32x2 w[2];
#pragma unroll
                for (int bj = 0; bj < 2; ++bj) { const f32x4 g = acc[ai][bj][m][0], up = acc[ai][bj][m][1]; f32x4 h;
#pragma unroll
                    for (int j = 0; j < 4; ++j) h[j] = g[j] * fast_rcp(1.0f + fast_exp2(-LOG2E * g[j])) * up[j];
                    w[bj].x = cvt_pk_bf16(h[0], h[1]); w[bj].y = cvt_pk_bf16(h[2], h[3]); }
                *(u32x4*)(rowp + ((fq & 1) ? (4 + wc) * 16 - 4 : wc * 16)) = widen16(w[0], w[1]); }
    }
};

template <class Epi, class Sched, bool ALIGN_EPI>
__device__ __forceinline__ void gemm_phase(LAS unsigned char* lds, const char* Abase, const int K, const Sched& S, const Epi& E, const int LD_ = 0) {
    int tid = threadIdx.x; asm volatile("" : "+v"(tid));
    const int wid = __builtin_amdgcn_readfirstlane(tid >> 6), lane = tid & 63, wr = wid >> 2, wc = wid & 3, fr = lane & 15, fq = lane >> 4;
    const int nt = K / BK, LD = LD_ ? LD_ : K;
    constexpr bool GA = Sched::GATHER;
    int Rr[2], Cc[2]; unsigned voffA[2], voffB[2];
#pragma unroll
    for (int i = 0; i < 2; ++i) { int R, C; stage_rc(tid * 16 + i * 8192, R, C); const int Rb = Epi::PERM ? ((R & ~31) + perm32(R & 31)) : R; Rr[i] = R; Cc[i] = C; voffA[i] = (unsigned)(R * LD + C) * 2u; voffB[i] = (unsigned)(Rb * LD + C) * 2u; }
    const size_t kstep = (size_t)(BK * 2);
    const size_t hstep = (size_t)HALF * LD * 2;
    const unsigned ldsw = (unsigned)wid * 1024u;
    const int aoff = lds_byte(wr * 64 + fr, fq * 8), boff = lds_byte(wc * 32 + fr, fq * 8);
#define PG8_SA(b, h) (((b) * 2 + (h)) * HTB)
#define PG8_SB(b, h) ((4 + (b) * 2 + (h)) * HTB)
#define PG8_STAGE(bufoff, gbase, voff) do { _Pragma("unroll") for (int _i = 0; _i < 2; ++_i) \
        __builtin_amdgcn_global_load_lds((const unsigned*)((const char*)(gbase) + (voff)[_i]), (LAS unsigned*)(lds + (bufoff) + ldsw + _i * 8192), 16, 0, 0); } while (0)
#define PG8_STAGE_A(bufoff, uptr, oarr, h, kofs) do { if constexpr (GA) { PG8_STAGE(bufoff, Abase + (kofs), (oarr)[h]); } else { PG8_STAGE(bufoff, (uptr) + (h) * hstep + (kofs), voffA); } } while (0)
#define PG8_LDA(dst, b, h) do { _Pragma("unroll") for (int m = 0; m < 4; ++m) _Pragma("unroll") for (int k = 0; k < 2; ++k) dst[m][k] = *(const LAS bf16x8*)(lds + PG8_SA(b, h) + aoff + m * 2048 + k * 1024); } while (0)
#define PG8_LDB(dst, b, h) do { _Pragma("unroll") for (int n = 0; n < 2; ++n) _Pragma("unroll") for (int k = 0; k < 2; ++k) dst[n][k] = *(const LAS bf16x8*)(lds + PG8_SB(b, h) + boff + n * 2048 + k * 1024); } while (0)
#define PG8_MMA(ai, bj, At, Bt) do { __builtin_amdgcn_s_setprio(1); _Pragma("unroll") for (int m = 0; m < 4; ++m) _Pragma("unroll") for (int n = 0; n < 2; ++n) _Pragma("unroll") for (int k = 0; k < 2; ++k) \
        acc[ai][bj][m][n] = __builtin_amdgcn_mfma_f32_16x16x32_bf16(Bt[n][k], At[m][k], acc[ai][bj][m][n], 0, 0, 0); __builtin_amdgcn_s_setprio(0); } while (0)
#define PG8_WAIT_V(n) asm volatile("s_waitcnt vmcnt(" #n ")" ::: "memory")
#define PG8_WAIT_L(n) asm volatile("s_waitcnt lgkmcnt(" #n ")" ::: "memory")
#define PG8_BAR __builtin_amdgcn_s_barrier()
#define PG8_SCHED __builtin_amdgcn_sched_barrier(0)
    Unit cur, nxt; int ui = 0;
    if (!S.next(0, cur)) return;
    f32x4 acc[2][2][4][2];
#pragma unroll
    for (int a = 0; a < 2; ++a)
#pragma unroll
        for (int b = 0; b < 2; ++b)
#pragma unroll
            for (int m = 0; m < 4; ++m)
#pragma unroll
                for (int n = 0; n < 2; ++n) acc[a][b][m][n] = (f32x4){0.f, 0.f, 0.f, 0.f};
    bf16x8 At[4][2], B0[2][2], B1[2][2];
    unsigned oA[2][2], oN[2][2];
    if constexpr (GA) S.a_offsets(cur, Rr, Cc, oA);
    const char* cA = Abase + S.a_tile(cur);
    const char* cB = S.b_ptr(cur);
    PG8_STAGE(PG8_SB(0, 0), cB, voffB); PG8_STAGE(PG8_SB(0, 1), cB + hstep, voffB); PG8_STAGE_A(PG8_SA(0, 0), cA, oA, 0, 0); PG8_STAGE_A(PG8_SA(0, 1), cA, oA, 1, 0);
    if (wr == 1) PG8_BAR;
    PG8_WAIT_V(2); PG8_BAR;
    PG8_STAGE(PG8_SB(1, 0), cB + kstep, voffB); PG8_STAGE_A(PG8_SA(1, 0), cA, oA, 0, kstep); PG8_STAGE(PG8_SB(1, 1), cB + hstep + kstep, voffB);
    PG8_WAIT_V(6); PG8_BAR;
    for (;;) {
        const bool has_next = S.next(ui + 1, nxt);
        const char* nB = cB; const char* nA = cA;
        if (has_next) { if constexpr (GA) S.a_offsets(nxt, Rr, Cc, oN); nB = S.b_ptr(nxt); nA = Abase + S.a_tile(nxt); }
        else if constexpr (GA) {
#pragma unroll
            for (int h = 0; h < 2; ++h)
#pragma unroll
                for (int i = 0; i < 2; ++i) oN[h][i] = oA[h][i];
        }
        for (int t = 0; t < nt; t += 2) {
            const bool last = (t == nt - 2);
            const size_t k1 = (size_t)(t + 1) * kstep, k2 = last ? (size_t)0 : (size_t)(t + 2) * kstep, k3 = k2 + kstep;
            const char* ua = last ? nA : cA; const char* b2 = last ? nB : cB + (size_t)(t + 2) * kstep; const char* b3 = b2 + kstep;
            unsigned o2[2][2];
            if constexpr (GA) {
#pragma unroll
                for (int h = 0; h < 2; ++h)
#pragma unroll
                    for (int i = 0; i < 2; ++i) o2[h][i] = last ? oN[h][i] : oA[h][i];
            }
            PG8_LDB(B0, 0, 0); PG8_LDB(B1, 0, 1); PG8_SCHED; PG8_LDA(At, 0, 0); PG8_STAGE_A(PG8_SA(1, 1), cA, oA, 1, k1);
            PG8_WAIT_V(8); PG8_WAIT_L(0); PG8_BAR; PG8_MMA(0, 0, At, B0); PG8_MMA(0, 1, At, B1); PG8_BAR; PG8_SCHED;
            PG8_LDA(At, 0, 1); PG8_STAGE(PG8_SB(0, 0), b2, voffB); PG8_STAGE(PG8_SB(0, 1), b2 + hstep, voffB); PG8_STAGE_A(PG8_SA(0, 0), ua, o2, 0, k2);
            PG8_WAIT_V(8); PG8_WAIT_L(0); PG8_BAR; PG8_MMA(1, 0, At, B0); PG8_MMA(1, 1, At, B1); PG8_BAR; PG8_SCHED;
            PG8_LDB(B0, 1, 0); PG8_LDB(B1, 1, 1); PG8_SCHED; PG8_LDA(At, 1, 0); PG8_STAGE_A(PG8_SA(0, 1), ua, o2, 1, k2);
            PG8_WAIT_V(8); PG8_WAIT_L(0); PG8_BAR; PG8_MMA(0, 0, At, B0); PG8_MMA(0, 1, At, B1); PG8_BAR; PG8_SCHED;
            PG8_LDA(At, 1, 1); PG8_STAGE(PG8_SB(1, 0), b3, voffB); PG8_STAGE(PG8_SB(1, 1), b3 + hstep, voffB); PG8_STAGE_A(PG8_SA(1, 0), ua, o2, 0, k3);
            PG8_WAIT_V(8); PG8_WAIT_L(0); PG8_BAR; PG8_MMA(1, 0, At, B0); PG8_MMA(1, 1, At, B1); PG8_BAR; PG8_SCHED;
        }
        if constexpr (ALIGN_EPI) { if (wr == 0) PG8_BAR; }
        E(acc, cur, wr, wc, fr, fq);
        if (!has_next) break;
#pragma unroll
        for (int a = 0; a < 2; ++a)
#pragma unroll
            for (int b = 0; b < 2; ++b)
#pragma unroll
                for (int m = 0; m < 4; ++m)
#pragma unroll
                    for (int n = 0; n < 2; ++n) acc[a][b][m][n] = (f32x4){0.f, 0.f, 0.f, 0.f};
        cur = nxt; cB = nB; cA = nA; ++ui;
        if constexpr (GA) {
#pragma unroll
            for (int h = 0; h < 2; ++h)
#pragma unroll
                for (int i = 0; i < 2; ++i) oA[h][i] = oN[h][i];
        }
        if constexpr (ALIGN_EPI) { if (wr == 1) PG8_BAR; }
    }
    PG8_WAIT_V(0);
    if constexpr (!ALIGN_EPI) { if (wr == 0) PG8_BAR; }
    PG8_BAR;
#undef PG8_SA
#undef PG8_SB
#undef PG8_STAGE
#undef PG8_STAGE_A
#undef PG8_LDA
#undef PG8_LDB
#undef PG8_MMA
#undef PG8_WAIT_V
#undef PG8_WAIT_L
#undef PG8_BAR
#undef PG8_SCHED
}
}

struct Args { const float* in[26]; float* out; unsigned char* ws; int ph_lo, ph_hi; };
struct Frame {
    LAS unsigned char* lds;
    volatile LAS unsigned* MISC;
    unsigned* ctl;
    int G, bid;
    const struct Args* a;
    float* out; unsigned char* ws;
};
enum { I_X = 0, I_C, I_CTX, I_CCTX, I_WMOD, I_BMOD, I_NPREMIX, I_NPOSTMIX, I_NPREFFN, I_NPOSTFFN, I_WIN, I_WOUT, I_MLGB, I_MLNORM, I_HGLB, I_HGNORM, I_DALAM, I_DANORM,
       I_FWG, I_FWU, I_FWD, I_RW, I_RB, I_MWG, I_MWU, I_MWD };

__device__ __forceinline__ void transpose_item(const float* colptr, float scale, int ld, int K, bf16_t* WT, int n0, int k0, LAS float* scr, int lane) {
#pragma unroll 8
    for (int i = 0; i < 32; ++i) { const int kk = 2 * i + (lane >> 5); scr[kk * 33 + (lane & 31)] = colptr[(size_t)(k0 + kk) * ld] * scale; }
    LDS_WAIT(); asm volatile("" ::: "memory");
    const int c = lane & 7;
#pragma unroll
    for (int j = 0; j < 4; ++j) { const int n = (lane >> 3) + 8 * j; const LAS float* s = scr + (8 * c) * 33 + n;
        u32x4 o; o.x = cvt_pk_bf16(s[0 * 33], s[1 * 33]); o.y = cvt_pk_bf16(s[2 * 33], s[3 * 33]); o.z = cvt_pk_bf16(s[4 * 33], s[5 * 33]); o.w = cvt_pk_bf16(s[6 * 33], s[7 * 33]);
        *(GAS u32x4*)(WT + (size_t)(n0 + n) * K + k0 + 8 * c) = o; }
    LDS_WAIT(); asm volatile("" ::: "memory");
}
__device__ __forceinline__ void p_mod_vectors(Frame& F) {
    PHASE_TID();
    if (F.bid >= 192) return;
    LAS float* sv = (LAS float*)(F.lds);
    LAS float* red = (LAS float*)(F.lds + 20480);
    for (int idx = tid; idx < 5 * D; idx += NTHR) { const int r = idx >> 10, k = idx & 1023; const float v = r < 4 ? F.a->in[I_C][r * D + k] : F.a->in[I_CCTX][k]; sv[idx] = siluf_(v); }
    __syncthreads();
    const int l = F.bid / 96, cb = (F.bid % 96) * 64;
    const float* W = F.a->in[I_WMOD] + (size_t)l * D * 6144 + cb + lane;
    float a[5] = {0.f, 0.f, 0.f, 0.f, 0.f};
    const int kb = wave * 128;
#pragma unroll 4
    for (int k = 0; k < 128; ++k) { const float wv = W[(size_t)(kb + k) * 6144];
#pragma unroll
        for (int r = 0; r < 5; ++r) a[r] += sv[r * 1024 + kb + k] * wv; }
#pragma unroll
    for (int r = 0; r < 5; ++r) red[(wave * 5 + r) * 64 + lane] = a[r];
    __syncthreads();
    if (tid < 320) { const int r = tid >> 6, ln = tid & 63; float s = 0.f;
#pragma unroll
        for (int w = 0; w < 8; ++w) s += red[(w * 5 + r) * 64 + ln];
        float* MODV = (float*)(F.ws + WS_SMALL + SM_MODV);
        MODV[(size_t)(l * 5 + r) * 6144 + cb + ln] = s + F.a->in[I_BMOD][l * 6144 + cb + ln]; }
    __syncthreads();
}
__device__ __forceinline__ void p_consts(Frame& F) {
    PHASE_TID();
    if (F.bid != 255 % F.G) return;
    float* COS = (float*)(F.ws + WS_SMALL + SM_COS); float* SIN = (float*)(F.ws + WS_SMALL + SM_SIN);
    float* CST = (float*)(F.ws + WS_SMALL + SM_CONST); float* LB = (float*)(F.ws + WS_SMALL + SM_LB);
    for (int idx = tid; idx < 1024; idx += NTHR) { const int pos = idx >> 4, f = idx & 15;
        const double frac[4] = {1.0, 0.5623413251903491, 0.31622776601683794, 0.1778279410038923};
        double inv = (f & 3) == 0 ? frac[0] : ((f & 3) == 1 ? frac[1] : ((f & 3) == 2 ? frac[2] : frac[3]));
        const int dec = f >> 2; inv *= (dec == 0 ? 1.0 : (dec == 1 ? 0.1 : (dec == 2 ? 0.01 : 0.001)));
        const double ang = (double)pos * inv; const double kq = __builtin_rint(ang * 0.15915494309189535); const float r = (float)(ang - kq * 6.283185307179586);
        COS[idx] = __cosf(r); SIN[idx] = __sinf(r); }
    if (tid < 2) { const int l = tid; const float* lp = F.a->in[I_DALAM] + l * 256; float s1 = 0.f, s2 = 0.f;
        for (int i = 0; i < 64; ++i) { s1 += lp[i] * lp[64 + i]; s2 += lp[128 + i] * lp[192 + i]; }
        const float lam_init = 0.8f - 0.6f * expf(-0.3f * (float)l);
        CST[l * 4 + 0] = expf(s1) - expf(s2) + lam_init; CST[l * 4 + 1] = lam_init; }
    { bf16_t* WG = (bf16_t*)(F.ws + WS_SMALL + SM_WGATE);
        for (int idx = tid; idx < 2 * 16 * D; idx += NTHR) { const int l = idx >> 14, g = (idx >> 10) & 15, k = idx & 1023;
            WG[idx] = (bf16_t)(cvt_pk_bf16(F.a->in[I_WIN][(size_t)l * D * WIN_LD + (size_t)k * WIN_LD + 1024 + g], 0.f) & 0xffffu); } }
    if (tid < 256) { const float z0 = F.a->in[I_HGLB][tid], z1 = F.a->in[I_HGLB][256 + tid]; const float mx = fmaxf(z0, z1); const float e0 = expf(z0 - mx), e1 = expf(z1 - mx);
        LB[tid] = 0.f; LB[256 + tid] = e1 / (e0 + e1); }
}
__device__ __forceinline__ void p_weights(Frame& F) {
    PHASE_TID();
    LAS float* scr = (LAS float*)(F.lds + 32768 + wave * 12288);
    const int gw = F.bid * NWAVES + wave, NGW = F.G * NWAVES, nl = lane & 31;
    constexpr int I_IN = 16 * (PW / 32), I_OUT = 16 * 32, I_GU = 16 * (2 * FF / 32), I_DN = (FF / 64) * 32, I_MGU = 16 * (2 * FE / 32), I_MDN = (FE / 64) * 32;
    constexpr int NITEMS = 2 * I_IN + 2 * I_OUT + I_GU + I_DN + NE * I_MGU + NE * I_MDN;
    for (int it = gw; it < NITEMS; it += NGW) {
        int r = it;
        if (r < 2 * I_IN) { const int l = r / I_IN; r %= I_IN; const int nblk = PW / 32, kb = r / nblk, nb = r % nblk, np = nb * 32 + nl; const int col = np < 1024 ? np : np + 16;
            const float sc = (np >= ML_K && np < ML_V) ? 0.125f : ((np >= DA_Q && np < DA_K) ? C2 : 1.0f);
            transpose_item(F.a->in[I_WIN] + (size_t)l * D * WIN_LD + col, sc, WIN_LD, D, (bf16_t*)(F.ws + WS_WIN) + (size_t)l * PW * D, nb * 32, kb * 64, scr, lane); continue; }
        r -= 2 * I_IN;
        if (r < 2 * I_OUT) { const int l = r / I_OUT; r %= I_OUT; const int kb = r / 32, nb = r % 32;
            transpose_item(F.a->in[I_WOUT] + (size_t)l * D * D + nb * 32 + nl, 1.0f, D, D, (bf16_t*)(F.ws + WS_WOUT) + (size_t)l * D * D, nb * 32, kb * 64, scr, lane); continue; }
        r -= 2 * I_OUT;
        if (r < I_GU) { const int nblk = 2 * FF / 32, kb = r / nblk, nb = r % nblk; const float* src = (nl < 16 ? F.a->in[I_FWG] : F.a->in[I_FWU]) + nb * 16 + (nl & 15);
            transpose_item(src, 1.0f, FF, D, (bf16_t*)(F.ws + WS_WGU), nb * 32, kb * 64, scr, lane); continue; }
        r -= I_GU;
        if (r < I_DN) { const int kb = r / 32, nb = r % 32;
            transpose_item(F.a->in[I_FWD] + nb * 32 + nl, 1.0f, D, FF, (bf16_t*)(F.ws + WS_WD), nb * 32, kb * 64, scr, lane); continue; }
        r -= I_DN;
        if (r < NE * I_MGU) { const int e = r / I_MGU; r %= I_MGU; const int nblk = 2 * FE / 32, kb = r / nblk, nb = r % nblk;
            const float* src = (nl < 16 ? F.a->in[I_MWG] : F.a->in[I_MWU]) + (size_t)e * D * FE + nb * 16 + (nl & 15);
            transpose_item(src, 1.0f, FE, D, (bf16_t*)(F.ws + WS_MOE_GU) + (size_t)e * 2 * FE * D, nb * 32, kb * 64, scr, lane); continue; }
        r -= NE * I_MGU;
        { const int e = r / I_MDN; r %= I_MDN; const int kb = r / 32, nb = r % 32;
            transpose_item(F.a->in[I_MWD] + (size_t)e * FE * D + nb * 32 + nl, 1.0f, D, FE, (bf16_t*)(F.ws + WS_MOE_D) + (size_t)e * D * FE, nb * 32, kb * 64, scr, lane); }
    }
}

struct RowCfg {
    const float* xlat; const float* xctx;
    float* olat; float* octx;
    const bf16_t* Y;
    const float* wpost; int lg, gi;
    const float* wpre; int lm, si;
    int xib, xob;
};
__device__ __forceinline__ const float* modv_row(Frame& F, int layer, int row) { const int r = row < NLAT ? (row >> 12) : 4; return (const float*)(F.ws + WS_SMALL + SM_MODV) + (size_t)(layer * 5 + r) * 6144; }
__device__ __forceinline__ void load_bf16_row(const bf16_t* p, int lane, f32x4 (&v)[4]) {
#pragma unroll
    for (int j = 0; j < 4; ++j) { const u32x2 w = *(const GAS u32x2*)(p + 4 * lane + 256 * j); v[j] = (f32x4){bf_lo(w.x), bf_hi(w.x), bf_lo(w.y), bf_hi(w.y)}; }
}
__device__ __forceinline__ float sumsq4(const f32x4 (&v)[4]) { float s = 0.f;
#pragma unroll
    for (int j = 0; j < 4; ++j) s += (v[j].x * v[j].x + v[j].y * v[j].y) + (v[j].z * v[j].z + v[j].w * v[j].w);
    return s; }
struct RowRegs { f32x4 wpost[4], wpre[4], g[4], sh[4], sc[4]; int rb; };
template <bool HAS_Y, bool WRITE_HN>
__device__ __forceinline__ void row_regs_init(const RowCfg& c, int lane, RowRegs& R) { R.rb = -1;
#pragma unroll
    for (int j = 0; j < 4; ++j) { if (HAS_Y) R.wpost[j] = *(const GAS f32x4*)(c.wpost + 4 * lane + 256 * j); if (WRITE_HN) R.wpre[j] = *(const GAS f32x4*)(c.wpre + 4 * lane + 256 * j); } }
template <bool HAS_Y, bool WRITE_X, bool WRITE_HN>
__device__ __forceinline__ void row_core(Frame& F, const RowCfg& c, int row, int lane, f32x4 (&yv)[4], f32x4 (&hv)[4], RowRegs& R) {
    { const int r = row < NLAT ? (row >> 12) : 4;
        if (r != R.rb) { R.rb = r;
            if (HAS_Y) { const float* gate = modv_row(F, c.lg, row) + c.gi * 1024;
#pragma unroll
                for (int j = 0; j < 4; ++j) R.g[j] = *(const GAS f32x4*)(gate + 4 * lane + 256 * j); }
            if (WRITE_HN) { const float* mv = modv_row(F, c.lm, row); const float* shift = mv + c.si * 1024; const float* scale = mv + (c.si + 1) * 1024;
#pragma unroll
                for (int j = 0; j < 4; ++j) { R.sh[j] = *(const GAS f32x4*)(shift + 4 * lane + 256 * j); R.sc[j] = *(const GAS f32x4*)(scale + 4 * lane + 256 * j); } } } }
    f32x4 xv[4];
    if (row < NLAT && c.xib) load_bf16_row((const bf16_t*)(c.xlat + (size_t)row * D) + D, lane, xv);
    else { const float* xs = row < NLAT ? c.xlat + (size_t)row * D : c.xctx + (size_t)(row - NLAT) * D;
#pragma unroll
        for (int j = 0; j < 4; ++j) xv[j] = *(const GAS f32x4*)(xs + 4 * lane + 256 * j); }
    if (HAS_Y) {
        const float ry = 1.0f / sqrtf(wave_sum(sumsq4(yv)) * (1.0f / D) + EPS);
#pragma unroll
        for (int j = 0; j < 4; ++j) xv[j] = xv[j] + R.g[j] * (yv[j] * ry * R.wpost[j]);
    }
    if (WRITE_X) {
        if (row < NLAT && c.xob) { bf16_t* xb = (bf16_t*)(c.olat + (size_t)row * D) + D;
#pragma unroll
            for (int j = 0; j < 4; ++j) { u32x2 o; o.x = cvt_pk_bf16(xv[j].x, xv[j].y); o.y = cvt_pk_bf16(xv[j].z, xv[j].w); *(GAS u32x2*)(xb + 4 * lane + 256 * j) = o; } }
        else { float* xd = row < NLAT ? c.olat + (size_t)row * D : c.octx + (size_t)(row - NLAT) * D;
#pragma unroll
            for (int j = 0; j < 4; ++j) *(GAS f32x4*)(xd + 4 * lane + 256 * j) = xv[j]; } }
    if (WRITE_HN) {
        const float rx = 1.0f / sqrtf(wave_sum(sumsq4(xv)) * (1.0f / D) + EPS);
        bf16_t* hn = (bf16_t*)(F.ws + WS_HN) + (size_t)row * D;
#pragma unroll
        for (int j = 0; j < 4; ++j) { hv[j] = (xv[j] * rx * R.wpre[j]) * (1.0f + R.sc[j]) + R.sh[j];
            u32x2 o; o.x = cvt_pk_bf16(hv[j].x, hv[j].y); o.y = cvt_pk_bf16(hv[j].z, hv[j].w); *(GAS u32x2*)(hn + 4 * lane + 256 * j) = o; }
    }
}
template <bool HAS_Y, bool WRITE_X, bool WRITE_HN, bool GATES>
__device__ __forceinline__ void row_phase(Frame& F, const RowCfg& c, int nrows) {
    PHASE_TID();
    LAS float* wgT = (LAS float*)F.lds;
    if (GATES) { const float* wg = F.a->in[I_WIN] + (size_t)c.lm * D * WIN_LD + 1024;
        for (int idx = tid; idx < 16 * D; idx += NTHR) { const int k = idx >> 4, i = idx & 15; wgT[i * D + k] = wg[(size_t)k * WIN_LD + i]; }
        __syncthreads(); }
    const int gw = F.bid * NWAVES + wave, NGW = F.G * NWAVES;
    RowRegs R; row_regs_init<HAS_Y, WRITE_HN>(c, lane, R);
    for (int row = gw; row < nrows; row += NGW) {
        f32x4 yv[4], hv[4];
        if (HAS_Y) load_bf16_row(c.Y + (size_t)row * D, lane, yv);
        row_core<HAS_Y, WRITE_X, WRITE_HN>(F, c, row, lane, yv, hv, R);
        if (GATES) { float* G = (float*)(F.ws + WS_GATES) + (size_t)row * 16; float mine = 0.f;
#pragma unroll
            for (int i = 0; i < 16; ++i) { float s = 0.f;
#pragma unroll
                for (int j = 0; j < 4; ++j) { const f32x4 w = *(const LAS f32x4*)(wgT + i * D + 4 * lane + 256 * j); s += (hv[j].x * w.x + hv[j].y * w.y) + (hv[j].z * w.z + hv[j].w * w.w); }
                s = wave_sum(s); if (lane == i) mine = s; }
            if (lane < 16) G[lane] = mine; }
    }
    if (GATES) __syncthreads();
}
__device__ __forceinline__ void route_phase(Frame& F, const RowCfg& c) {
    PHASE_TID();
    LAS float* wrT = (LAS float*)F.lds;
    LAS unsigned* lcnt = (LAS unsigned*)(F.lds + 32768);
    LAS unsigned* rec = (LAS unsigned*)(F.lds + 32768 + 256);
    for (int idx = tid; idx < 8 * D; idx += NTHR) { const int k = idx >> 3, e = idx & 7; wrT[e * D + k] = F.a->in[I_RW][(size_t)k * 8 + e]; }
    unsigned* cntw = F.ctl + CW_CNT; unsigned* lists = F.ctl + CW_LIST; unsigned* route = (unsigned*)(F.ws + WS_ROUTE);
    RowRegs R; row_regs_init<true, true>(c, lane, R);
    for (int blk = F.bid; blk < NLAT / 64; blk += F.G) {
        if (tid < 16) lcnt[tid] = 0u;
        __syncthreads();
        for (int q = 0; q < 8; ++q) { const int tl = wave * 8 + q, row = blk * 64 + tl;
            f32x4 yv[4], hv[4]; load_bf16_row(c.Y + (size_t)row * D, lane, yv);
            row_core<true, true, true>(F, c, row, lane, yv, hv, R);
            float lg[8];
#pragma unroll
            for (int e = 0; e < 8; ++e) { float s = 0.f;
#pragma unroll
                for (int j = 0; j < 4; ++j) { const f32x4 w = *(const LAS f32x4*)(wrT + e * D + 4 * lane + 256 * j); s += (hv[j].x * w.x + hv[j].y * w.y) + (hv[j].z * w.z + hv[j].w * w.w); }
                lg[e] = wave_sum(s) + F.a->in[I_RB][e]; }
            int e1 = 0; float v1 = lg[0];
#pragma unroll
            for (int e = 1; e < 8; ++e) if (lg[e] > v1) { v1 = lg[e]; e1 = e; }
            int e2 = (e1 + 1) & 7; float v2 = -3.0e38f;
#pragma unroll
            for (int e = 0; e < 8; ++e) if (e != e1 && lg[e] > v2) { v2 = lg[e]; e2 = e; }
            const float ex = __expf(v2 - v1), g1 = 1.0f / (1.0f + ex), g2 = ex * g1;
            if (lane == 0) { const unsigned p1 = __hip_atomic_fetch_add(&lcnt[e1], 1u, __ATOMIC_RELAXED, __HIP_MEMORY_SCOPE_WORKGROUP), p2 = __hip_atomic_fetch_add(&lcnt[e2], 1u, __ATOMIC_RELAXED, __HIP_MEMORY_SCOPE_WORKGROUP);
                rec[tl * 6 + 0] = (unsigned)e1; rec[tl * 6 + 1] = (unsigned)e2; rec[tl * 6 + 2] = p1; rec[tl * 6 + 3] = p2; rec[tl * 6 + 4] = __float_as_uint(g1); rec[tl * 6 + 5] = __float_as_uint(g2); }
        }
        __syncthreads();
        if (tid < 8) lcnt[8 + tid] = __hip_atomic_fetch_add(cntw + 64 * tid, lcnt[tid], RLX_AGENT);
        __syncthreads();
        if (tid < 64) { const int tok = blk * 64 + tid; const unsigned e1 = rec[tid * 6 + 0], e2 = rec[tid * 6 + 1];
            const unsigned p1 = lcnt[8 + e1] + rec[tid * 6 + 2], p2 = lcnt[8 + e2] + rec[tid * 6 + 3];
            lists[(size_t)e1 * NLAT + p1] = (unsigned)tok; lists[(size_t)e2 * NLAT + p2] = (unsigned)tok;
            u32x4 r0 = {e1, p1, rec[tid * 6 + 4], 0u}, r1 = {e2, p2, rec[tid * 6 + 5], 0u};
            *(u32x4*)(route + (size_t)tok * 8) = r0; *(u32x4*)(route + (size_t)tok * 8 + 4) = r1; }
        __syncthreads();
    }
}
__device__ __forceinline__ void final_phase(Frame& F, const RowCfg& c) {
    PHASE_TID();
    const unsigned* cntw = F.ctl + CW_CNT; int tb[8]; { int acc = 0;
#pragma unroll
        for (int e = 0; e < 8; ++e) { const int ce = (int)__hip_atomic_load(cntw + 64 * e, RLX_AGENT); tb[e] = acc | ((ce >> 8) << 16); acc += (ce + 255) >> 8; } }
    const bf16_t* SIDE = (const bf16_t*)(F.ws + WS_MOE_SIDE);
    const unsigned* route = (const unsigned*)(F.ws + WS_ROUTE); const bf16_t* YM = (const bf16_t*)(F.ws + WS_MOE_GU);
    const int gw = F.bid * NWAVES + wave, NGW = F.G * NWAVES;
    RowRegs R; row_regs_init<true, false>(c, lane, R);
    u32x4 r0n = {}, r1n = {};
    if (gw < NLAT) { r0n = *(const GAS u32x4*)(route + (size_t)gw * 8); r1n = *(const GAS u32x4*)(route + (size_t)gw * 8 + 4); }
    for (int row = gw; row < NLAT; row += NGW) {
        const u32x4 r0 = r0n, r1 = r1n;
        if (row + NGW < NLAT) { r0n = *(const GAS u32x4*)(route + (size_t)(row + NGW) * 8); r1n = *(const GAS u32x4*)(route + (size_t)(row + NGW) * 8 + 4); }
        int t1 = 0, t2 = 0;
#pragma unroll
        for (int e = 0; e < 8; ++e) { if ((int)r0.x == e) t1 = tb[e]; if ((int)r1.x == e) t2 = tb[e]; }
        const size_t s1 = (size_t)(t1 & 0xffff) * 256 + r0.y, s2 = (size_t)(t2 & 0xffff) * 256 + r1.y; const float g1 = __uint_as_float(r0.z), g2 = __uint_as_float(r1.z);
        const int p1 = (int)r0.y - (t1 >> 16) * 256, p2 = (int)r1.y - (t2 >> 16) * 256;
        f32x4 ya[4], yb[4], yv[4], hv[4];
        if (p1 < 0) load_bf16_row(YM + s1 * D, lane, ya);
        else { load_bf16_row(SIDE + ((size_t)r0.x * 256 + p1) * D, lane, ya);
            for (int ks = 1; ks < pg8::KSL; ++ks) { f32x4 t[4]; load_bf16_row(SIDE + ((size_t)(ks * 8 + (int)r0.x) * 256 + p1) * D, lane, t);
#pragma unroll
                for (int j = 0; j < 4; ++j) ya[j] += t[j]; } }
        if (p2 < 0) load_bf16_row(YM + s2 * D, lane, yb);
        else { load_bf16_row(SIDE + ((size_t)r1.x * 256 + p2) * D, lane, yb);
            for (int ks = 1; ks < pg8::KSL; ++ks) { f32x4 t[4]; load_bf16_row(SIDE + ((size_t)(ks * 8 + (int)r1.x) * 256 + p2) * D, lane, t);
#pragma unroll
                for (int j = 0; j < 4; ++j) yb[j] += t[j]; } }
#pragma unroll
        for (int j = 0; j < 4; ++j) yv[j] = ya[j] * g1 + yb[j] * g2;
        row_core<true, true, false>(F, c, row, lane, yv, hv, R);
    }
}

__device__ __forceinline__ int seq_row(int b, int dir, int n) {
    if (n < CTXL) { const int j = dir ? (CTXL - 1 - n) : n; return NLAT + b * CTXL + j; }
    const int l = dir ? (SEQ - 1 - (n - CTXL)) : (n - CTXL); return b * SEQ + l;
}
constexpr int LCH = 68, NCH = 64, NSEQ = 64, NUNIT = NSEQ * NCH;
constexpr size_t WS_DC = WS_Y;
constexpr size_t WS_C0 = WS_HN;
constexpr size_t WS_DN = WS_Y + 32 * MiB;
constexpr size_t WS_N0 = WS_Y + 33 * MiB;
constexpr size_t SM_SCAL = 512 * 1024;
template <int MODE>
__device__ __forceinline__ void mix_rec_phase(Frame& F, int layer, bool need_ctx) {
    PHASE_TID();
    const bf16_t* P = (const bf16_t*)(F.ws + WS_P); const float* GT = (const float*)(F.ws + WS_GATES); float* SCR = (float*)(F.ws + WS_SCR);
    bf16_t* DC = (bf16_t*)(F.ws + WS_DC); const bf16_t* C0 = (const bf16_t*)(F.ws + WS_C0); float* DN = (float*)(F.ws + WS_DN); const float* N0 = (const float*)(F.ws + WS_N0);
    float* SCAL = (float*)(F.ws + WS_SMALL + SM_SCAL);
    LAS float* tq = (LAS float*)(F.lds + wave * 13312); LAS float* tk = tq + 17 * 64; LAS float* tv = tk + 17 * 64; LAS float* tg = tv + 17 * 64;
    const int dblk = lane >> 3, eblk = lane & 7;
    const int gw = F.bid * NWAVES + wave, NGW = F.G * NWAVES;
    for (int unit = NUNIT / 2 + gw; unit < NUNIT; unit += NGW) {
        const int sq = unit >> 6, j = unit & 63, kind = sq >> 5, b = (sq >> 3) & 3, h = (sq >> 1) & 3, dir = sq & 1;
        float C[8][8], n8[8];
        float mrun = (MODE == 0) ? -1e30f : 0.f, bsum = 0.f;
        if (MODE == 0) {
#pragma unroll
            for (int i = 0; i < 8; ++i) { n8[i] = (kind == 0) ? 0.f : 1.f;
#pragma unroll
                for (int jj = 0; jj < 8; ++jj) C[i][jj] = 0.f; }
        } else {
            const bf16_t* c0 = C0 + (size_t)unit * 4096 + (8 * dblk) * 64 + 8 * eblk;
#pragma unroll
            for (int i = 0; i < 8; ++i) { const u32x4 w = *(const GAS u32x4*)(c0 + i * 64);
                C[i][0] = bf_lo(w.x); C[i][1] = bf_hi(w.x); C[i][2] = bf_lo(w.y); C[i][3] = bf_hi(w.y); C[i][4] = bf_lo(w.z); C[i][5] = bf_hi(w.z); C[i][6] = bf_lo(w.w); C[i][7] = bf_hi(w.w);
                n8[i] = N0[(size_t)unit * 64 + 8 * dblk + i]; }
            mrun = SCAL[2 * 4096 + unit];
        }
        float* outp = SCR + (size_t)(kind * 2 + dir) * ROWS * 256 + h * 64 + 8 * eblk + dblk;
        const float gb_i = F.a->in[I_MLGB][layer * 16 + (2 * dir) * 4 + h], gb_f = F.a->in[I_MLGB][layer * 16 + (2 * dir + 1) * 4 + h];
        const float lb = ((const float*)(F.ws + WS_SMALL + SM_LB))[layer * 256 + h * 64 + lane];
        for (int n0 = 0; n0 < LCH; n0 += 17) {
            const int nb = j * LCH + n0;
            if (kind == 0) {
#pragma unroll
                for (int tt = 0; tt < 17; ++tt) { const bf16_t* pr = P + (size_t)seq_row(b, dir, nb + tt) * PW + h * 64 + lane;
                    tq[tt * 64 + lane] = bf2f(pr[ML_Q]); tk[tt * 64 + lane] = bf2f(pr[ML_K]); tv[tt * 64 + lane] = bf2f(pr[ML_V]); }
                if (lane < 17) { const float* g = GT + (size_t)seq_row(b, dir, nb + lane) * 16; tg[lane] = g[(2 * dir) * 4 + h] + gb_i; tg[17 + lane] = log_sigmoidf_(g[(2 * dir + 1) * 4 + h] + gb_f); }
            } else {
#pragma unroll
                for (int tt = 0; tt < 17; ++tt) { const bf16_t* pr = P + (size_t)seq_row(b, dir, nb + tt) * PW + h * 64 + lane;
                    const float sg = sigmoidf_(bf2f(pr[HG_F + dir * 256]));
                    tq[tt * 64 + lane] = siluf_(bf2f(pr[HG_Q])); tk[tt * 64 + lane] = fmaxf(lb, 1e-30f) + (1.0f - lb) * sg; tv[tt * 64 + lane] = bf2f(pr[HG_I]); }
            }
            LDS_WAIT(); asm volatile("" ::: "memory");
            for (int tt = 0; tt < 17; ++tt) {
                const f32x4 ka = *(const LAS f32x4*)(tk + tt * 64 + 8 * dblk), kb = *(const LAS f32x4*)(tk + tt * 64 + 8 * dblk + 4);
                const f32x4 va = *(const LAS f32x4*)(tv + tt * 64 + 8 * eblk), vb = *(const LAS f32x4*)(tv + tt * 64 + 8 * eblk + 4);
                const float k8[8] = {ka.x, ka.y, ka.z, ka.w, kb.x, kb.y, kb.z, kb.w}, v8[8] = {va.x, va.y, va.z, va.w, vb.x, vb.y, vb.z, vb.w};
                float q8[8];
                if (MODE == 2) { const f32x4 qa = *(const LAS f32x4*)(tq + tt * 64 + 8 * dblk), qb = *(const LAS f32x4*)(tq + tt * 64 + 8 * dblk + 4);
                    q8[0] = qa.x; q8[1] = qa.y; q8[2] = qa.z; q8[3] = qa.w; q8[4] = qb.x; q8[5] = qb.y; q8[6] = qb.z; q8[7] = qb.w; }
                float po[8], dpart = 0.f, floorv = 0.f;
#pragma unroll
                for (int jj = 0; jj < 8; ++jj) po[jj] = 0.f;
                if (kind == 0) {
                    const float li = tg[tt], lf = tg[17 + tt];
                    const float mnew = fmaxf(lf + mrun, li); const float fs = __expf(lf + mrun - mnew), is = __expf(li - mnew); mrun = mnew; bsum += lf;
#pragma unroll
                    for (int i = 0; i < 8; ++i) { const float ik = is * k8[i]; n8[i] = fs * n8[i] + ik;
#pragma unroll
                        for (int jj = 0; jj < 8; ++jj) { C[i][jj] = fs * C[i][jj] + ik * v8[jj]; if (MODE == 2) po[jj] += q8[i] * C[i][jj]; }
                        if (MODE == 2) dpart += q8[i] * n8[i]; }
                    if (MODE == 2) floorv = __expf(-mnew);
                } else {
#pragma unroll
                    for (int i = 0; i < 8; ++i) { const float f = k8[i], kk = 1.0f - f; n8[i] *= f;
#pragma unroll
                        for (int jj = 0; jj < 8; ++jj) { C[i][jj] = f * C[i][jj] + kk * v8[jj]; if (MODE == 2) po[jj] += q8[i] * C[i][jj]; } }
                }
                if (MODE == 2) {
                    float r4[4], r2[2], o;
                    const bool b5 = (lane & 32) != 0, b4 = (lane & 16) != 0, b3 = (lane & 8) != 0;
#pragma unroll
                    for (int x = 0; x < 4; ++x) { const float keep = b5 ? po[4 + x] : po[x], send = b5 ? po[x] : po[4 + x]; r4[x] = keep + __shfl_xor(send, 32); }
#pragma unroll
                    for (int x = 0; x < 2; ++x) { const float keep = b4 ? r4[2 + x] : r4[x], send = b4 ? r4[x] : r4[2 + x]; r2[x] = keep + __shfl_xor(send, 16); }
                    { const float keep = b3 ? r2[1] : r2[0], send = b3 ? r2[0] : r2[1]; o = keep + __shfl_xor(send, 8); }
                    if (kind == 0) { dpart += __shfl_xor(dpart, 8); dpart += __shfl_xor(dpart, 16); dpart += __shfl_xor(dpart, 32); o = o / fmaxf(fabsf(dpart), floorv); }
                    const int row = seq_row(b, dir, nb + tt);
                    if (need_ctx || row < NLAT) outp[(size_t)row * 256] = o;
                }
            }
            LDS_WAIT(); asm volatile("" ::: "memory");
        }
        if (MODE == 0) {
            bf16_t* dc = DC + (size_t)unit * 4096 + (8 * dblk) * 64 + 8 * eblk;
#pragma unroll
            for (int i = 0; i < 8; ++i) { u32x4 w; w.x = cvt_pk_bf16(C[i][0], C[i][1]); w.y = cvt_pk_bf16(C[i][2], C[i][3]); w.z = cvt_pk_bf16(C[i][4], C[i][5]); w.w = cvt_pk_bf16(C[i][6], C[i][7]); *(GAS u32x4*)(dc + i * 64) = w; }
            if (eblk == 0) {
#pragma unroll
                for (int i = 0; i < 8; ++i) DN[(size_t)unit * 64 + 8 * dblk + i] = n8[i]; }
            if (lane == 0) { SCAL[unit] = mrun; SCAL[4096 + unit] = bsum; }
        }
    }
}
__device__ __forceinline__ void mix_scan_phase(Frame& F) {
    PHASE_TID();
    const bf16_t* DC = (const bf16_t*)(F.ws + WS_DC); bf16_t* C0 = (bf16_t*)(F.ws + WS_C0); const float* DN = (const float*)(F.ws + WS_DN); float* N0 = (float*)(F.ws + WS_N0);
    float* SCAL = (float*)(F.ws + WS_SMALL + SM_SCAL);
    LAS float* sml = (LAS float*)F.lds; LAS float* sbl = sml + 64;
    for (int it = NSEQ * 2 + F.bid; it < NSEQ * 4; it += F.G) {
        const int sq = it >> 2, qtr = it & 3, kind = sq >> 5, d = 16 * qtr + (tid >> 5), e2 = (tid & 31) * 2;
        __syncthreads();
        if (tid < 64) { sml[tid] = SCAL[sq * 64 + tid]; sbl[tid] = SCAL[4096 + sq * 64 + tid]; }
        __syncthreads();
        float c0 = 0.f, c1 = 0.f, nn = 0.f, m = 0.f;
        const bf16_t* dcp = DC + (size_t)(sq * 64) * 4096 + d * 64 + e2; bf16_t* c0p = C0 + (size_t)(sq * 64) * 4096 + d * 64 + e2;
        const float* dnp = DN + (size_t)(sq * 64) * 64 + d; float* n0p = N0 + (size_t)(sq * 64) * 64 + d;
        for (int jb = 0; jb < 64; jb += 16) {
            unsigned dcv[16]; float dnv[16];
#pragma unroll
            for (int j = 0; j < 16; ++j) { dcv[j] = *(const GAS unsigned*)(dcp + (size_t)(jb + j) * 4096); dnv[j] = dnp[(size_t)(jb + j) * 64]; }
#pragma unroll
            for (int j = 0; j < 16; ++j) {
                *(GAS unsigned*)(c0p + (size_t)(jb + j) * 4096) = cvt_pk_bf16(c0, c1);
                if (kind == 0) {
                    if (e2 == 0) n0p[(size_t)(jb + j) * 64] = nn;
                    if (qtr == 0 && tid == 0) SCAL[2 * 4096 + sq * 64 + jb + j] = m;
                    const float ml = sml[jb + j], bl = sbl[jb + j]; const float mnew = fmaxf(bl + m, ml); const float so = __expf(bl + m - mnew), sn = __expf(ml - mnew); m = mnew;
                    c0 = so * c0 + sn * bf_lo(dcv[j]); c1 = so * c1 + sn * bf_hi(dcv[j]); nn = so * nn + sn * dnv[j];
                } else { const float a = dnv[j]; c0 = a * c0 + bf_lo(dcv[j]); c1 = a * c1 + bf_hi(dcv[j]); }
            }
        }
    }
}
constexpr int NC2 = 68;
constexpr size_t WS_DCM = WS_SCR;
constexpr size_t WS_C0M = WS_SCR + 34 * MiB;
constexpr size_t WS_DNM = WS_Y;
constexpr size_t WS_N0M = WS_Y + 2 * MiB;
constexpr size_t SM_SCALM = 768 * 1024;
__device__ __forceinline__ f32x16 zero16() { f32x16 v;
#pragma unroll
    for (int r = 0; r < 16; ++r) v[r] = 0.f;
    asm volatile("" : "+v"(v)); return v; }
__device__ __forceinline__ f32x16 mfma32(bf16x8 a, bf16x8 b, f32x16 c) { const f32x16 d = __builtin_amdgcn_mfma_f32_32x32x16_bf16(a, b, c, 0, 0, 0); asm volatile("" :: "v"(a), "v"(b)); return d; }
__device__ __forceinline__ f32x4 mfma16(bf16x8 a, bf16x8 b, f32x4 c) {
    asm volatile("s_nop 1\n\tv_mfma_f32_16x16x32_bf16 %0, %1, %2, %0\n\ts_nop 7\n\ts_nop 7" : "+v"(c) : "v"(a), "v"(b));
    return c; }
__device__ __forceinline__ int crow(int r, int hi) { return (r & 3) + 8 * (r >> 2) + 4 * hi; }
template <int CTRL> __device__ __forceinline__ float dpp_zero(float v) { return __int_as_float(__builtin_amdgcn_update_dpp(0, __float_as_int(v), CTRL, 0xF, 0xF, true)); }
template <int CTRL, int ROWMASK> __device__ __forceinline__ float dpp_keep(float v) { return __int_as_float(__builtin_amdgcn_update_dpp(__float_as_int(v), __float_as_int(v), CTRL, ROWMASK, 0xF, false)); }
__device__ __forceinline__ float wave_prefix_sum(float x) {
    x += dpp_zero<0x111>(x); x += dpp_zero<0x112>(x); x += dpp_zero<0x114>(x); x += dpp_zero<0x118>(x);
    x += dpp_get<0x142, 0xA>(x); x += dpp_get<0x143, 0xC>(x); return x; }
__device__ __forceinline__ float wave_prefix_max(float x) {
    x = fmaxf(x, dpp_keep<0x111, 0xF>(x)); x = fmaxf(x, dpp_keep<0x112, 0xF>(x)); x = fmaxf(x, dpp_keep<0x114, 0xF>(x)); x = fmaxf(x, dpp_keep<0x118, 0xF>(x));
    x = fmaxf(x, dpp_keep<0x142, 0xA>(x)); x = fmaxf(x, dpp_keep<0x143, 0xC>(x)); return x; }
__device__ __forceinline__ float wave_max(float v) {
    v = fmaxf(v, dpp_keep<0xB1, 0xF>(v)); v = fmaxf(v, dpp_keep<0x4E, 0xF>(v)); v = fmaxf(v, dpp_keep<0x141, 0xF>(v)); v = fmaxf(v, dpp_keep<0x140, 0xF>(v));
    v = fmaxf(v, dpp_keep<0x142, 0xA>(v)); v = fmaxf(v, dpp_keep<0x143, 0xC>(v));
    return __int_as_float(__builtin_amdgcn_readlane(__float_as_int(v), 63)); }
__device__ __forceinline__ bf16x8 tr_frag(const LAS unsigned char* p) {
    const s16x4 lo = __builtin_bit_cast(s16x4, __builtin_amdgcn_ds_read_tr16_b64_v4i16((LAS s16x4*)(p)));
    const s16x4 hh = __builtin_bit_cast(s16x4, __builtin_amdgcn_ds_read_tr16_b64_v4i16((LAS s16x4*)(p + 512)));
    return (bf16x8){lo[0], lo[1], lo[2], lo[3], hh[0], hh[1], hh[2], hh[3]}; }
__device__ __forceinline__ u32x4 scale_bf16x8(u32x4 w, float sc) { u32x4 o; o.x = cvt_pk_bf16(bf_lo(w.x) * sc, bf_hi(w.x) * sc); o.y = cvt_pk_bf16(bf_lo(w.y) * sc, bf_hi(w.y) * sc); o.z = cvt_pk_bf16(bf_lo(w.z) * sc, bf_hi(w.z) * sc); o.w = cvt_pk_bf16(bf_lo(w.w) * sc, bf_hi(w.w) * sc); return o; }
__device__ __forceinline__ void ml_unit(int unit, int& b, int& h, int& c, int& row0, int& jf, int& jb) {
    const int bh = unit / NC2; c = unit - bh * NC2; b = bh >> 2; h = bh & 3;
    row0 = c < 4 ? NLAT + b * CTXL + 64 * c : b * SEQ + 64 * (c - 4); jf = c; jb = c < 4 ? 3 - c : 71 - c; }
__device__ __forceinline__ void mlstm_a_phase(Frame& F, int layer) {
    PHASE_TID();
    const bf16_t* P = (const bf16_t*)(F.ws + WS_P); const float* GT = (const float*)(F.ws + WS_GATES);
    bf16_t* DCM = (bf16_t*)(F.ws + WS_DCM); float* DNM = (float*)(F.ws + WS_DNM); float* SC = (float*)(F.ws + WS_SMALL + SM_SCALM);
    LAS unsigned char* Vimg = F.lds; LAS unsigned char* Kimg = F.lds + 8192; LAS float* wv = (LAS float*)(F.lds + 24576);
    const int r32 = lane & 31, hi = lane >> 5;
    const int vrd = ((lane >> 4) & 1) * 32 + (lane & 3) * 8 + (4 * hi + ((lane & 15) >> 2)) * 64;
    const int ps = tid >> 3, pc = tid & 7, pst = (pc >> 2) * 4096 + ps * 64 + (pc & 3) * 16;
    const bf16x8 ones = {0x3F80, 0x3F80, 0x3F80, 0x3F80, 0x3F80, 0x3F80, 0x3F80, 0x3F80};
    u32x4 nk, nv; float gli = 0.f, glf = 0.f, gbi = 0.f, gbf = 0.f;
#define MA_LOAD(uu) do { int b_, h_, c_, r_, j_, k_; ml_unit((uu), b_, h_, c_, r_, j_, k_); \
        if (wave < 2) { const float* g_ = GT + (size_t)(r_ + (wave == 0 ? lane : 63 - lane)) * 16; const float* gb_ = F.a->in[I_MLGB] + layer * 16; \
            gli = g_[(2 * wave) * 4 + h_]; glf = g_[(2 * wave + 1) * 4 + h_]; gbi = gb_[(2 * wave) * 4 + h_]; gbf = gb_[(2 * wave + 1) * 4 + h_]; } \
        nk = *(const GAS u32x4*)(P + (size_t)(r_ + ps) * PW + ML_K + h_ * 64 + pc * 8); nv = *(const GAS u32x4*)(P + (size_t)(r_ + ps) * PW + ML_V + h_ * 64 + pc * 8); } while (0)
    if (F.bid < 16 * NC2) MA_LOAD(F.bid);
    for (int unit = F.bid; unit < 16 * NC2; unit += F.G) {
        int b, h, c, row0, jf, jb; ml_unit(unit, b, h, c, row0, jf, jb);
        __syncthreads();
        const u32x4 kraw = nk;
        *(LAS u32x4*)(Vimg + pst) = nv;
        const float cli = gli + gbi, clf = glf + gbf;
        if (unit + F.G < 16 * NC2) MA_LOAD(unit + F.G);
        if (wave < 2) { const int dir = wave; const int tk = dir == 0 ? lane : 63 - lane;
            const float li = cli, lf = log_sigmoidf_(clf);
            const float bt = wave_prefix_sum(lf);
            const float btot = __int_as_float(__builtin_amdgcn_readlane(__float_as_int(bt), 63));
            const float a = btot - bt + li; const float mloc = wave_max(a);
            wv[dir * 64 + tk] = __expf(a - mloc);
            if (lane == 0) { const int si = ((b * 4 + h) * 2 + dir) * NC2 + (dir == 0 ? jf : jb); SC[si] = mloc; SC[32 * NC2 + si] = btot; } }
        __syncthreads();
        *(LAS u32x4*)(Kimg + pst) = scale_bf16x8(kraw, wv[ps]); *(LAS u32x4*)(Kimg + 8192 + pst) = scale_bf16x8(kraw, wv[64 + ps]);
        __syncthreads();
        { const int dir = wave >> 2, eblk = (wave >> 1) & 1, dblk = wave & 1;
            f32x16 acc = zero16(), dn = zero16();
#pragma unroll
            for (int ks = 0; ks < 4; ++ks) { const bf16x8 va = tr_frag(Vimg + eblk * 4096 + ks * 1024 + vrd), kb = tr_frag(Kimg + dir * 8192 + dblk * 4096 + ks * 1024 + vrd);
                acc = mfma32(va, kb, acc); if (eblk == 0) dn = mfma32(ones, kb, dn); }
            const size_t si = (size_t)((b * 4 + h) * 2 + dir) * NC2 + (dir == 0 ? jf : jb);
            bf16_t* dst = DCM + si * 4096 + (32 * eblk) * 64 + 32 * dblk + r32;
#pragma unroll
            for (int r = 0; r < 16; ++r) dst[crow(r, hi) * 64] = (bf16_t)(cvt_pk_bf16(acc[r], 0.f) & 0xffffu);
            if (eblk == 0 && hi == 0) DNM[si * 64 + 32 * dblk + r32] = dn[0];
        }
    }
#undef MA_LOAD
}
__device__ __forceinline__ void mix_scan2_phase(Frame& F) {
    PHASE_TID();
    const bf16_t* DCM = (const bf16_t*)(F.ws + WS_DCM); bf16_t* C0M = (bf16_t*)(F.ws + WS_C0M); const float* DNM = (const float*)(F.ws + WS_DNM); float* N0M = (float*)(F.ws + WS_N0M);
    float* SC = (float*)(F.ws + WS_SMALL + SM_SCALM);
    LAS float* sml = (LAS float*)(F.lds + 120 * 1024); LAS float* sbl = sml + NC2;
    for (int it = F.bid; it < 64 * 4; it += F.G) {
        const int sq = it >> 2, qtr = it & 3, kind = sq >> 5, e = 16 * qtr + (tid >> 5), d2 = (tid & 31) * 2;
        __syncthreads();
        if (kind == 0 && tid < NC2) { sml[tid] = SC[sq * NC2 + tid]; sbl[tid] = SC[32 * NC2 + sq * NC2 + tid]; }
        __syncthreads();
        float c0 = 0.f, c1 = 0.f, n0 = 0.f, n1 = 0.f, m = 0.f;
        const bf16_t* dcp = DCM + (size_t)(sq * NC2) * 4096 + e * 64 + d2; bf16_t* c0p = C0M + (size_t)(sq * NC2) * 4096 + e * 64 + d2;
        const float* dnp = DNM + (size_t)(sq * NC2) * 64 + d2; float* n0p = N0M + (size_t)(sq * NC2) * 64 + d2;
        const bool nrow = (kind == 0) && (qtr == 0) && ((tid >> 5) == 0);
#define SCAN_LOAD(DC, DN, jb) do { _Pragma("unroll") for (int j = 0; j < 17; ++j) { DC[j] = *(const GAS unsigned*)(dcp + (size_t)((jb) + j) * 4096); DN[j] = (nrow || kind == 1) ? *(const GAS f32x2*)(dnp + (size_t)((jb) + j) * 64) : (f32x2){0.f, 0.f}; } } while (0)
#define SCAN_STEP(DC, DN, jb) do { _Pragma("unroll") for (int j = 0; j < 17; ++j) { \
                *(GAS unsigned*)(c0p + (size_t)((jb) + j) * 4096) = cvt_pk_bf16(c0, c1); \
                if (kind == 0) { \
                    if (nrow) { *(GAS f32x2*)(n0p + (size_t)((jb) + j) * 64) = (f32x2){n0, n1}; if (tid == 0) SC[64 * NC2 + sq * NC2 + (jb) + j] = m; } \
                    const float ml = sml[(jb) + j], bl = sbl[(jb) + j]; const float mnew = fmaxf(bl + m, ml); const float so = __expf(bl + m - mnew), sn = __expf(ml - mnew); m = mnew; \
                    c0 = so * c0 + sn * bf_lo(DC[j]); c1 = so * c1 + sn * bf_hi(DC[j]); n0 = so * n0 + sn * DN[j].x; n1 = so * n1 + sn * DN[j].y; \
                } else { c0 = DN[j].x * c0 + bf_lo(DC[j]); c1 = DN[j].y * c1 + bf_hi(DC[j]); } } } while (0)
        { unsigned dca[17], dcb[17]; f32x2 dna[17], dnb[17];
            SCAN_LOAD(dca, dna, 0); SCAN_LOAD(dcb, dnb, 17); SCAN_STEP(dca, dna, 0);
            SCAN_LOAD(dca, dna, 34); SCAN_STEP(dcb, dnb, 17);
            SCAN_LOAD(dcb, dnb, 51); SCAN_STEP(dca, dna, 34);
            SCAN_STEP(dcb, dnb, 51); }
#undef SCAN_LOAD
#undef SCAN_STEP
    }
}
__device__ __forceinline__ void mlstm_c_phase(Frame& F, int layer, bool need_ctx) {
    PHASE_TID();
    const bf16_t* P = (const bf16_t*)(F.ws + WS_P); const float* GT = (const float*)(F.ws + WS_GATES); bf16_t* MIX = (bf16_t*)(F.ws + WS_MIX);
    const bf16_t* C0M = (const bf16_t*)(F.ws + WS_C0M); const float* N0M = (const float*)(F.ws + WS_N0M); const float* SC = (const float*)(F.ws + WS_SMALL + SM_SCALM);
    LAS unsigned char* Qimg = F.lds; LAS unsigned char* Kimg = F.lds + 8192; LAS unsigned char* Vimg = F.lds + 16384;
    LAS float* vec = (LAS float*)(F.lds + 24576);
    LAS float* Hx = (LAS float*)(F.lds + 26624);
    const int r32 = lane & 31, hi = lane >> 5;
    const int vrd = ((lane >> 4) & 1) * 32 + (lane & 3) * 8 + (4 * hi + ((lane & 15) >> 2)) * 64;
    const int ps = tid >> 3, pc = tid & 7, pst = (pc >> 2) * 4096 + ps * 64 + (pc & 3) * 16, prm = ps * 128 + ((pc ^ ((ps >> 1) & 7)) << 4);
    const bf16x8 ones = {0x3F80, 0x3F80, 0x3F80, 0x3F80, 0x3F80, 0x3F80, 0x3F80, 0x3F80};
    const int nunit = need_ctx ? 16 * NC2 : 16 * 64;
    const int vb = F.G == 256 ? ((F.bid + 192) & 255) : F.bid;
    u32x4 rq, rk, rv, ro; float gli = 0.f, glf = 0.f, gbi = 0.f, gbf = 0.f, gm0 = 0.f, gn0 = 0.f;
#define ML_LOAD(uu) do { const int un_ = need_ctx ? (uu) : ((uu) >> 6) * NC2 + 4 + ((uu) & 63); int b_, h_, c_, r_, j_, k_; ml_unit(un_, b_, h_, c_, r_, j_, k_); \
        if (wave < 2) { const float* g_ = GT + (size_t)(r_ + (wave == 0 ? lane : 63 - lane)) * 16; const float* gb_ = F.a->in[I_MLGB] + layer * 16; \
            gli = g_[(2 * wave) * 4 + h_]; glf = g_[(2 * wave + 1) * 4 + h_]; gbi = gb_[(2 * wave) * 4 + h_]; gbf = gb_[(2 * wave + 1) * 4 + h_]; gm0 = SC[64 * NC2 + ((b_ * 4 + h_) * 2 + wave) * NC2 + (wave == 0 ? j_ : k_)]; gn0 = N0M[((size_t)((b_ * 4 + h_) * 2 + wave) * NC2 + (wave == 0 ? j_ : k_)) * 64 + lane]; } \
        const bf16_t* pr_ = P + (size_t)(r_ + ps) * PW + h_ * 64 + pc * 8; rq = *(const GAS u32x4*)(pr_ + ML_Q); rk = *(const GAS u32x4*)(pr_ + ML_K); rv = *(const GAS u32x4*)(pr_ + ML_V); ro = *(const GAS u32x4*)(pr_ + ML_O); } while (0)
    if (tid < 256) ((LAS float*)(F.lds + 128000))[tid] = F.a->in[I_MLNORM][layer * 256 + tid];
    if (vb < nunit) ML_LOAD(vb);
    for (int u0 = vb; u0 < nunit; u0 += F.G) {
        const int unit = need_ctx ? u0 : (u0 >> 6) * NC2 + 4 + (u0 & 63);
        int b, h, c, row0, jf, jb; ml_unit(unit, b, h, c, row0, jf, jb);
        __syncthreads();
        *(LAS u32x4*)(Qimg + prm) = rq; *(LAS u32x4*)(Kimg + prm) = rk; *(LAS u32x4*)(Vimg + pst) = rv; const u32x4 ow = ro;
        const float cli = gli + gbi, clf = glf + gbf, cm0 = gm0, cn0 = gn0;
        if (u0 + F.G < nunit) ML_LOAD(u0 + F.G);
        u32x4 cbr[4];
        { const int dir_ = wave >> 2, eblk_ = wave & 1; const size_t si = (size_t)((b * 4 + h) * 2 + dir_) * NC2 + (dir_ == 0 ? jf : jb);
            const bf16_t* c0 = C0M + si * 4096 + (size_t)(32 * eblk_ + r32) * 64 + 8 * hi;
#pragma unroll
            for (int ks = 0; ks < 4; ++ks) cbr[ks] = *(const GAS u32x4*)(c0 + 16 * ks); }
        if (wave < 2) { const int dir = wave; const int tk = dir == 0 ? lane : 63 - lane;
            ((LAS float*)(F.lds + 130048))[dir * 64 + lane] = cn0;
            const float li = cli, lf = log_sigmoidf_(clf);
            const float m0 = cm0;
            const float bt = wave_prefix_sum(lf);
            const float cv = li - bt; const float pm = wave_prefix_max(cv);
            const float gv = fmaxf(m0, pm);
            LAS float* vd = vec + dir * 256; vd[tk] = cv; vd[64 + tk] = gv; vd[128 + tk] = __expf(m0 - gv); vd[192 + tk] = __expf(-(bt + gv)); }
        __syncthreads();
        { const int dir = wave >> 2, tblk = (wave >> 1) & 1, eblk = wave & 1;
            const LAS float* vd = vec + dir * 256;
            const int tl = 32 * tblk + r32; const float g_t = vd[64 + tl];
            bf16x8 qf[4];
#pragma unroll
            for (int ks = 0; ks < 4; ++ks) qf[ks] = *(const LAS bf16x8*)(Qimg + tl * 128 + (((2 * ks + hi) ^ ((tl >> 1) & 7)) << 4));
            f32x16 O = zero16(), L = zero16(), Oi = zero16(), Li = zero16();
#pragma unroll
            for (int sblk = 0; sblk < 2; ++sblk) {
                const bool valid = dir == 0 ? (sblk <= tblk) : (sblk >= tblk);
                if (valid) {
                    f32x16 S = zero16();
                    const int sl = 32 * sblk + r32;
#pragma unroll
                    for (int ks = 0; ks < 4; ++ks) { const bf16x8 ka = *(const LAS bf16x8*)(Kimg + sl * 128 + (((2 * ks + hi) ^ ((sl >> 1) & 7)) << 4)); S = mfma32(ka, qf[ks], S); }
#pragma unroll
                    for (int r = 0; r < 16; ++r) { const int s = 32 * sblk + crow(r, hi); const float w = __expf(vd[s] - g_t); const bool ok = dir == 0 ? (s <= tl) : (s >= tl); S[r] = ok ? S[r] * w : 0.f; }
                    u32x4 w0, w1;
                    w0.x = cvt_pk_bf16(S[0], S[1]); w0.y = cvt_pk_bf16(S[2], S[3]); w0.z = cvt_pk_bf16(S[4], S[5]); w0.w = cvt_pk_bf16(S[6], S[7]);
                    w1.x = cvt_pk_bf16(S[8], S[9]); w1.y = cvt_pk_bf16(S[10], S[11]); w1.z = cvt_pk_bf16(S[12], S[13]); w1.w = cvt_pk_bf16(S[14], S[15]);
                    const bf16x8 p0 = __builtin_bit_cast(bf16x8, w0), p1 = __builtin_bit_cast(bf16x8, w1);
                    const bf16x8 v0 = tr_frag(Vimg + eblk * 4096 + (2 * sblk) * 1024 + vrd), v1 = tr_frag(Vimg + eblk * 4096 + (2 * sblk + 1) * 1024 + vrd);
                    O = mfma32(p0, v0, O); O = mfma32(p1, v1, O);
                    L = mfma32(p0, ones, L); L = mfma32(p1, ones, L);
                }
            }
            {
#pragma unroll
                for (int ks = 0; ks < 4; ++ks) { const bf16x8 cb = __builtin_bit_cast(bf16x8, cbr[ks]);
                    const LAS float* n0l = (const LAS float*)(F.lds + 130048) + dir * 64 + 8 * hi + 16 * ks; const f32x4 na = *(const LAS f32x4*)n0l, nb = *(const LAS f32x4*)(n0l + 4);
                    u32x4 nw; nw.x = cvt_pk_bf16(na.x, na.y); nw.y = cvt_pk_bf16(na.z, na.w); nw.z = cvt_pk_bf16(nb.x, nb.y); nw.w = cvt_pk_bf16(nb.z, nb.w);
                    Oi = mfma32(qf[ks], cb, Oi); Li = mfma32(qf[ks], __builtin_bit_cast(bf16x8, nw), Li); } }
#pragma unroll
            for (int r = 0; r < 16; ++r) { const int t = 32 * tblk + crow(r, hi); const float wi = vd[128 + t], fl = vd[192 + t];
                const float num = O[r] + wi * Oi[r], den = L[r] + wi * Li[r];
                Hx[(dir * 64 + t) * 65 + 32 * eblk + r32] = num * fast_rcp(fmaxf(fabsf(den), fl)); }
        }
        __syncthreads();
        { const int t = tid >> 3, e8 = (tid & 7) * 8; float v[8]; float ss = 0.f;
#pragma unroll
            for (int i = 0; i < 8; ++i) { v[i] = Hx[t * 65 + e8 + i] + Hx[(64 + t) * 65 + e8 + i]; ss += v[i] * v[i]; }
            ss = sum8(ss);
            const float rs = 1.0f / sqrtf(ss * (1.0f / 64.0f) + EPS);
            const float og[8] = {bf_lo(ow.x), bf_hi(ow.x), bf_lo(ow.y), bf_hi(ow.y), bf_lo(ow.z), bf_hi(ow.z), bf_lo(ow.w), bf_hi(ow.w)};
            const LAS float* nwp = (const LAS float*)(F.lds + 128000) + h * 64 + e8; const f32x4 nwa = *(const LAS f32x4*)nwp, nwb = *(const LAS f32x4*)(nwp + 4);
            const float nw[8] = {nwa.x, nwa.y, nwa.z, nwa.w, nwb.x, nwb.y, nwb.z, nwb.w}; float o[8];
#pragma unroll
            for (int i = 0; i < 8; ++i) o[i] = v[i] * rs * nw[i] * sigmoidf_(og[i]);
            u32x4 w; w.x = cvt_pk_bf16(o[0], o[1]); w.y = cvt_pk_bf16(o[2], o[3]); w.z = cvt_pk_bf16(o[4], o[5]); w.w = cvt_pk_bf16(o[6], o[7]);
            *(GAS u32x4*)(MIX + (size_t)(row0 + t) * D + h * 64 + e8) = w; }
    }
#undef ML_LOAD
    __syncthreads();
}
constexpr int HG_QR = 0, HG_VI = 8192, HG_GS = 16384, HG_KK = 49152, HG_QH = 65536, HG_KH = 81920, HG_AD = 98304, HG_LT = 106496, HG_C0 = 110592, HG_LB = 126976;
__device__ __forceinline__ int rm_off(int row, int ch) { return row * 128 + ((ch ^ ((row >> 1) & 7)) << 4); }
struct HgRaw { u32x4 v, q, f0, f1; };
template <bool WITH_Q>
__device__ __forceinline__ void hg_load(Frame& F, int h, int row0, int tid, HgRaw& r) {
    const bf16_t* pr = (const bf16_t*)(F.ws + WS_P) + (size_t)(row0 + (tid >> 3)) * PW + h * 64 + (tid & 7) * 8;
    r.v = *(const GAS u32x4*)(pr + HG_I); if (WITH_Q) r.q = *(const GAS u32x4*)(pr + HG_Q); r.f0 = *(const GAS u32x4*)(pr + HG_F); r.f1 = *(const GAS u32x4*)(pr + HG_F + 256);
}
template <bool WITH_Q>
__device__ __forceinline__ void hg_stage(Frame& F, int layer, int h, const HgRaw& raw, int tid) {
    const int ps = tid >> 3, pc = tid & 7;
    {
        const f32x4 lba = *(const LAS f32x4*)((const LAS float*)(F.lds + HG_LB) + h * 64 + pc * 8), lbb = *(const LAS f32x4*)((const LAS float*)(F.lds + HG_LB) + h * 64 + pc * 8 + 4);
        const float lb[8] = {lba.x, lba.y, lba.z, lba.w, lbb.x, lbb.y, lbb.z, lbb.w};
        *(LAS u32x4*)(F.lds + HG_VI + (pc >> 2) * 4096 + ps * 64 + (pc & 3) * 16) = raw.v;
        if (WITH_Q) { const u32x4 w = raw.q; u32x4 o;
            o.x = cvt_pk_bf16(siluf_(bf_lo(w.x)), siluf_(bf_hi(w.x))); o.y = cvt_pk_bf16(siluf_(bf_lo(w.y)), siluf_(bf_hi(w.y))); o.z = cvt_pk_bf16(siluf_(bf_lo(w.z)), siluf_(bf_hi(w.z))); o.w = cvt_pk_bf16(siluf_(bf_lo(w.w)), siluf_(bf_hi(w.w)));
            *(LAS u32x4*)(F.lds + HG_QR + rm_off(ps, pc)) = o; }
#pragma unroll
        for (int dir = 0; dir < 2; ++dir) { const u32x4 w = dir == 0 ? raw.f0 : raw.f1;
            const float fr[8] = {bf_lo(w.x), bf_hi(w.x), bf_lo(w.y), bf_hi(w.y), bf_lo(w.z), bf_hi(w.z), bf_lo(w.w), bf_hi(w.w)}; float g8[8], k8[8];
            float f8[8];
#pragma unroll
            for (int i = 0; i < 8; ++i) { const float sg = sigmoidf_(fr[i]); const float f = fmaxf(lb[i], 1e-30f) + (1.0f - lb[i]) * sg; f8[i] = f; g8[i] = __log2f(f);     k8[i] = (1.0f - lb[i]) * (1.0f - sg); }
            if (WITH_Q) { LAS float* fd = (LAS float*)(F.lds + HG_QH) + dir * 4096 + ps * 64 + pc * 8;
                *(LAS f32x4*)fd = (f32x4){f8[0], f8[1], f8[2], f8[3]}; *(LAS f32x4*)(fd + 4) = (f32x4){f8[4], f8[5], f8[6], f8[7]}; }
            LAS float* gs = (LAS float*)(F.lds + HG_GS) + dir * 4096 + ps * 64 + pc * 8;
            *(LAS f32x4*)gs = (f32x4){g8[0], g8[1], g8[2], g8[3]}; *(LAS f32x4*)(gs + 4) = (f32x4){g8[4], g8[5], g8[6], g8[7]};
            u32x4 o; o.x = cvt_pk_bf16(k8[0], k8[1]); o.y = cvt_pk_bf16(k8[2], k8[3]); o.z = cvt_pk_bf16(k8[4], k8[5]); o.w = cvt_pk_bf16(k8[6], k8[7]);
            *(LAS u32x4*)(F.lds + HG_KK + dir * 8192 + rm_off(ps, pc)) = o; }
    }
    __syncthreads();
    { const int dir = tid >> 8, grp = (tid >> 6) & 3, k = tid & 63; LAS float* gs = (LAS float*)(F.lds + HG_GS) + dir * 4096 + k; float acc = 0.f;
#pragma unroll
        for (int x = 0; x < 16; ++x) { const int tok = 16 * grp + (dir == 0 ? x : 15 - x); acc += gs[tok * 64]; gs[tok * 64] = acc; }
        ((LAS float*)(F.lds + HG_LT))[(dir * 4 + grp) * 64 + k] = acc; }
    __syncthreads();
}
__device__ __forceinline__ void hg_a_phase(Frame& F, int layer) {
    PHASE_TID();
    bf16_t* DCM = (bf16_t*)(F.ws + WS_DCM); float* DNM = (float*)(F.ws + WS_DNM);
    const int r32 = lane & 31, hi = lane >> 5;
    const int vrd = ((lane >> 4) & 1) * 32 + (lane & 3) * 8 + (4 * hi + ((lane & 15) >> 2)) * 64;
    const int ps = tid >> 3, pc = tid & 7;
    if (tid < 256) ((LAS float*)(F.lds + HG_LB))[tid] = ((const float*)(F.ws + WS_SMALL + SM_LB))[layer * 256 + tid];
    HgRaw cur; if (F.bid < 16 * NC2) { int b, h, c, row0, jf, jb; ml_unit(F.bid, b, h, c, row0, jf, jb); hg_load<false>(F, h, row0, tid, cur); }
    for (int unit = F.bid; unit < 16 * NC2; unit += F.G) {
        int b, h, c, row0, jf, jb; ml_unit(unit, b, h, c, row0, jf, jb);
        HgRaw nxt = cur; if (unit + F.G < 16 * NC2) { int b2, h2, c2, r2, j2, j3; ml_unit(unit + F.G, b2, h2, c2, r2, j2, j3); hg_load<false>(F, h2, r2, tid, nxt); }
        __syncthreads();
        hg_stage<false>(F, layer, h, cur, tid); cur = nxt;
        const LAS float* LT = (const LAS float*)(F.lds + HG_LT);
#pragma unroll
        for (int dir = 0; dir < 2; ++dir) { const int grp = ps >> 4; const LAS float* gs = (const LAS float*)(F.lds + HG_GS) + dir * 4096 + ps * 64 + pc * 8;
            const u32x4 kw = *(const LAS u32x4*)(F.lds + HG_KK + dir * 8192 + rm_off(ps, pc));
            const float kk8[8] = {bf_lo(kw.x), bf_hi(kw.x), bf_lo(kw.y), bf_hi(kw.y), bf_lo(kw.z), bf_hi(kw.z), bf_lo(kw.w), bf_hi(kw.w)}; float o8[8];
#pragma unroll
            for (int i = 0; i < 8; ++i) { float ex = LT[(dir * 4 + grp) * 64 + pc * 8 + i] - gs[i];
#pragma unroll
                for (int g2 = 0; g2 < 4; ++g2) { const bool after = dir == 0 ? (g2 > grp) : (g2 < grp); if (after) ex += LT[(dir * 4 + g2) * 64 + pc * 8 + i]; }
                o8[i] = kk8[i] * fast_exp2(ex); }
            u32x4 o; o.x = cvt_pk_bf16(o8[0], o8[1]); o.y = cvt_pk_bf16(o8[2], o8[3]); o.z = cvt_pk_bf16(o8[4], o8[5]); o.w = cvt_pk_bf16(o8[6], o8[7]);
            *(LAS u32x4*)(F.lds + HG_QH + dir * 8192 + (pc >> 2) * 4096 + ps * 64 + (pc & 3) * 16) = o; }
        if (tid < 128) { const int dir = tid >> 6, k = tid & 63; const float tot = (LT[(dir * 4 + 0) * 64 + k] + LT[(dir * 4 + 1) * 64 + k]) + (LT[(dir * 4 + 2) * 64 + k] + LT[(dir * 4 + 3) * 64 + k]);
            DNM[((size_t)(32 + (b * 4 + h) * 2 + dir) * NC2 + (dir == 0 ? jf : jb)) * 64 + k] = fast_exp2(tot); }
        __syncthreads();
        { const int dir = wave >> 2, eblk = (wave >> 1) & 1, dblk = wave & 1;
            f32x16 acc = zero16();
#pragma unroll
            for (int ks = 0; ks < 4; ++ks) { const bf16x8 va = tr_frag(F.lds + HG_VI + eblk * 4096 + ks * 1024 + vrd), kb = tr_frag(F.lds + HG_QH + dir * 8192 + dblk * 4096 + ks * 1024 + vrd);
                acc = mfma32(va, kb, acc); }
            const size_t si = (size_t)(32 + (b * 4 + h) * 2 + dir) * NC2 + (dir == 0 ? jf : jb);
            bf16_t* dst = DCM + si * 4096 + (32 * eblk) * 64 + 32 * dblk + r32;
#pragma unroll
            for (int r = 0; r < 16; ++r) dst[crow(r, hi) * 64] = (bf16_t)(cvt_pk_bf16(acc[r], 0.f) & 0xffffu);
        }
    }
}
__device__ __forceinline__ bf16x8 scale_frag(bf16x8 v, const LAS float* e0, const LAS float* e1, const LAS float* e2, int n) {
    const u32x4 w = __builtin_bit_cast(u32x4, v);
    f32x4 a = *(const LAS f32x4*)e0, bq = *(const LAS f32x4*)(e0 + 4);
    if (n > 1) { a = a + *(const LAS f32x4*)e1; bq = bq + *(const LAS f32x4*)(e1 + 4); }
    if (n > 2) { a = a + *(const LAS f32x4*)e2; bq = bq + *(const LAS f32x4*)(e2 + 4); }
    u32x4 o; o.x = cvt_pk_bf16(bf_lo(w.x) * fast_exp2(a.x), bf_hi(w.x) * fast_exp2(a.y)); o.y = cvt_pk_bf16(bf_lo(w.y) * fast_exp2(a.z), bf_hi(w.y) * fast_exp2(a.w));
    o.z = cvt_pk_bf16(bf_lo(w.z) * fast_exp2(bq.x), bf_hi(w.z) * fast_exp2(bq.y)); o.w = cvt_pk_bf16(bf_lo(w.w) * fast_exp2(bq.z), bf_hi(w.w) * fast_exp2(bq.w));
    return __builtin_bit_cast(bf16x8, o); }
__device__ __forceinline__ void hg_c_phase(Frame& F, int layer, bool need_ctx) {
    PHASE_TID();
    const bf16_t* P = (const bf16_t*)(F.ws + WS_P); bf16_t* MIX = (bf16_t*)(F.ws + WS_MIX); const bf16_t* C0M = (const bf16_t*)(F.ws + WS_C0M);
    const int ps = tid >> 3, pc = tid & 7;
    const int l16 = lane & 15, g4 = lane >> 4;
    const int nunit = need_ctx ? 16 * NC2 : 16 * 64;
    const int vb = F.G == 256 ? ((F.bid + 128) & 255) : F.bid;
    if (tid < 256) { ((LAS float*)(F.lds + HG_LB))[tid] = ((const float*)(F.ws + WS_SMALL + SM_LB))[layer * 256 + tid]; ((LAS float*)(F.lds + 129024))[tid] = F.a->in[I_HGNORM][layer * 256 + tid]; }
    HgRaw cur; if (vb < nunit) { const int un = need_ctx ? vb : (vb >> 6) * NC2 + 4 + (vb & 63); int b, h, c, row0, jf, jb; ml_unit(un, b, h, c, row0, jf, jb); hg_load<true>(F, h, row0, tid, cur); }
    for (int u0 = vb; u0 < nunit; u0 += F.G) {
        const int unit = need_ctx ? u0 : (u0 >> 6) * NC2 + 4 + (u0 & 63);
        int b, h, c, row0, jf, jb; ml_unit(unit, b, h, c, row0, jf, jb);
        HgRaw nxt = cur; if (u0 + F.G < nunit) { const int un = need_ctx ? u0 + F.G : ((u0 + F.G) >> 6) * NC2 + 4 + ((u0 + F.G) & 63); int b2, h2, c2, r2, j2, j3; ml_unit(un, b2, h2, c2, r2, j2, j3); hg_load<true>(F, h2, r2, tid, nxt); }
        u32x4 c0raw[2];
#pragma unroll
        for (int dir = 0; dir < 2; ++dir) { const size_t sid = (size_t)(32 + (b * 4 + h) * 2 + dir) * NC2 + (dir == 0 ? jf : jb); c0raw[dir] = *(const GAS u32x4*)(C0M + sid * 4096 + ps * 64 + pc * 8); }
        const u32x4 owraw = *(const GAS u32x4*)(P + (size_t)(row0 + (tid >> 3)) * PW + HG_G + h * 64 + (tid & 7) * 8);
        __syncthreads();
        hg_stage<true>(F, layer, h, cur, tid); cur = nxt;
        const LAS float* LT = (const LAS float*)(F.lds + HG_LT);
        { const int dir = wave >> 2, grp = wave & 3, pl = lane >> 3, kc = lane & 7, n1 = 16 - pl;
            LAS float* AD = (LAS float*)(F.lds + HG_AD) + (dir * 4 + grp) * 256;
            const LAS float* FD = (const LAS float*)(F.lds + HG_QH) + dir * 4096 + kc * 8;
            const int s1 = dir == 0 ? pl : 15 - pl, s2 = 15 - s1;
            const u32x4 kw1 = *(const LAS u32x4*)(F.lds + HG_KK + dir * 8192 + rm_off(16 * grp + s1, kc)), kw2 = *(const LAS u32x4*)(F.lds + HG_KK + dir * 8192 + rm_off(16 * grp + s2, kc));
            float kd[8] = {bf_lo(kw1.x), bf_hi(kw1.x), bf_lo(kw1.y), bf_hi(kw1.y), bf_lo(kw1.z), bf_hi(kw1.z), bf_lo(kw1.w), bf_hi(kw1.w)};
            for (int it = 0; it < 17; ++it) {
                const bool second = it >= n1; const int x = second ? (15 - pl) + (it - n1) : pl + it;
                const int tl = dir == 0 ? x : 15 - x, sl = second ? s2 : s1, tr = 16 * grp + tl;
                const f32x4 fa = *(const LAS f32x4*)(FD + tr * 64), fb = *(const LAS f32x4*)(FD + tr * 64 + 4);
                const u32x4 qw = *(const LAS u32x4*)(F.lds + HG_QR + rm_off(tr, kc));
                kd[0] *= fa.x; kd[1] *= fa.y; kd[2] *= fa.z; kd[3] *= fa.w; kd[4] *= fb.x; kd[5] *= fb.y; kd[6] *= fb.z; kd[7] *= fb.w;
                if (it == 0 || it == n1) { const u32x4 kw = second ? kw2 : kw1;
                    kd[0] = bf_lo(kw.x); kd[1] = bf_hi(kw.x); kd[2] = bf_lo(kw.y); kd[3] = bf_hi(kw.y); kd[4] = bf_lo(kw.z); kd[5] = bf_hi(kw.z); kd[6] = bf_lo(kw.w); kd[7] = bf_hi(kw.w); }
                float sum = (bf_lo(qw.x) * kd[0] + bf_hi(qw.x) * kd[1]) + (bf_lo(qw.y) * kd[2] + bf_hi(qw.y) * kd[3]);
                sum += (bf_lo(qw.z) * kd[4] + bf_hi(qw.z) * kd[5]) + (bf_lo(qw.w) * kd[6] + bf_hi(qw.w) * kd[7]);
                sum = sum8(sum);
                if (kc == 0) AD[tl * 16 + sl] = sum; }
        }
        __syncthreads();
        { const u32x4 qw = *(const LAS u32x4*)(F.lds + HG_QR + rm_off(ps, pc));
            const float q8[8] = {bf_lo(qw.x), bf_hi(qw.x), bf_lo(qw.y), bf_hi(qw.y), bf_lo(qw.z), bf_hi(qw.z), bf_lo(qw.w), bf_hi(qw.w)};
#pragma unroll
            for (int dir = 0; dir < 2; ++dir) { const int grp = ps >> 4; const LAS float* gs = (const LAS float*)(F.lds + HG_GS) + dir * 4096 + ps * 64 + pc * 8;
                const u32x4 kw = *(const LAS u32x4*)(F.lds + HG_KK + dir * 8192 + rm_off(ps, pc));
                const float kk8[8] = {bf_lo(kw.x), bf_hi(kw.x), bf_lo(kw.y), bf_hi(kw.y), bf_lo(kw.z), bf_hi(kw.z), bf_lo(kw.w), bf_hi(kw.w)}; float qo[8], ko[8];
#pragma unroll
                for (int i = 0; i < 8; ++i) { const float gv = gs[i]; qo[i] = q8[i] * fast_exp2(gv); ko[i] = kk8[i] * fast_exp2(LT[(dir * 4 + grp) * 64 + pc * 8 + i] - gv); }
                u32x4 o; o.x = cvt_pk_bf16(qo[0], qo[1]); o.y = cvt_pk_bf16(qo[2], qo[3]); o.z = cvt_pk_bf16(qo[4], qo[5]); o.w = cvt_pk_bf16(qo[6], qo[7]);
                *(LAS u32x4*)(F.lds + HG_QH + dir * 8192 + rm_off(ps, pc)) = o;
                o.x = cvt_pk_bf16(ko[0], ko[1]); o.y = cvt_pk_bf16(ko[2], ko[3]); o.z = cvt_pk_bf16(ko[4], ko[5]); o.w = cvt_pk_bf16(ko[6], ko[7]);
                *(LAS u32x4*)(F.lds + HG_KH + dir * 8192 + rm_off(ps, pc)) = o;
                *(LAS u32x4*)(F.lds + HG_C0 + dir * 8192 + rm_off(ps, pc)) = c0raw[dir]; } }
        __syncthreads();
        { const int dir = wave >> 2, isub = wave & 3;
#define HG_GRP(j) (dir == 0 ? (j) : 3 - (j))
            const int gt_ = HG_GRP(isub); const int tt = 16 * gt_ + l16;
            const LAS float* LTd = LT + dir * 256;
            bf16x8 qh[2];
#pragma unroll
            for (int k2 = 0; k2 < 2; ++k2) qh[k2] = *(const LAS bf16x8*)(F.lds + HG_QH + dir * 8192 + rm_off(tt, 4 * k2 + g4));
            f32x4 S[4];
#pragma unroll
            for (int j = 0; j < 4; ++j) { S[j] = (f32x4){0.f, 0.f, 0.f, 0.f};
                if (j < isub) { const int gsrc = HG_GRP(j); const int ts = 16 * gsrc + l16; const int nd = isub - j - 1;
#pragma unroll
                    for (int k2 = 0; k2 < 2; ++k2) { const bf16x8 ka = *(const LAS bf16x8*)(F.lds + HG_KH + dir * 8192 + rm_off(ts, 4 * k2 + g4));
                        const int ko = 32 * k2 + 8 * g4;
                        const bf16x8 qb = nd == 0 ? qh[k2] : scale_frag(qh[k2], LTd + HG_GRP(j + 1) * 64 + ko, LTd + HG_GRP(j + 2 > 3 ? 3 : j + 2) * 64 + ko, LTd, nd);
                        S[j] = mfma16(ka, qb, S[j]); }
                } else if (j == isub) { const f32x4 ad = *(const LAS f32x4*)((const LAS float*)(F.lds + HG_AD) + (dir * 4 + gt_) * 256 + l16 * 16 + 4 * g4);
#pragma unroll
                    for (int r = 0; r < 4; ++r) { const int sl = 4 * g4 + r; const bool ok = dir == 0 ? (sl <= l16) : (sl >= l16); S[j][r] = ok ? ad[r] : 0.f; } }
            }
            f32x4 O[4];
#pragma unroll
            for (int et = 0; et < 4; ++et) O[et] = (f32x4){0.f, 0.f, 0.f, 0.f};
#pragma unroll
            for (int pr2 = 0; pr2 < 2; ++pr2) { if (2 * pr2 <= isub) {
                u32x4 pw; pw.x = cvt_pk_bf16(S[2 * pr2][0], S[2 * pr2][1]); pw.y = cvt_pk_bf16(S[2 * pr2][2], S[2 * pr2][3]); pw.z = cvt_pk_bf16(S[2 * pr2 + 1][0], S[2 * pr2 + 1][1]); pw.w = cvt_pk_bf16(S[2 * pr2 + 1][2], S[2 * pr2 + 1][3]);
                const bf16x8 pa = __builtin_bit_cast(bf16x8, pw);
                const int ra = 16 * HG_GRP(2 * pr2) + 4 * g4 + (l16 >> 2), rb = 16 * HG_GRP(2 * pr2 + 1) + 4 * g4 + (l16 >> 2);
#pragma unroll
                for (int et = 0; et < 4; ++et) { const int cb = 16 * et + 4 * (l16 & 3); const int co = (cb >> 5) * 4096 + (cb & 31) * 2;
                    const s16x4 lo = __builtin_bit_cast(s16x4, __builtin_amdgcn_ds_read_tr16_b64_v4i16((LAS s16x4*)(F.lds + HG_VI + co + ra * 64)));
                    const s16x4 hh = __builtin_bit_cast(s16x4, __builtin_amdgcn_ds_read_tr16_b64_v4i16((LAS s16x4*)(F.lds + HG_VI + co + rb * 64)));
                    const bf16x8 vf = {lo[0], lo[1], lo[2], lo[3], hh[0], hh[1], hh[2], hh[3]};
                    O[et] = mfma16(pa, vf, O[et]); } } }
            { const size_t si = (size_t)(32 + (b * 4 + h) * 2 + dir) * NC2 + (dir == 0 ? jf : jb);
#pragma unroll
                for (int k2 = 0; k2 < 2; ++k2) { const int ko = 32 * k2 + 8 * g4;
                    const bf16x8 qi = isub == 0 ? qh[k2] : scale_frag(qh[k2], LTd + HG_GRP(0) * 64 + ko, LTd + HG_GRP(1) * 64 + ko, LTd + HG_GRP(2) * 64 + ko, isub);
#pragma unroll
                    for (int et = 0; et < 4; ++et) { const bf16x8 cb = *(const LAS bf16x8*)(F.lds + HG_C0 + dir * 8192 + rm_off(16 * et + l16, 4 * k2 + g4));
                        O[et] = mfma16(qi, cb, O[et]); } } }
            LAS float* Hx = (LAS float*)(F.lds + HG_GS);
#pragma unroll
            for (int et = 0; et < 4; ++et)
#pragma unroll
                for (int r = 0; r < 4; ++r) Hx[(dir * 64 + 16 * gt_ + 4 * g4 + r) * 64 + 16 * et + l16] = O[et][r];
#undef HG_GRP
        }
        __syncthreads();
        { const int t = tid >> 3, e8 = (tid & 7) * 8; const LAS float* Hx = (const LAS float*)(F.lds + HG_GS); float v[8]; float ss = 0.f;
            const f32x4 a0 = *(const LAS f32x4*)(Hx + t * 64 + e8), a1 = *(const LAS f32x4*)(Hx + t * 64 + e8 + 4), b0 = *(const LAS f32x4*)(Hx + (64 + t) * 64 + e8), b1 = *(const LAS f32x4*)(Hx + (64 + t) * 64 + e8 + 4);
            v[0] = a0.x + b0.x; v[1] = a0.y + b0.y; v[2] = a0.z + b0.z; v[3] = a0.w + b0.w; v[4] = a1.x + b1.x; v[5] = a1.y + b1.y; v[6] = a1.z + b1.z; v[7] = a1.w + b1.w;
#pragma unroll
            for (int i = 0; i < 8; ++i) ss += v[i] * v[i];
            ss = sum8(ss);
            const float rs = 1.0f / sqrtf(ss * (1.0f / 64.0f) + EPS);
            const u32x4 ow = owraw;
            const float og[8] = {bf_lo(ow.x), bf_hi(ow.x), bf_lo(ow.y), bf_hi(ow.y), bf_lo(ow.z), bf_hi(ow.z), bf_lo(ow.w), bf_hi(ow.w)};
            const LAS float* nwp = (const LAS float*)(F.lds + 129024) + h * 64 + e8; const f32x4 nwa = *(const LAS f32x4*)nwp, nwb = *(const LAS f32x4*)(nwp + 4);
            const float nw[8] = {nwa.x, nwa.y, nwa.z, nwa.w, nwb.x, nwb.y, nwb.z, nwb.w}; float o[8];
#pragma unroll
            for (int i = 0; i < 8; ++i) o[i] = v[i] * rs * nw[i] * siluf_(og[i]);
            u32x4 w; w.x = cvt_pk_bf16(o[0], o[1]); w.y = cvt_pk_bf16(o[2], o[3]); w.z = cvt_pk_bf16(o[4], o[5]); w.w = cvt_pk_bf16(o[6], o[7]);
            *(GAS u32x4*)(MIX + (size_t)(row0 + t) * D + 256 + h * 64 + e8) = w; }
    }
    __syncthreads();
}
__device__ __forceinline__ void finish_phase(Frame& F, int layer, int nrows) {
    PHASE_TID();
    const bf16_t* P = (const bf16_t*)(F.ws + WS_P); const float* SCR = (const float*)(F.ws + WS_SCR); bf16_t* MIX = (bf16_t*)(F.ws + WS_MIX);
    const int gw = F.bid * NWAVES + wave, NGW = F.G * NWAVES, c0 = 4 * lane;
    for (int row = gw; row < nrows; row += NGW) {
#pragma unroll
        for (int kind = 1; kind < 2; ++kind) {
            const f32x4 a = *(const GAS f32x4*)(SCR + ((size_t)(kind * 2 + 0) * ROWS + row) * 256 + c0), bq = *(const GAS f32x4*)(SCR + ((size_t)(kind * 2 + 1) * ROWS + row) * 256 + c0);
            const f32x4 v = a + bq; float ss = (v.x * v.x + v.y * v.y) + (v.z * v.z + v.w * v.w);
            ss = sum16(ss);
            const float r = 1.0f / sqrtf(ss * (1.0f / 64.0f) + EPS);
            const f32x4 w = *(const GAS f32x4*)(F.a->in[kind == 0 ? I_MLNORM : I_HGNORM] + layer * 256 + c0);
            const u32x2 gw2 = *(const GAS u32x2*)(P + (size_t)row * PW + (kind == 0 ? ML_O : HG_G) + c0);
            const f32x4 gr = {bf_lo(gw2.x), bf_hi(gw2.x), bf_lo(gw2.y), bf_hi(gw2.y)}; f32x4 o;
#pragma unroll
            for (int j = 0; j < 4; ++j) { const float gt = kind == 0 ? sigmoidf_(gr[j]) : siluf_(gr[j]); o[j] = v[j] * r * w[j] * gt; }
            u32x2 ow; ow.x = cvt_pk_bf16(o[0], o[1]); ow.y = cvt_pk_bf16(o[2], o[3]);
            *(GAS u32x2*)(MIX + (size_t)row * D + kind * 256 + c0) = ow;
        }
    }
}
#if 0
__device__ __forceinline__ void attn_naive_phase(Frame& F, int layer, bool need_ctx) {
    PHASE_TID();
    const bf16_t* P = (const bf16_t*)(F.ws + WS_P); bf16_t* MIX = (bf16_t*)(F.ws + WS_MIX);
    LAS float* Kt = (LAS float*)F.lds;
    LAS float* Vt = (LAS float*)(F.lds + 32 * 136 * 4);
    const float lam = ((const float*)(F.ws + WS_SMALL + SM_CONST))[layer * 4 + 0], lam_init = ((const float*)(F.ws + WS_SMALL + SM_CONST))[layer * 4 + 1];
    const int ql = tid >> 2, s = (tid >> 1) & 1, hf = tid & 1;
    const int nu = 512 + (need_ctx ? 32 : 0);
    for (int u = F.bid; u < nu; u += F.G) {
        int b, h, qrow0, k0, nk;
        if (u < 512) { const int bh = u >> 5, qb = u & 31; b = bh >> 2; h = bh & 3; qrow0 = b * SEQ + qb * 128; k0 = 0; nk = NKEYS; }
        else { const int bh = (u - 512) >> 1, qb = (u - 512) & 1; b = bh >> 2; h = bh & 3; qrow0 = NLAT + b * CTXL + qb * 128; k0 = SEQ; nk = CTXL; }
        const int row = qrow0 + ql;
        unsigned qp[32];
        { const bf16_t* qptr = P + (size_t)row * PW + DA_Q + h * 128 + s * 64;
#pragma unroll
            for (int i = 0; i < 8; ++i) { const u32x4 w = *(const GAS u32x4*)(qptr + 8 * i); qp[4 * i] = w.x; qp[4 * i + 1] = w.y; qp[4 * i + 2] = w.z; qp[4 * i + 3] = w.w; } }
        const int skey = tid >> 4, sch = tid & 15;
        float mx = -3.0e38f;
        for (int t0 = 0; t0 < nk; t0 += 32) {
            __syncthreads();
            { const int kidx = k0 + t0 + skey; const int krow = kidx < SEQ ? b * SEQ + kidx : NLAT + b * CTXL + (kidx - SEQ);
                const u32x4 w = *(const GAS u32x4*)(P + (size_t)krow * PW + DA_K + h * 128 + sch * 8);
                LAS float* d = Kt + skey * 136 + (sch >> 3) * 68 + (sch & 7) * 8;
                *(LAS f32x4*)d = (f32x4){bf_lo(w.x), bf_hi(w.x), bf_lo(w.y), bf_hi(w.y)}; *(LAS f32x4*)(d + 4) = (f32x4){bf_lo(w.z), bf_hi(w.z), bf_lo(w.w), bf_hi(w.w)}; }
            __syncthreads();
            for (int j = 0; j < 32; ++j) { const LAS float* kr = Kt + j * 136 + s * 68; float d0 = 0.f, d1 = 0.f;
#pragma unroll
                for (int i = 0; i < 16; i += 2) { const f32x4 ka = *(const LAS f32x4*)(kr + 4 * i), kb = *(const LAS f32x4*)(kr + 4 * i + 4);
                    d0 += (bf_lo(qp[2 * i]) * ka.x + bf_hi(qp[2 * i]) * ka.y) + (bf_lo(qp[2 * i + 1]) * ka.z + bf_hi(qp[2 * i + 1]) * ka.w);
                    d1 += (bf_lo(qp[2 * i + 2]) * kb.x + bf_hi(qp[2 * i + 2]) * kb.y) + (bf_lo(qp[2 * i + 3]) * kb.z + bf_hi(qp[2 * i + 3]) * kb.w); }
                mx = fmaxf(mx, d0 + d1); }
        }
        float acc[64];
#pragma unroll
        for (int i = 0; i < 64; ++i) acc[i] = 0.f;
        float lsum = 0.f;
        for (int t0 = 0; t0 < nk; t0 += 32) {
            __syncthreads();
            { const int kidx = k0 + t0 + skey; const int krow = kidx < SEQ ? b * SEQ + kidx : NLAT + b * CTXL + (kidx - SEQ);
                const u32x4 w = *(const GAS u32x4*)(P + (size_t)krow * PW + DA_K + h * 128 + sch * 8);
                LAS float* d = Kt + skey * 136 + (sch >> 3) * 68 + (sch & 7) * 8;
                *(LAS f32x4*)d = (f32x4){bf_lo(w.x), bf_hi(w.x), bf_lo(w.y), bf_hi(w.y)}; *(LAS f32x4*)(d + 4) = (f32x4){bf_lo(w.z), bf_hi(w.z), bf_lo(w.w), bf_hi(w.w)};
                const u32x4 wv = *(const GAS u32x4*)(P + (size_t)krow * PW + DA_V + h * 128 + sch * 8);
                LAS float* dv = Vt + skey * 136 + (sch >> 3) * 68 + (sch & 7) * 8;
                *(LAS f32x4*)dv = (f32x4){bf_lo(wv.x), bf_hi(wv.x), bf_lo(wv.y), bf_hi(wv.y)}; *(LAS f32x4*)(dv + 4) = (f32x4){bf_lo(wv.z), bf_hi(wv.z), bf_lo(wv.w), bf_hi(wv.w)}; }
            __syncthreads();
            for (int j = 0; j < 32; ++j) { const LAS float* kr = Kt + j * 136 + s * 68; float d0 = 0.f, d1 = 0.f;
#pragma unroll
                for (int i = 0; i < 16; i += 2) { const f32x4 ka = *(const LAS f32x4*)(kr + 4 * i), kb = *(const LAS f32x4*)(kr + 4 * i + 4);
                    d0 += (bf_lo(qp[2 * i]) * ka.x + bf_hi(qp[2 * i]) * ka.y) + (bf_lo(qp[2 * i + 1]) * ka.z + bf_hi(qp[2 * i + 1]) * ka.w);
                    d1 += (bf_lo(qp[2 * i + 2]) * kb.x + bf_hi(qp[2 * i + 2]) * kb.y) + (bf_lo(qp[2 * i + 3]) * kb.z + bf_hi(qp[2 * i + 3]) * kb.w); }
                const float p = fast_exp2((d0 + d1) - mx); lsum += p;
                const LAS float* vr = Vt + j * 136 + hf * 68;
#pragma unroll
                for (int i = 0; i < 16; ++i) { const f32x4 v4 = *(const LAS f32x4*)(vr + 4 * i); acc[4 * i] += p * v4.x; acc[4 * i + 1] += p * v4.y; acc[4 * i + 2] += p * v4.z; acc[4 * i + 3] += p * v4.w; } }
        }
        const float inv = 1.0f / lsum; float ss = 0.f;
#pragma unroll
        for (int i = 0; i < 64; ++i) { const float o = acc[i] * inv; const float other = __shfl_xor(o, 2); acc[i] = o - lam * other; ss += acc[i] * acc[i]; }
        ss += __shfl_xor(ss, 1);
        if (s == 0) { const float r = (1.0f - lam_init) / sqrtf(ss * (1.0f / 128.0f) + EPS); const float* nw = F.a->in[I_DANORM] + layer * 128 + hf * 64;
            bf16_t* op = MIX + (size_t)row * D + 512 + h * 128 + hf * 64;
#pragma unroll
            for (int i = 0; i < 8; ++i) { u32x4 w; w.x = cvt_pk_bf16(acc[8 * i] * r * nw[8 * i], acc[8 * i + 1] * r * nw[8 * i + 1]); w.y = cvt_pk_bf16(acc[8 * i + 2] * r * nw[8 * i + 2], acc[8 * i + 3] * r * nw[8 * i + 3]);
                w.z = cvt_pk_bf16(acc[8 * i + 4] * r * nw[8 * i + 4], acc[8 * i + 5] * r * nw[8 * i + 5]); w.w = cvt_pk_bf16(acc[8 * i + 6] * r * nw[8 * i + 6], acc[8 * i + 7] * r * nw[8 * i + 7]);
                *(GAS u32x4*)(op + 8 * i) = w; } }
    }
    __syncthreads();
}

#endif
__device__ __forceinline__ void glds16s(const void* sbase, unsigned voff, unsigned lds_dst) { unsigned keep;
    asm volatile("s_mov_b32 %0, m0\n\ts_mov_b32 m0, %3\n\ts_nop 0\n\tglobal_load_lds_dwordx4 %1, %2\n\ts_mov_b32 m0, %0" : "=&s"(keep) : "v"(voff), "s"(sbase), "s"(lds_dst) : "memory"); }
__device__ __forceinline__ void glds16(const void* gsrc, unsigned lds_dst) { unsigned keep;
    asm volatile("s_mov_b32 %0, m0\n\ts_mov_b32 m0, %2\n\ts_nop 0\n\tglobal_load_lds_dwordx4 %1, off\n\ts_mov_b32 m0, %0" : "=&s"(keep) : "v"(gsrc), "s"(lds_dst) : "memory"); }
constexpr int CW_KMAX = 12288;
__device__ __forceinline__ void kmax_phase(Frame& F, int layer) {
    PHASE_TID();
    const bf16_t* P = (const bf16_t*)(F.ws + WS_P);
    LAS float* red = (LAS float*)(F.lds);
    for (int it = F.bid; it < 256; it += F.G) {
        const int bhs = it >> 3, sl = it & 7, b = bhs >> 3, h = (bhs >> 1) & 3, sub = bhs & 1;
        float mx = 0.f;
        for (int k0 = sl * 544; k0 < sl * 544 + 544; k0 += 64) {
            const int key = k0 + (tid >> 3), ch = tid & 7;
            const int krow = key < SEQ ? b * SEQ + key : NLAT + b * CTXL + (key - SEQ);
            float ss = 0.f;
            if (key < sl * 544 + 544) { const u32x4 w = *(const GAS u32x4*)(P + (size_t)krow * PW + DA_K + h * 128 + sub * 64 + ch * 8);
                const float a0 = bf_lo(w.x), a1 = bf_hi(w.x), a2 = bf_lo(w.y), a3 = bf_hi(w.y), a4 = bf_lo(w.z), a5 = bf_hi(w.z), a6 = bf_lo(w.w), a7 = bf_hi(w.w);
                ss = ((a0 * a0 + a1 * a1) + (a2 * a2 + a3 * a3)) + ((a4 * a4 + a5 * a5) + (a6 * a6 + a7 * a7)); }
            ss = sum8(ss);
            mx = fmaxf(mx, ss);
        }
#pragma unroll
        for (int o = 8; o < 64; o <<= 1) mx = fmaxf(mx, __shfl_xor(mx, o));
        if (lane == 0) red[wave] = mx;
        __syncthreads();
        if (tid == 0) { float m = red[0];
#pragma unroll
            for (int w = 1; w < 8; ++w) m = fmaxf(m, red[w]);
            atomicMax(F.ctl + CW_KMAX + layer * 64 + bhs, __float_as_uint(m)); }
        __syncthreads();
    }
}
__device__ __forceinline__ void attn_phase(Frame& F, int layer, bool need_ctx) {
    PHASE_TID();
    const bf16_t* P = (const bf16_t*)(F.ws + WS_P); bf16_t* MIX = (bf16_t*)(F.ws + WS_MIX);
    const float lam = ((const float*)(F.ws + WS_SMALL + SM_CONST))[layer * 4 + 0], lam_init = ((const float*)(F.ws + WS_SMALL + SM_CONST))[layer * 4 + 1];
    const int r32 = lane & 31, hi = lane >> 5, sub = wave & 1, rg = wave >> 1;
    LAS unsigned char* Kb = F.lds;
    LAS unsigned char* Vb = F.lds + 16384;
    const unsigned ldsb = (unsigned)(size_t)F.lds;
    LAS float* Xb = (LAS float*)(F.lds);
    const int krd = r32 * 256, kx = r32 & 15;
    const int vrd = ((lane >> 4) & 1) * 32 + (lane & 3) * 8 + (4 * hi + ((lane & 15) >> 2)) * 64;
    unsigned voK[2], voV[2];
#pragma unroll
    for (int i_ = 0; i_ < 2; ++i_) { const int rowk = 4 * (2 * wave + i_) + (lane >> 4), chk = (lane & 15) ^ (rowk & 15); voK[i_] = (unsigned)((rowk * PW + chk * 8) * 2);
        const int j_ = 2 * wave + i_, rowv = 16 * (j_ & 3) + (lane >> 2), colv = (j_ >> 2) * 32 + (lane & 3) * 8; voV[i_] = (unsigned)((rowv * PW + colv) * 2); }
    const int nu = 512 + (need_ctx ? 32 : 0);
    if (wave >= 4) __builtin_amdgcn_s_setprio(1);
    for (int i = 0;; ++i) {
        int u = i * F.G + ((i >= 2 && F.G == 256) ? ((F.bid + 64) & 255) : F.bid); if (u >= nu) break;
        int b, h, qrow0, t0, t1;
        if (u < 512) { int bh, qb; if (F.G == 256) { bh = (F.bid & 7) * 2 + i; qb = F.bid >> 3; } else { bh = u >> 5; qb = u & 31; }
            b = bh >> 2; h = bh & 3; qrow0 = b * SEQ + qb * 128; t0 = 0; t1 = NKEYS / 64; }
        else { const int bh = (u - 512) >> 1, qb = (u - 512) & 1; b = bh >> 2; h = bh & 3; qrow0 = NLAT + b * CTXL + qb * 128; t0 = SEQ / 64; t1 = NKEYS / 64; }
        const int row = qrow0 + rg * 32 + r32;
        bf16x8 qf[4]; float qn2 = 0.f;
        { const bf16_t* qp = P + (size_t)row * PW + DA_Q + h * 128 + sub * 64 + hi * 8;
#pragma unroll
            for (int ks = 0; ks < 4; ++ks) { const u32x4 w = *(const GAS u32x4*)(qp + 16 * ks); qf[ks] = __builtin_bit_cast(bf16x8, w);
                const float a0 = bf_lo(w.x), a1 = bf_hi(w.x), a2 = bf_lo(w.y), a3 = bf_hi(w.y), a4 = bf_lo(w.z), a5 = bf_hi(w.z), a6 = bf_lo(w.w), a7 = bf_hi(w.w);
                qn2 += ((a0 * a0 + a1 * a1) + (a2 * a2 + a3 * a3)) + ((a4 * a4 + a5 * a5) + (a6 * a6 + a7 * a7)); } }
        qn2 += __shfl_xor(qn2, 32);
        const float kmax2 = __uint_as_float(__hip_atomic_load(F.ctl + CW_KMAX + layer * 64 + (b * 4 + h) * 2 + sub, RLX_AGENT));
        const float nm = -(sqrtf(qn2 * kmax2) * 1.001f + 1e-20f);
        f32x16 O[4], NM16; float ls0 = 0.f, ls1 = 0.f;
#pragma unroll
        for (int r = 0; r < 16; ++r) { O[0][r] = 0.f; O[1][r] = 0.f; O[2][r] = 0.f; O[3][r] = 0.f; NM16[r] = nm; }
        asm volatile("" : "+v"(NM16));
#define ATT_TROW(t) ((t) < SEQ / 64 ? b * SEQ + (t) * 64 : NLAT + b * CTXL + ((t) - SEQ / 64) * 64)
#define ATT_DMAK(t, buf) do { const bf16_t* pk_ = P + (size_t)ATT_TROW(t) * PW + DA_K + h * 128; \
        _Pragma("unroll") for (int i_ = 0; i_ < 2; ++i_) glds16s(pk_, voK[i_], (unsigned)__builtin_amdgcn_readfirstlane((int)(ldsb + (buf) * 32768 + (2 * wave + i_) * 1024))); } while (0)
#define ATT_DMAV(t, buf) do { const bf16_t* pv_ = P + (size_t)ATT_TROW(t) * PW + DA_V + h * 128; \
        _Pragma("unroll") for (int i_ = 0; i_ < 2; ++i_) glds16s(pv_, voV[i_], (unsigned)__builtin_amdgcn_readfirstlane((int)(ldsb + 16384 + (buf) * 32768 + (2 * wave + i_) * 1024))); } while (0)
#define ATT_QK(SA, SB, buf) do { const LAS unsigned char* kb_ = Kb + (buf) * 32768 + krd; bf16x8 kf_[8]; \
        _Pragma("unroll") for (int ks = 0; ks < 4; ++ks) { const int co = ((sub * 8 + 2 * ks + hi) ^ kx) << 4; kf_[2 * ks] = *(const LAS bf16x8*)(kb_ + co); kf_[2 * ks + 1] = *(const LAS bf16x8*)(kb_ + 32 * 256 + co); } \
        __builtin_amdgcn_sched_barrier(0);     \
        __builtin_amdgcn_s_setprio(2); SA = mfma32(kf_[0], qf[0], NM16); SB = mfma32(kf_[1], qf[0], NM16);     \
        _Pragma("unroll") for (int ks = 1; ks < 4; ++ks) { SA = mfma32(kf_[2 * ks], qf[ks], SA); SB = mfma32(kf_[2 * ks + 1], qf[ks], SB); } if (wave >= 4) __builtin_amdgcn_s_setprio(1); else __builtin_amdgcn_s_setprio(0); } while (0)
#define ATT_STEP(CA, CB, t) do { const int cur = ((t) - t0) % 3, nx2 = ((t) + 2 - t0) % 3; \
        if ((t) + 2 < t1) { ATT_DMAK((t) + 2, nx2); ATT_DMAV((t) + 2, nx2); if (ATT_DBL & 8) { ATT_DMAK((t) + 2, nx2); ATT_DMAV((t) + 2, nx2); } } \
        f32x16 CA, CB; ATT_QK(CA, CB, cur); if (ATT_DBL & 1) { ATT_QK(CA, CB, cur); } \
        bf16x8 pf[4]; \
        _Pragma("unroll") for (int s2 = 0; s2 < 2; ++s2) { u32x4 w0, w1; \
            w0.x = cvtpk_s(fast_exp2(CA[8 * s2 + 0]), fast_exp2(CA[8 * s2 + 1])); w0.y = cvtpk_s(fast_exp2(CA[8 * s2 + 2]), fast_exp2(CA[8 * s2 + 3])); \
            w0.z = cvtpk_s(fast_exp2(CA[8 * s2 + 4]), fast_exp2(CA[8 * s2 + 5])); w0.w = cvtpk_s(fast_exp2(CA[8 * s2 + 6]), fast_exp2(CA[8 * s2 + 7])); \
            w1.x = cvtpk_s(fast_exp2(CB[8 * s2 + 0]), fast_exp2(CB[8 * s2 + 1])); w1.y = cvtpk_s(fast_exp2(CB[8 * s2 + 2]), fast_exp2(CB[8 * s2 + 3])); \
            w1.z = cvtpk_s(fast_exp2(CB[8 * s2 + 4]), fast_exp2(CB[8 * s2 + 5])); w1.w = cvtpk_s(fast_exp2(CB[8 * s2 + 6]), fast_exp2(CB[8 * s2 + 7])); \
            ls0 = dot2_ones(w0.x, ls0); ls1 = dot2_ones(w1.x, ls1); ls0 = dot2_ones(w0.y, ls0); ls1 = dot2_ones(w1.y, ls1); \
            ls0 = dot2_ones(w0.z, ls0); ls1 = dot2_ones(w1.z, ls1); ls0 = dot2_ones(w0.w, ls0); ls1 = dot2_ones(w1.w, ls1);     \
            pf[s2] = __builtin_bit_cast(bf16x8, w0); pf[2 + s2] = __builtin_bit_cast(bf16x8, w1); } \
        const LAS unsigned char* vb_ = Vb + cur * 32768 + vrd; \
        bf16x8 vfa_[4], vfb_[4]; \
        _Pragma("unroll") for (int blk = 0; blk < 4; ++blk) vfa_[blk] = tr_frag(vb_ + blk * 4096); \
        _Pragma("unroll") for (int blk = 0; blk < 4; ++blk) vfb_[blk] = tr_frag(vb_ + blk * 4096 + 1024); \
        __builtin_amdgcn_sched_barrier(0); \
        __builtin_amdgcn_s_setprio(2); \
        _Pragma("unroll") for (int blk = 0; blk < 4; ++blk) O[blk] = mfma32(pf[0], vfa_[blk], O[blk]); \
        _Pragma("unroll") for (int blk = 0; blk < 4; ++blk) vfa_[blk] = tr_frag(vb_ + blk * 4096 + 2048); \
        __builtin_amdgcn_sched_barrier(0); \
        _Pragma("unroll") for (int blk = 0; blk < 4; ++blk) O[blk] = mfma32(pf[1], vfb_[blk], O[blk]); \
        _Pragma("unroll") for (int blk = 0; blk < 4; ++blk) vfb_[blk] = tr_frag(vb_ + blk * 4096 + 3072); \
        __builtin_amdgcn_sched_barrier(0); \
        _Pragma("unroll") for (int blk = 0; blk < 4; ++blk) O[blk] = mfma32(pf[2], vfa_[blk], O[blk]); \
        _Pragma("unroll") for (int blk = 0; blk < 4; ++blk) O[blk] = mfma32(pf[3], vfb_[blk], O[blk]); \
        if (wave >= 4) __builtin_amdgcn_s_setprio(1); else __builtin_amdgcn_s_setprio(0); \
        if ((t) + 2 < t1) { if (ATT_DBL & 8) asm volatile("s_waitcnt vmcnt(8) lgkmcnt(0)" ::: "memory"); else asm volatile("s_waitcnt vmcnt(4) lgkmcnt(0)" ::: "memory"); } else asm volatile("s_waitcnt vmcnt(0) lgkmcnt(0)" ::: "memory"); \
        __builtin_amdgcn_s_barrier(); asm volatile("" ::: "memory"); } while (0)
        __syncthreads();
        ATT_DMAK(t0, 0); ATT_DMAV(t0, 0); ATT_DMAK(t0 + 1, 1); ATT_DMAV(t0 + 1, 1);
        asm volatile("s_waitcnt vmcnt(4)" ::: "memory"); __builtin_amdgcn_s_barrier(); asm volatile("" ::: "memory");
        for (int t = t0; t < t1; ++t) { ATT_STEP(sa_, sb_, t); }
#undef ATT_TROW
#undef ATT_DMAK
#undef ATT_DMAV
#undef ATT_QK
#undef ATT_STEP
        { float lsum = ls0 + ls1; lsum += __shfl_xor(lsum, 32);
            LAS float* lw = (LAS float*)(F.lds + 65536) + wave * 32;
            if (hi == 0) lw[r32] = 1.0f / lsum;
            asm volatile("s_waitcnt lgkmcnt(0)" ::: "memory");
#pragma unroll
            for (int g = 0; g < 4; ++g) { const f32x4 iv = *(const LAS f32x4*)(lw + 8 * g + 4 * hi);
#pragma unroll
                for (int j = 0; j < 4; ++j) { const float inv = iv[j]; O[0][4 * g + j] *= inv; O[1][4 * g + j] *= inv; O[2][4 * g + j] *= inv; O[3][4 * g + j] *= inv; } } }
        LAS float* xw = Xb + rg * 4096 + lane;
        if (sub == 1) {
#pragma unroll
            for (int blk = 0; blk < 4; ++blk)
#pragma unroll
                for (int r = 0; r < 16; ++r) xw[(blk * 16 + r) * 64] = O[blk][r];
        }
        __syncthreads();
        if (sub == 0) {
            const float* nw = F.a->in[I_DANORM] + layer * 128 + r32;
            const float w0 = nw[0], w1 = nw[32], w2 = nw[64], w3 = nw[96];
#pragma unroll
            for (int r = 0; r < 16; ++r) {
                const float d0 = O[0][r] - lam * xw[(0 * 16 + r) * 64], d1 = O[1][r] - lam * xw[(1 * 16 + r) * 64], d2 = O[2][r] - lam * xw[(2 * 16 + r) * 64], d3 = O[3][r] - lam * xw[(3 * 16 + r) * 64];
                float ss = (d0 * d0 + d1 * d1) + (d2 * d2 + d3 * d3);
                ss = sum32(ss);
                const float sc2 = (1.0f - lam_init) / sqrtf(ss * (1.0f / 128.0f) + EPS);
                const int qr = (r & 3) + 8 * (r >> 2) + 4 * hi;
                bf16_t* op = MIX + (size_t)(qrow0 + rg * 32 + qr) * D + 512 + h * 128 + r32;
                op[0] = (bf16_t)(cvt_pk_bf16(d0 * sc2 * w0, 0.f) & 0xffffu); op[32] = (bf16_t)(cvt_pk_bf16(d1 * sc2 * w1, 0.f) & 0xffffu);
                op[64] = (bf16_t)(cvt_pk_bf16(d2 * sc2 * w2, 0.f) & 0xffffu); op[96] = (bf16_t)(cvt_pk_bf16(d3 * sc2 * w3, 0.f) & 0xffffu);
            }
        }
    }
    __builtin_amdgcn_s_setprio(0);
    __syncthreads();
}

__device__ __forceinline__ void gates_gemm_phase(Frame& F, int layer) {
    PHASE_TID();
    const bf16_t* HN = (const bf16_t*)(F.ws + WS_HN); const bf16_t* WG = (const bf16_t*)(F.ws + WS_SMALL + SM_WGATE) + (size_t)layer * 16 * D; float* G = (float*)(F.ws + WS_GATES);
    const int l16 = lane & 15, g4 = lane >> 4;
    for (int item = (F.G - 1 - F.bid) * NWAVES + wave; item < ROWS / 16; item += F.G * NWAVES) {
        const int row0 = item * 16;
        const bf16_t* ap = HN + (size_t)(row0 + l16) * D + 8 * g4; const bf16_t* bp = WG + (size_t)l16 * D + 8 * g4;
        f32x4 acc0 = (f32x4){0.f, 0.f, 0.f, 0.f}; asm volatile("" : "+v"(acc0));
        for (int kb = 0; kb < D; kb += 512) {
            u32x4 ra0[16], rb[16];
#pragma unroll
            for (int j = 0; j < 16; ++j) { ra0[j] = *(const GAS u32x4*)(ap + kb + 32 * j); rb[j] = *(const GAS u32x4*)(bp + kb + 32 * j); }
#pragma unroll
            for (int j = 0; j < 16; j += 2) { const bf16x8 a0 = __builtin_bit_cast(bf16x8, ra0[j]), b0 = __builtin_bit_cast(bf16x8, rb[j]), a1 = __builtin_bit_cast(bf16x8, ra0[j + 1]), b1 = __builtin_bit_cast(bf16x8, rb[j + 1]);
                asm volatile("s_nop 1\n\tv_mfma_f32_16x16x32_bf16 %0, %1, %2, %0\n\tv_mfma_f32_16x16x32_bf16 %0, %3, %4, %0\n\ts_nop 7\n\ts_nop 7" : "+v"(acc0) : "v"(a0), "v"(b0), "v"(a1), "v"(b1)); }
        }
#pragma unroll
        for (int r = 0; r < 4; ++r) G[(size_t)(row0 + 4 * g4 + r) * 16 + l16] = acc0[r];
    }
}

template <int K>
__device__ __forceinline__ void ctx_gemm_phase(Frame& F, const bf16_t* A, const bf16_t* Bt, bf16_t* C) {
    PHASE_TID();
    LAS float* part = (LAS float*)F.lds;
    const int l16 = lane & 15, g4 = lane >> 4; constexpr int kw = K >> 3;
    for (int tile = F.bid; tile < 256; tile += F.G) {
        const int tm = tile >> 4, tn = tile & 15;
        const bf16_t* ap = A + (size_t)(tm * 64 + l16) * K + wave * kw + 8 * g4;
        const bf16_t* bp = Bt + (size_t)(tn * 64 + l16) * K + wave * kw + 8 * g4;
        f32x4 acc[4][4];
#pragma unroll
        for (int m = 0; m < 4; ++m)
#pragma unroll
            for (int n = 0; n < 4; ++n) { acc[m][n] = (f32x4){0.f, 0.f, 0.f, 0.f}; asm volatile("" : "+v"(acc[m][n])); }
        constexpr int NS = kw / 32, BS = 2;
#pragma unroll
        for (int s0 = 0; s0 < NS; s0 += BS) {
            asm volatile("" ::: "memory");
            u32x4 ra[BS][4], rb[BS][4];
#pragma unroll
            for (int j = 0; j < BS; ++j) if (s0 + j < NS) {
#pragma unroll
                for (int m = 0; m < 4; ++m) { ra[j][m] = *(const GAS u32x4*)(ap + (size_t)(16 * m) * K + 32 * (s0 + j)); rb[j][m] = *(const GAS u32x4*)(bp + (size_t)(16 * m) * K + 32 * (s0 + j)); } }
#pragma unroll
            for (int j = 0; j < BS; ++j) if (s0 + j < NS) {
                bf16x8 a[4], b[4];
#pragma unroll
                for (int m = 0; m < 4; ++m) { a[m] = __builtin_bit_cast(bf16x8, ra[j][m]); b[m] = __builtin_bit_cast(bf16x8, rb[j][m]); }
#pragma unroll
                for (int m = 0; m < 4; ++m)
                    asm volatile("s_nop 1\n\tv_mfma_f32_16x16x32_bf16 %0, %4, %5, %0\n\tv_mfma_f32_16x16x32_bf16 %1, %4, %6, %1\n\tv_mfma_f32_16x16x32_bf16 %2, %4, %7, %2\n\tv_mfma_f32_16x16x32_bf16 %3, %4, %8, %3\n\ts_nop 7\n\ts_nop 7"
                                 : "+v"(acc[m][0]), "+v"(acc[m][1]), "+v"(acc[m][2]), "+v"(acc[m][3]) : "v"(a[m]), "v"(b[0]), "v"(b[1]), "v"(b[2]), "v"(b[3]));
            }
        }
        __syncthreads();
#pragma unroll
        for (int m = 0; m < 4; ++m)
#pragma unroll
            for (int n = 0; n < 4; ++n)
#pragma unroll
                for (int r = 0; r < 4; ++r) part[wave * 4096 + ((m * 4 + n) * 4 + r) * 64 + lane] = acc[m][n][r];
        __syncthreads();
#pragma unroll
        for (int j = 0; j < 8; ++j) { const int idx = tid + 512 * j; float sum = 0.f;
#pragma unroll
            for (int w = 0; w < 8; ++w) sum += part[w * 4096 + idx];
            const int ln = idx & 63, r = (idx >> 6) & 3, mn = idx >> 8, m = mn >> 2, n = mn & 3;
            C[(size_t)(tm * 64 + 16 * m + 4 * (ln >> 4) + r) * D + tn * 64 + 16 * n + (ln & 15)] = (bf16_t)(cvt_pk_bf16(sum, 0.f) & 0xffffu); }
    }
    __syncthreads();
}
constexpr int NPHASE = 25;

#define IN(k) (lo <= (k) && (k) < hi)
#define SEAM(k) do { if (N_LAUNCHES == 1 && (k) + 1 < hi) xcd_barrier(bar); } while (0)
template <int l>
__device__ __forceinline__ void layer_body(Frame& F, const XcdBarrier& bar, const int lo, const int hi) {
    float* XC = (float*)(F.ws + WS_XC);
    bf16_t* HN = (bf16_t*)(F.ws + WS_HN); bf16_t* Pb = (bf16_t*)(F.ws + WS_P); bf16_t* MIX = (bf16_t*)(F.ws + WS_MIX); bf16_t* Yb = (bf16_t*)(F.ws + WS_Y);
    const float* COS = (const float*)(F.ws + WS_SMALL + SM_COS); const float* SIN = (const float*)(F.ws + WS_SMALL + SM_SIN);
        constexpr int pb = 1 + 12 * l; constexpr bool need_ctx = (l == 0); constexpr int nrows = need_ctx ? ROWS : NLAT;
        if (l == 0 && IN(pb + 0)) {
            RowCfg c{F.a->in[I_X], F.a->in[I_CTX], nullptr, nullptr, nullptr, nullptr, 0, 0, F.a->in[I_NPREMIX], 0, 0, 0, 0};
            if (EN(1)) { row_phase<false, false, true, false>(F, c, ROWS); if (REP(1)) { row_phase<false, false, true, false>(F, c, ROWS); } } SEAM(pb + 0); }
        if (IN(pb + 1)) {
            pg8::DenseOrder S; S.init(ROWS, PW, D, (const bf16_t*)(F.ws + WS_WIN) + (size_t)l * PW * D, F.G, F.bid);
            pg8::EpiProj E{Pb, COS, SIN};
            if (EN(2)) { pg8::gemm_phase<pg8::EpiProj, pg8::DenseOrder, true>(F.lds, (const char*)HN, D, S, E); if (REP(2)) { pg8::gemm_phase<pg8::EpiProj, pg8::DenseOrder, true>(F.lds, (const char*)HN, D, S, E); } gates_gemm_phase(F, l); } SEAM(pb + 1); }
        if (IN(pb + 2)) { if (EN(3)) { kmax_phase(F, l); if (REP(15)) kmax_phase(F, l); mlstm_a_phase(F, l); if (REP(16)) mlstm_a_phase(F, l); hg_a_phase(F, l); if (REP(17)) hg_a_phase(F, l); } SEAM(pb + 2); }
        if (IN(pb + 3)) { if (EN(3)) { mix_scan2_phase(F); if (REP(18)) mix_scan2_phase(F); } SEAM(pb + 3); }
        if (IN(pb + 4)) { if (EN(3)) { mlstm_c_phase(F, l, need_ctx); if (REP(19)) mlstm_c_phase(F, l, need_ctx); hg_c_phase(F, l, need_ctx); if (REP(20)) hg_c_phase(F, l, need_ctx); }
            if (EN(4)) { attn_phase(F, l, need_ctx); if (REP(4)) { attn_phase(F, l, need_ctx); } } SEAM(pb + 4); }

        if (IN(pb + 7)) {
            pg8::DenseOrder S; S.init(NLAT, D, D, (const bf16_t*)(F.ws + WS_WOUT) + (size_t)l * D * D, F.G, F.bid);
            pg8::EpiBf16 E{Yb, D};
            if (EN(6)) { pg8::gemm_phase<pg8::EpiBf16, pg8::DenseOrder, true>(F.lds, (const char*)MIX, D, S, E); if (REP(6)) { pg8::gemm_phase<pg8::EpiBf16, pg8::DenseOrder, true>(F.lds, (const char*)MIX, D, S, E); } }
            if (need_ctx && EN(6)) ctx_gemm_phase<D>(F, MIX + (size_t)NLAT * D, (const bf16_t*)(F.ws + WS_WOUT) + (size_t)l * D * D, Yb + (size_t)NLAT * D);
            SEAM(pb + 7); }
        if constexpr (l == 0) {
            if (IN(pb + 8)) { RowCfg c{F.a->in[I_X], F.a->in[I_CTX], F.out, XC, Yb, F.a->in[I_NPOSTMIX], 0, 2, F.a->in[I_NPREFFN], 0, 3, 0, 1};
                if (EN(7)) { row_phase<true, true, true, false>(F, c, ROWS); if (REP(7)) { row_phase<true, true, true, false>(F, c, ROWS); } } SEAM(pb + 8); }
            if (IN(pb + 9)) { pg8::DenseOrder S; S.init(ROWS, 2 * FF, D, (const bf16_t*)(F.ws + WS_WGU), F.G, F.bid);
                pg8::EpiSwiGLU E{Pb, FF};
                if (EN(8)) { pg8::gemm_phase<pg8::EpiSwiGLU, pg8::DenseOrder, true>(F.lds, (const char*)HN, D, S, E); if (REP(8)) { pg8::gemm_phase<pg8::EpiSwiGLU, pg8::DenseOrder, true>(F.lds, (const char*)HN, D, S, E); } } SEAM(pb + 9); }
            if (IN(pb + 10)) { pg8::DenseOrder S; S.init(NLAT, D, FF, (const bf16_t*)(F.ws + WS_WD), F.G, F.bid);
                pg8::EpiBf16 E{Yb, D};
                if (EN(9)) { pg8::gemm_phase<pg8::EpiBf16, pg8::DenseOrder, true>(F.lds, (const char*)Pb, FF, S, E); if (REP(9)) { pg8::gemm_phase<pg8::EpiBf16, pg8::DenseOrder, true>(F.lds, (const char*)Pb, FF, S, E); } }
                if (EN(9)) ctx_gemm_phase<FF>(F, Pb + (size_t)NLAT * FF, (const bf16_t*)(F.ws + WS_WD), Yb + (size_t)NLAT * D);
                SEAM(pb + 10); }
            if (IN(pb + 11)) { RowCfg c{F.out, XC, F.out, XC, Yb, F.a->in[I_NPOSTFFN], 0, 5, F.a->in[I_NPREMIX] + D, 1, 0, 1, 1};
                if (EN(10)) { row_phase<true, true, true, false>(F, c, ROWS); if (REP(10)) { row_phase<true, true, true, false>(F, c, ROWS); } } SEAM(pb + 11); }
        } else {
            if (IN(pb + 8)) { RowCfg c{F.out, XC, F.out, XC, Yb, F.a->in[I_NPOSTMIX] + D, 1, 2, F.a->in[I_NPREFFN] + D, 1, 3, 1, 1};
                if (EN(11)) { route_phase(F, c); if (REP(11)) { route_phase(F, c); } } SEAM(pb + 8); }
            if (IN(pb + 9)) { pg8::MoeOrder<true> S; S.init(F.ctl + CW_CNT, 2 * FE, D, (const bf16_t*)(F.ws + WS_MOE_GU), (size_t)2 * FE * D, F.ctl + CW_LIST, F.G, F.bid);
                pg8::EpiSwiGLU E{Pb, FE};
                if (EN(12)) { pg8::gemm_phase<pg8::EpiSwiGLU, pg8::MoeOrder<true>, true>(F.lds, (const char*)HN, D, S, E); if (REP(12)) { pg8::gemm_phase<pg8::EpiSwiGLU, pg8::MoeOrder<true>, true>(F.lds, (const char*)HN, D, S, E); } } SEAM(pb + 9); }
            if (IN(pb + 10)) {
                if (EN(13)) { { pg8::MoeDown<0> S; S.init(F.ctl + CW_CNT, (const bf16_t*)(F.ws + WS_MOE_D), (size_t)D * FE, F.G, F.bid); pg8::EpiBf16 E{(bf16_t*)(F.ws + WS_MOE_GU), D};
                        pg8::gemm_phase<pg8::EpiBf16, pg8::MoeDown<0>, true>(F.lds, (const char*)Pb, FE, S, E); }
                    { pg8::MoeDown<1> S; S.init(F.ctl + CW_CNT, (const bf16_t*)(F.ws + WS_MOE_D), (size_t)D * FE, F.G, F.bid); pg8::EpiBf16 E{(bf16_t*)(F.ws + WS_MOE_SIDE), D};
                        pg8::gemm_phase<pg8::EpiBf16, pg8::MoeDown<1>, true>(F.lds, (const char*)Pb, pg8::KSW, S, E, FE); } } SEAM(pb + 10); }
            if (IN(pb + 11)) { RowCfg c{F.out, XC, F.out, XC, nullptr, F.a->in[I_NPOSTFFN] + D, 1, 5, nullptr, 0, 0, 1, 0};
                if (EN(14)) { final_phase(F, c); if (REP(14)) { final_phase(F, c); } } }
        }
    }
__global__ void __launch_bounds__(NTHR, 2) fwd(Args args) {
    extern __shared__ __attribute__((aligned(16))) unsigned char lds_raw[];
    Frame F;
    F.lds = (LAS unsigned char*)lds_raw; F.MISC = (volatile LAS unsigned*)(F.lds + MISC_OFF);
    F.G = gridDim.x; F.bid = blockIdx.x;
    F.a = &args;
    F.out = args.out; F.ws = args.ws; F.ctl = (unsigned*)(args.ws + WS_CTL);
    for (int u = threadIdx.x; u < (LDS_BYTES - LDSCTL_OFF) / 4; u += NTHR) ((LAS unsigned*)(F.lds + LDSCTL_OFF))[u] = 0u;
    __syncthreads();
    XcdBarrier bar; bar.bar = F.ctl + CW_BAR; bar.x = 0; bar.st = nullptr;
    if (N_LAUNCHES == 1) bar = xcd_barrier_post(F.ctl + CW_BAR, F.MISC + 8);
    const int lo = args.ph_lo, hi = args.ph_hi;

    if (IN(0)) { if (EN(0)) { p_mod_vectors(F); p_consts(F); p_weights(F); if (REP(0)) { p_mod_vectors(F); p_consts(F); p_weights(F); } } SEAM(0); }

    layer_body<0>(F, bar, lo, hi);
    layer_body<1>(F, bar, lo, hi);
#undef IN
#undef SEAM
}

extern "C" void kernel_launch(void* const* d_in, const int* in_sizes, int n_in, void* d_out, int out_size, void* d_ws, size_t ws_size, hipStream_t stream) {
    static int grid = 0;
    if (grid == 0) {
        if (n_in != 26 || out_size != NLAT * D || ws_size < WS_END) { fprintf(stderr, "kernel_launch: unexpected shapes: n_in %d out %d ws %zu (need %zu)\n", n_in, out_size, ws_size, (size_t)WS_END); grid = -1; return; }
        int dev = 0, cus = 0, per_cu = 0;
        if (hipGetDevice(&dev) != hipSuccess || hipDeviceGetAttribute(&cus, hipDeviceAttributeMultiprocessorCount, dev) != hipSuccess) { grid = -1; return; }
        if (hipFuncSetAttribute((const void*)fwd, hipFuncAttributeMaxDynamicSharedMemorySize, LDS_BYTES) != hipSuccess) { fprintf(stderr, "kernel_launch: hipFuncSetAttribute failed\n"); grid = -1; return; }
        if (hipOccupancyMaxActiveBlocksPerMultiprocessor(&per_cu, (const void*)fwd, NTHR, LDS_BYTES) != hipSuccess || per_cu < 1) { fprintf(stderr, "kernel_launch: occupancy query says %d\n", per_cu); }
        (void)hipGetLastError();
        grid = cus;
    }
    if (grid < 0) return;
    (void)hipMemsetAsync((char*)d_ws + WS_CTL, 0, CTL_ZERO_BYTES, stream);
    Args a{};
    for (int i = 0; i < 26; ++i) a.in[i] = (const float*)d_in[i];
    a.out = (float*)d_out; a.ws = (unsigned char*)d_ws;
    if (N_LAUNCHES == 1) { a.ph_lo = 0; a.ph_hi = NPHASE; hipLaunchKernelGGL(fwd, dim3(grid), dim3(NTHR), LDS_BYTES, stream, a); }
    else {
        for (int p = 0; p < NPHASE; ++p) { if (p == 13) continue; a.ph_lo = p; a.ph_hi = p + 1; hipLaunchKernelGGL(fwd, dim3(grid), dim3(NTHR), LDS_BYTES, stream, a); }
    }
}
```
